# Optimizing an MI355X kernel written in HIP

```python
import math
import jax
import jax.numpy as jnp
from jax import lax
import numpy as np

D_MODEL = 2048
BATCH = 4
SEQ = 2048
DEPTH = 2

N_HEADS = 16
HEAD_DIM = 128
ATT_WIDTH = N_HEADS * HEAD_DIM
ATT_SCALE = HEAD_DIM ** -0.5
DIL_PATTERNS = ((128, 1), (512, 4), (2048, 16))
BAND_BLOCK = 128
REL_BUCKETS = 32
REL_MAX_EXACT = REL_BUCKETS // 2
REL_MAX_DISTANCE = 2048
NSA_KV_GROUPS = 4
NSA_HEADS_PER_GROUP = N_HEADS // NSA_KV_GROUPS
NSA_BRANCHES = 3
CMP_BLOCK = 32
CMP_STRIDE = 16
CMP_HIDDEN = 256
SLC_BLOCK = 64
SLC_TOP_N = 16
SLC_QUERY_BLOCK = 32
WIN_SIZE = 512
N_A_LAYERS = DEPTH // 2
N_B_LAYERS = DEPTH - N_A_LAYERS
RMS_EPS = 1e-6
NEG_INF = -1e30
FORCE_SCORE = 1e9

kernel_name = 'yoco_dilated_nsa_hybrid'


def rms_norm(x, g):
    xf = x.astype(jnp.float32)
    y = xf * lax.rsqrt(jnp.mean(xf * xf, axis=-1, keepdims=True) + RMS_EPS)
    return (y * g.astype(jnp.float32)).astype(x.dtype)


def rel_bucket(dist):
    n = jnp.maximum(dist, 0)
    nf = jnp.maximum(n, 1).astype(jnp.float32)
    log_b = REL_MAX_EXACT + (jnp.log(nf / REL_MAX_EXACT) / math.log(REL_MAX_DISTANCE / REL_MAX_EXACT)
                             * (REL_BUCKETS - REL_MAX_EXACT)).astype(jnp.int32)
    return jnp.where(n < REL_MAX_EXACT, n, jnp.minimum(log_b, REL_BUCKETS - 1))


def rel_bias(table, dist):
    b = jnp.take(table, rel_bucket(dist), axis=0).astype(jnp.float32)
    return jnp.moveaxis(b, -1, 0)


def dilated_attention(q, k, v, table, window, dilation):
    B, H, S, Dh = q.shape
    L = S // dilation
    n_keys = window // dilation
    nb = -(-L // BAND_BLOCK)
    Lp = nb * BAND_BLOCK

    def to_sub(t):
        t = t.reshape(B, H, L, dilation, Dh).transpose(0, 1, 3, 2, 4)
        return jnp.pad(t, ((0, 0), (0, 0), (0, 0), (0, Lp - L), (0, 0)))

    def band(t):
        tp = jnp.pad(t, ((0, 0), (0, 0), (0, 0), (BAND_BLOCK, 0), (0, 0)))
        tp = tp.reshape(B, H, dilation, nb + 1, BAND_BLOCK, Dh)
        return jnp.concatenate([tp[:, :, :, :-1], tp[:, :, :, 1:]], axis=4)

    qb = to_sub(q).reshape(B, H, dilation, nb, BAND_BLOCK, Dh)
    kb = band(to_sub(k))
    vb = band(to_sub(v))
    qi = jnp.arange(BAND_BLOCK)[:, None]
    ki = jnp.arange(2 * BAND_BLOCK)[None, :]
    delta = qi + BAND_BLOCK - ki
    key_pos = jnp.arange(nb)[:, None, None] * BAND_BLOCK - BAND_BLOCK + ki[None]
    valid = (delta >= 0) & (delta <= n_keys) & (key_pos >= 0)
    bias = rel_bias(table, delta * dilation)
    s = jnp.einsum('bhrnqd,bhrnkd->bhrnqk', qb, kb).astype(jnp.float32) * ATT_SCALE + bias[None, :, None, None]
    s = jnp.where(valid, s, NEG_INF)
    m = jnp.max(s, axis=-1, keepdims=True)
    p = jnp.exp(s - m)
    den = jnp.sum(p, axis=-1, keepdims=True)
    o = jnp.einsum('bhrnqk,bhrnkd->bhrnqd', p.astype(vb.dtype), vb).astype(jnp.float32) / den
    lse = (m + jnp.log(den))[..., 0]
    o = o.reshape(B, H, dilation, Lp, Dh)[:, :, :, :L].transpose(0, 1, 3, 2, 4).reshape(B, H, S, Dh)
    lse = lse.reshape(B, H, dilation, Lp)[..., :L].transpose(0, 1, 3, 2).reshape(B, H, S)
    return o, lse


def dilated_mixer(h, w_in, w_out, table):
    B, S, _ = h.shape
    q, k, v, z = jnp.split(h @ w_in, 4, axis=-1)

    def heads(t):
        return t.reshape(B, S, N_HEADS, HEAD_DIM).transpose(0, 2, 1, 3)

    q, k, v = heads(q), heads(k), heads(v)
    outs, lses = [], []
    for window, dilation in DIL_PATTERNS:
        o, l = dilated_attention(q, k, v, table, window, dilation)
        outs.append(o)
        lses.append(l)
    alpha = jax.nn.softmax(jnp.stack(lses), axis=0)
    o = jnp.einsum('pbhs,pbhsd->bshd', alpha, jnp.stack(outs)).reshape(B, S, ATT_WIDTH).astype(h.dtype)
    return (o * jax.nn.silu(z)) @ w_out


def compress_blocks(t, pos, w1, w2):
    B, G, S, Dh = t.shape
    c = t.reshape(B, G, S // CMP_STRIDE, CMP_STRIDE, Dh)
    blocks = jnp.concatenate([c[:, :, :-1], c[:, :, 1:]], axis=3) + pos
    flat = blocks.reshape(B, G, blocks.shape[2], CMP_BLOCK * Dh)
    return jax.nn.gelu(flat @ w1) @ w2


def shared_kv(h, kv_norm, w_kv, cmp_pos_k, cmp_pos_v, cmp_w1_k, cmp_w2_k, cmp_w1_v, cmp_w2_v):
    B, S, _ = h.shape
    kv = (rms_norm(h, kv_norm) @ w_kv).reshape(B, S, 2 * NSA_BRANCHES, NSA_KV_GROUPS, HEAD_DIM)
    kv = kv.transpose(2, 0, 3, 1, 4)
    k_cmp = compress_blocks(kv[0], cmp_pos_k, cmp_w1_k, cmp_w2_k)
    v_cmp = compress_blocks(kv[1], cmp_pos_v, cmp_w1_v, cmp_w2_v)
    return k_cmp, v_cmp, kv[2], kv[3], kv[4], kv[5]


def nsa_mixer(h, w_in, w_out, table, k_cmp, v_cmp, k_slc, v_slc, k_win, v_win):
    B, S, _ = h.shape
    G, J, Dh = NSA_KV_GROUPS, NSA_HEADS_PER_GROUP, HEAD_DIM
    f32 = jnp.float32
    proj = h @ w_in
    q = proj[..., :ATT_WIDTH].reshape(B, S, G, J, Dh).transpose(0, 2, 3, 1, 4)
    z = proj[..., ATT_WIDTH:(1 + NSA_BRANCHES) * ATT_WIDTH].reshape(B, S, NSA_BRANCHES, N_HEADS, Dh)
    gate = jax.nn.sigmoid(proj[..., (1 + NSA_BRANCHES) * ATT_WIDTH:].astype(f32)).reshape(B, S, NSA_BRANCHES, N_HEADS)
    t = jnp.arange(S)

    nc = k_cmp.shape[2]
    cmp_end = jnp.arange(nc) * CMP_STRIDE + CMP_BLOCK - 1
    dist_c = t[:, None] - cmp_end[None, :]
    valid_c = dist_c >= 0
    bias_c = rel_bias(table, dist_c).reshape(G, J, S, nc)
    s_c = jnp.einsum('bgjsd,bgcd->bgjsc', q, k_cmp).astype(f32) * ATT_SCALE + bias_c
    s_c = jnp.where(valid_c, s_c, NEG_INF)
    p_c = jnp.where(valid_c, jnp.exp(s_c - jnp.max(s_c, axis=-1, keepdims=True)), 0.0)
    p_c = p_c / jnp.maximum(jnp.sum(p_c, axis=-1, keepdims=True), 1e-30)
    o_c = jnp.einsum('bgjsc,bgcd->bgjsd', p_c.astype(v_cmp.dtype), v_cmp)

    ns = S // SLC_BLOCK
    n_sel = min(SLC_TOP_N, ns)
    ci = np.arange(nc)[:, None] * CMP_STRIDE
    sj = np.arange(ns)[None, :] * SLC_BLOCK
    overlap = jnp.asarray(((ci < sj + SLC_BLOCK) & (ci + CMP_BLOCK > sj)).astype(np.float32))
    imp = jnp.einsum('bgjsc,cn->bgsn', p_c, overlap)
    cur = (t // SLC_BLOCK)[:, None]
    blk = jnp.arange(ns)[None, :]
    forced = (blk == 0) | (blk == cur) | (blk == cur - 1)
    imp = jnp.where(forced, FORCE_SCORE, jnp.where(blk > cur, -FORCE_SCORE, imp))
    _, sel = lax.top_k(imp, n_sel)

    kb = k_slc.reshape(B, G, ns, SLC_BLOCK, Dh)
    vb = v_slc.reshape(B, G, ns, SLC_BLOCK, Dh)
    nq = S // SLC_QUERY_BLOCK
    q_blocks = q.reshape(B, G, J, nq, SLC_QUERY_BLOCK, Dh).transpose(3, 0, 1, 2, 4, 5)
    sel_blocks = sel.reshape(B, G, nq, SLC_QUERY_BLOCK, n_sel).transpose(2, 0, 1, 3, 4)
    starts = jnp.arange(nq) * SLC_QUERY_BLOCK
    table_g = table.reshape(REL_BUCKETS, G, J)
    gather = jax.vmap(jax.vmap(lambda blocks, ix: blocks[ix]))
    group_bias = jax.vmap(lambda tb, bk: tb[bk], in_axes=(1, 1), out_axes=1)

    def selected_block(args):
        qb_, ix, start = args
        kg = gather(kb, ix)
        vg = gather(vb, ix)
        tq = start + jnp.arange(SLC_QUERY_BLOCK)
        dist = tq[:, None, None] - (ix[..., None] * SLC_BLOCK + jnp.arange(SLC_BLOCK))
        bias = jnp.moveaxis(group_bias(table_g, rel_bucket(dist)), -1, 2).astype(f32)
        s = jnp.einsum('bgjqd,bgqnkd->bgjqnk', qb_, kg).astype(f32) * ATT_SCALE + bias
        s = jnp.where((dist >= 0)[:, :, None], s, NEG_INF)
        p = jax.nn.softmax(s.reshape(*s.shape[:4], -1), axis=-1).reshape(s.shape)
        return jnp.einsum('bgjqnk,bgqnkd->bgjqd', p.astype(vg.dtype), vg)

    o_s = lax.map(selected_block, (q_blocks, sel_blocks, starts))
    o_s = o_s.transpose(1, 2, 3, 0, 4, 5).reshape(B, G, J, S, Dh)

    nb = S // BAND_BLOCK
    nw = WIN_SIZE // BAND_BLOCK
    kw_len = (nw + 1) * BAND_BLOCK

    def band(t_):
        tp = jnp.pad(t_, ((0, 0), (0, 0), (WIN_SIZE, 0), (0, 0))).reshape(B, G, nb + nw, BAND_BLOCK, Dh)
        return jnp.concatenate([tp[:, :, i:i + nb] for i in range(nw + 1)], axis=3)

    qw = q.reshape(B, G, J, nb, BAND_BLOCK, Dh)
    qpos = jnp.arange(nb)[:, None] * BAND_BLOCK + jnp.arange(BAND_BLOCK)[None, :]
    kpos = jnp.arange(nb)[:, None] * BAND_BLOCK - WIN_SIZE + jnp.arange(kw_len)[None, :]
    delta = qpos[:, :, None] - kpos[:, None, :]
    valid_w = (delta >= 0) & (delta < WIN_SIZE) & (kpos[:, None, :] >= 0)
    bias_w = rel_bias(table, delta).reshape(G, J, nb, BAND_BLOCK, kw_len)
    s_w = jnp.einsum('bgjnqd,bgnkd->bgjnqk', qw, band(k_win)).astype(f32) * ATT_SCALE + bias_w
    p_w = jax.nn.softmax(jnp.where(valid_w, s_w, NEG_INF), axis=-1)
    o_w = jnp.einsum('bgjnqk,bgnkd->bgjnqd', p_w.astype(v_win.dtype), band(v_win)).reshape(B, G, J, S, Dh)

    def to_tokens(o):
        return o.transpose(0, 3, 1, 2, 4).reshape(B, S, N_HEADS, Dh)

    o_all = jnp.stack([to_tokens(o_c), to_tokens(o_s), to_tokens(o_w)], axis=2)
    y = jnp.sum(gate[..., None].astype(h.dtype) * o_all * jax.nn.silu(z), axis=2)
    return y.reshape(B, S, ATT_WIDTH) @ w_out


def setup_inputs(seed: int = 0) -> dict:
    key = jax.random.key(seed)
    ks = jax.random.split(key, 16)
    f32 = jnp.float32

    def w(k, shape, fan_in):
        return jax.random.normal(k, shape, f32) * fan_in ** -0.5

    in_a = 4 * ATT_WIDTH
    in_b = (1 + NSA_BRANCHES) * ATT_WIDTH + NSA_BRANCHES * N_HEADS
    n_kv = 2 * NSA_BRANCHES * NSA_KV_GROUPS * HEAD_DIM
    return {
        'x': jax.random.normal(ks[0], (BATCH, SEQ, D_MODEL), f32),
        'norm_pre': 1.0 + 0.02 * jax.random.normal(ks[1], (DEPTH, D_MODEL), f32),
        'norm_post': 1.0 + 0.02 * jax.random.normal(ks[2], (DEPTH, D_MODEL), f32),
        'rel_table': 0.5 * jax.random.normal(ks[3], (REL_BUCKETS, N_HEADS), f32),
        'w_in_a': w(ks[4], (N_A_LAYERS, D_MODEL, in_a), D_MODEL),
        'w_out_a': w(ks[5], (N_A_LAYERS, ATT_WIDTH, D_MODEL), ATT_WIDTH),
        'kv_norm': 1.0 + 0.02 * jax.random.normal(ks[6], (D_MODEL,), f32),
        'w_kv': w(ks[7], (D_MODEL, n_kv), D_MODEL),
        'cmp_pos_k': 0.1 * jax.random.normal(ks[8], (CMP_BLOCK, HEAD_DIM), f32),
        'cmp_pos_v': 0.1 * jax.random.normal(ks[9], (CMP_BLOCK, HEAD_DIM), f32),
        'cmp_w1_k': w(ks[10], (CMP_BLOCK * HEAD_DIM, CMP_HIDDEN), CMP_BLOCK * HEAD_DIM),
        'cmp_w2_k': w(ks[11], (CMP_HIDDEN, HEAD_DIM), CMP_HIDDEN),
        'cmp_w1_v': w(ks[12], (CMP_BLOCK * HEAD_DIM, CMP_HIDDEN), CMP_BLOCK * HEAD_DIM),
        'cmp_w2_v': w(ks[13], (CMP_HIDDEN, HEAD_DIM), CMP_HIDDEN),
        'w_in_b': w(ks[14], (N_B_LAYERS, D_MODEL, in_b), D_MODEL),
        'w_out_b': w(ks[15], (N_B_LAYERS, ATT_WIDTH, D_MODEL), ATT_WIDTH),
    }


def reference(x, norm_pre, norm_post, rel_table, w_in_a, w_out_a, kv_norm, w_kv, cmp_pos_k, cmp_pos_v,
              cmp_w1_k, cmp_w2_k, cmp_w1_v, cmp_w2_v, w_in_b, w_out_b):
    h = x
    shared = None
    for layer in range(DEPTH):
        hn = rms_norm(h, norm_pre[layer])
        if layer < N_A_LAYERS:
            y = dilated_mixer(hn, w_in_a[layer], w_out_a[layer], rel_table)
        else:
            if layer == N_A_LAYERS:
                shared = shared_kv(h, kv_norm, w_kv, cmp_pos_k, cmp_pos_v, cmp_w1_k, cmp_w2_k, cmp_w1_v, cmp_w2_v)
            b = layer - N_A_LAYERS
            y = nsa_mixer(hn, w_in_b[b], w_out_b[b], rel_table, *shared)
        h = h + rms_norm(y, norm_post[layer])
    return h
```

```cpp
#include <hip/hip_runtime.h>
#include <hip/hip_cooperative_groups.h>
#include <cstdio>
#include <cstdint>
namespace cg = cooperative_groups;

namespace pg8 {
#define PG8_LAS __attribute__((address_space(3)))
typedef unsigned short bf16_t;
typedef short bf16x8 __attribute__((ext_vector_type(8)));
typedef float f32x4 __attribute__((ext_vector_type(4)));
typedef unsigned u32x4 __attribute__((ext_vector_type(4)));
constexpr int BM = 256, BK = 64, HALF = 128, HTB = HALF * BK * 2  , STAGE_BYTES = 8 * HTB, NXCD = 8, WGM = 8;

__host__ __device__ __forceinline__ int lds_byte(int r, int c) { const int st = (r >> 4) * 2 + (c >> 5), rr = r & 15, cc = c & 31, ob = rr * 64 + cc * 2; return st * 1024 + (ob ^ (((ob >> 9) & 1) << 5)); }
__host__ __device__ __forceinline__ void stage_rc(int b, int& R, int& C) { const int st = b / 1024, sb = b % 1024, swz = sb ^ (((sb >> 9) & 1) << 5); R = (st >> 1) * 16 + swz / 64; C = (st & 1) * 32 + (swz % 64) / 2; }
__host__ __device__ __forceinline__ int perm32(int rho) { const int n = rho >> 4, i = rho & 15; return 8 * (i >> 2) + 4 * n + (i & 3); }

struct Unit { int pm, pn; };
struct Gemm { const bf16_t* A; const bf16_t* Bt; int M, N, K; };

struct StaticOrder {
    int nM, nN, nwg, G, c;
    __host__ __device__ void init(int M, int N, int G_, int c_) { nM = M / BM; nN = N / BM; nwg = nM * nN; G = G_; c = c_; }
    __host__ __device__ bool next(int i, Unit& u) const {
        const long L = (long)i * G + c; if (L >= nwg) return false;
        int wgid = (int)L; { const int q = nwg / NXCD, r = nwg % NXCD, xcd = wgid % NXCD, off = wgid / NXCD; wgid = (xcd < r ? xcd * (q + 1) : r * (q + 1) + (xcd - r) * q) + off; }
        const int nig = WGM * nN, gid = wgid / nig, fm = gid * WGM, gsz = (nM - fm) < WGM ? (nM - fm) : WGM;
        u.pm = fm + ((wgid % nig) % gsz); u.pn = (wgid % nig) / gsz; return true;
    }
    __device__ __forceinline__ void a_ready(const Unit&) const {}
    __device__ __forceinline__ void done(const Unit&) const {}
};

__device__ __forceinline__ unsigned cvt_pk_bf16(float lo, float hi) { unsigned r; asm volatile("v_cvt_pk_bf16_f32 %0, %1, %2" : "=v"(r) : "v"(lo), "v"(hi)); return r; }
typedef float f32x2 __attribute__((ext_vector_type(2)));

template <int KIND> struct EpiK {
    static constexpr bool PERM = true, AFTER_DRAIN = false;
    bf16_t* b0; bf16_t* b1;
    __device__ __forceinline__ void operator()(const f32x4 (&acc)[2][2][4][2], const Unit& u, int wr, int wc, int fr, int fq) const {
        bf16_t* base; bool hm; int ld = 2048, pr = u.pn;
        if (KIND == 1) { if (u.pn < 24) { base = b0; hm = true; } else { base = b1; hm = false; pr = u.pn - 24; } }
        else if (KIND == 2) { base = b0; hm = false; }
        else { if (u.pn < 8) { base = b0; hm = true; } else if (u.pn < 32) { base = b0 + (size_t)16 * 1024 * 1024; hm = false; ld = 6144; pr = u.pn - 8; }
               else if (u.pn < 44) { base = b1; hm = true; pr = u.pn - 32; } else { base = b1 + (size_t)24 * 1024 * 1024; hm = false; ld = 256; pr = 0; } }
        const int row0 = u.pm * BM + wr * 64 + fr;
        const int cin = wc * 32 + 8 * fq;
#pragma unroll
        for (int ai = 0; ai < 2; ++ai)
#pragma unroll
            for (int m = 0; m < 4; ++m) {
                const int row = row0 + ai * HALF + m * 16;
                float s = 0.f;
#pragma unroll
                for (int bj = 0; bj < 2; ++bj) {
                    const f32x4 v0 = acc[ai][bj][m][0], v1 = acc[ai][bj][m][1];
                    if (KIND == 2) s += (v0[0] * v0[0] + v0[1] * v0[1]) + (v0[2] * v0[2] + v0[3] * v0[3]) + (v1[0] * v1[0] + v1[1] * v1[1]) + (v1[2] * v1[2] + v1[3] * v1[3]);
                    u32x4 w; w.x = cvt_pk_bf16(v0[0], v0[1]); w.y = cvt_pk_bf16(v0[2], v0[3]); w.z = cvt_pk_bf16(v1[0], v1[1]); w.w = cvt_pk_bf16(v1[2], v1[3]);
                    bf16_t* dst = hm ? base + ((size_t)(pr * 2 + bj) * 8192 + row) * 128 + cin
                                     : base + (size_t)row * ld + pr * 256 + bj * HALF + cin;
                    *(u32x4*)dst = w;
                }
                if (KIND == 2) { s += __shfl_xor(s, 16); s += __shfl_xor(s, 32); if (fq == 0) ((float*)b1)[(size_t)row * 32 + u.pn * 4 + wc] = s; }
            }
    }
};
template <class Epi, class Sched, bool ALIGN_EPI = false, bool SP2 = false>
__device__ __forceinline__ void gemm_phase(PG8_LAS unsigned char* lds, const Gemm g, const Sched& S, const Epi& E) {
    const int tid = threadIdx.x, wid = __builtin_amdgcn_readfirstlane(tid >> 6), lane = tid & 63, wr = wid >> 2, wc = wid & 3, fr = lane & 15, fq = lane >> 4;
    const int K = g.K, nt = K / BK;
    unsigned voffA[2], voffB[2];
#pragma unroll
    for (int i = 0; i < 2; ++i) { int R, C; stage_rc(tid * 16 + i * 8192, R, C); const int Rb = Epi::PERM ? ((R & ~31) + perm32(R & 31)) : R;
        voffA[i] = (unsigned)(R * K + C) * 2u; voffB[i] = (unsigned)(Rb * K + C) * 2u; }
    const size_t kstep = (size_t)(BK * 2);
    const size_t hstep = (size_t)HALF * K * 2;
    const size_t tstep = 2 * hstep;
    const unsigned ldsw = (unsigned)wid * 1024u;
    const int aoff = lds_byte(wr * 64 + fr, fq * 8), boff = lds_byte(wc * 32 + fr, fq * 8);
#define PG8_SA(b, h) (((b) * 2 + (h)) * HTB)
#define PG8_SB(b, h) ((4 + (b) * 2 + (h)) * HTB)
#define PG8_STAGE(bufoff, gbase, voff) do { _Pragma("unroll") for (int _i = 0; _i < 2; ++_i) \
        __builtin_amdgcn_global_load_lds((const unsigned*)((const char*)(gbase) + (voff)[_i]), (PG8_LAS unsigned*)(lds + (bufoff) + ldsw + _i * 8192), 16, 0, 0); } while (0)
#define PG8_LDA(dst, b, h) do { _Pragma("unroll") for (int m = 0; m < 4; ++m) _Pragma("unroll") for (int k = 0; k < 2; ++k) dst[m][k] = *(const PG8_LAS bf16x8*)(lds + PG8_SA(b, h) + aoff + m * 2048 + k * 1024); } while (0)
#define PG8_LDB(dst, b, h) do { _Pragma("unroll") for (int n = 0; n < 2; ++n) _Pragma("unroll") for (int k = 0; k < 2; ++k) dst[n][k] = *(const PG8_LAS bf16x8*)(lds + PG8_SB(b, h) + boff + n * 2048 + k * 1024); } while (0)
#define PG8_MMA(ai, bj, At, Bt) do { __builtin_amdgcn_s_setprio(1); _Pragma("unroll") for (int m = 0; m < 4; ++m) _Pragma("unroll") for (int n = 0; n < 2; ++n) _Pragma("unroll") for (int k = 0; k < 2; ++k) \
        acc[ai][bj][m][n] = __builtin_amdgcn_mfma_f32_16x16x32_bf16(Bt[n][k], At[m][k], acc[ai][bj][m][n], 0, 0, 0); __builtin_amdgcn_s_setprio(0); } while (0)
#define PG8_WAIT_V(n) asm volatile("s_waitcnt vmcnt(" #n ")" ::: "memory")
#define PG8_WAIT_L(n) asm volatile("s_waitcnt lgkmcnt(" #n ")" ::: "memory")
#define PG8_BAR __builtin_amdgcn_s_barrier()
#define PG8_SCHED __builtin_amdgcn_sched_barrier(0)
    Unit cur, nxt; int ui = 0;
    if (!S.next(0, cur)) return;
    f32x4 acc[2][2][4][2];
#pragma unroll
    for (int a = 0; a < 2; ++a)
#pragma unroll
        for (int b = 0; b < 2; ++b)
#pragma unroll
            for (int m = 0; m < 4; ++m)
#pragma unroll
                for (int n = 0; n < 2; ++n) acc[a][b][m][n] = (f32x4){0.f, 0.f, 0.f, 0.f};
    bf16x8 At[4][2], B0[2][2], B1[2][2];
    const char* cA = (const char*)g.A + (size_t)cur.pm * tstep; const char* cB = (const char*)g.Bt + (size_t)cur.pn * tstep;
    S.a_ready(cur);
    if constexpr (SP2) {
        PG8_STAGE(PG8_SB(0, 0), cB, voffB); PG8_STAGE(PG8_SB(0, 1), cB + hstep, voffB); PG8_STAGE(PG8_SA(0, 0), cA, voffA); PG8_STAGE(PG8_SA(0, 1), cA + hstep, voffA);
        if (wr == 1) PG8_BAR;
        PG8_WAIT_V(2); PG8_BAR;
        PG8_STAGE(PG8_SB(1, 0), cB + kstep, voffB); PG8_STAGE(PG8_SA(1, 0), cA + kstep, voffA); PG8_STAGE(PG8_SB(1, 1), cB + hstep + kstep, voffB);
        PG8_WAIT_V(6); PG8_BAR;
    } else {
        PG8_STAGE(PG8_SB(0, 0), cB, voffB); PG8_STAGE(PG8_SA(0, 0), cA, voffA); PG8_STAGE(PG8_SB(0, 1), cB + hstep, voffB); PG8_STAGE(PG8_SA(0, 1), cA + hstep, voffA);
        if (wr == 1) PG8_BAR;
        PG8_WAIT_V(4); PG8_BAR;
        PG8_STAGE(PG8_SB(1, 0), cB + kstep, voffB); PG8_STAGE(PG8_SA(1, 0), cA + kstep, voffA); PG8_STAGE(PG8_SB(1, 1), cB + hstep + kstep, voffB);
        PG8_WAIT_V(6); PG8_BAR;
    }
    for (;;) {
        const bool has_next = S.next(ui + 1, nxt);
        const char* nA = has_next ? (const char*)g.A + (size_t)nxt.pm * tstep : cA; const char* nB = has_next ? (const char*)g.Bt + (size_t)nxt.pn * tstep : cB;
        for (int t = 0; t < nt; t += 2) {
            const bool last = (t == nt - 2);
            const char* a1 = cA + (size_t)(t + 1) * kstep;
            const char* a2 = last ? nA : cA + (size_t)(t + 2) * kstep; const char* b2 = last ? nB : cB + (size_t)(t + 2) * kstep;
            const char* a3 = a2 + kstep; const char* b3 = b2 + kstep;
            if (last && has_next) S.a_ready(nxt);
            if constexpr (SP2) {
            PG8_LDB(B0, 0, 0); PG8_LDB(B1, 0, 1); PG8_SCHED; PG8_LDA(At, 0, 0); PG8_STAGE(PG8_SA(1, 1), a1 + hstep, voffA);
            PG8_WAIT_V(8); PG8_WAIT_L(0); PG8_BAR; PG8_MMA(0, 0, At, B0); PG8_MMA(0, 1, At, B1); PG8_BAR; PG8_SCHED;
            PG8_LDA(At, 0, 1); PG8_STAGE(PG8_SB(0, 0), b2, voffB); PG8_STAGE(PG8_SB(0, 1), b2 + hstep, voffB); PG8_STAGE(PG8_SA(0, 0), a2, voffA);
            PG8_WAIT_V(8); PG8_WAIT_L(0); PG8_BAR; PG8_MMA(1, 0, At, B0); PG8_MMA(1, 1, At, B1); PG8_BAR; PG8_SCHED;
            PG8_LDB(B0, 1, 0); PG8_LDB(B1, 1, 1); PG8_SCHED; PG8_LDA(At, 1, 0); PG8_STAGE(PG8_SA(0, 1), a2 + hstep, voffA);
            PG8_WAIT_V(8); PG8_WAIT_L(0); PG8_BAR; PG8_MMA(0, 0, At, B0); PG8_MMA(0, 1, At, B1); PG8_BAR; PG8_SCHED;
            PG8_LDA(At, 1, 1); PG8_STAGE(PG8_SB(1, 0), b3, voffB); PG8_STAGE(PG8_SB(1, 1), b3 + hstep, voffB); PG8_STAGE(PG8_SA(1, 0), a3, voffA);
            PG8_WAIT_V(8); PG8_WAIT_L(0); PG8_BAR; PG8_MMA(1, 0, At, B0); PG8_MMA(1, 1, At, B1); PG8_BAR; PG8_SCHED;
            } else {
            PG8_LDB(B0, 0, 0); PG8_SCHED; PG8_LDA(At, 0, 0); PG8_STAGE(PG8_SA(1, 1), a1 + hstep, voffA);
            PG8_WAIT_L(8); PG8_BAR; PG8_WAIT_L(0); PG8_MMA(0, 0, At, B0); PG8_BAR; PG8_SCHED;
            PG8_LDB(B1, 0, 1); PG8_STAGE(PG8_SB(0, 0), b2, voffB);
            PG8_BAR; PG8_WAIT_L(0); PG8_MMA(0, 1, At, B1); PG8_BAR;
            PG8_LDA(At, 0, 1); PG8_STAGE(PG8_SA(0, 0), a2, voffA);
            PG8_BAR; PG8_WAIT_L(0); PG8_MMA(1, 0, At, B0); PG8_BAR; PG8_SCHED;
            PG8_STAGE(PG8_SB(0, 1), b2 + hstep, voffB);
            PG8_WAIT_V(6); PG8_BAR; PG8_MMA(1, 1, At, B1); PG8_BAR;
            PG8_LDB(B0, 1, 0); PG8_SCHED; PG8_LDA(At, 1, 0); PG8_STAGE(PG8_SA(0, 1), a2 + hstep, voffA);
            PG8_WAIT_L(8); PG8_BAR; PG8_WAIT_L(0); PG8_MMA(0, 0, At, B0); PG8_BAR; PG8_SCHED;
            PG8_LDB(B1, 1, 1); PG8_STAGE(PG8_SB(1, 0), b3, voffB);
            PG8_BAR; PG8_WAIT_L(0); PG8_MMA(0, 1, At, B1); PG8_BAR;
            PG8_LDA(At, 1, 1); PG8_STAGE(PG8_SA(1, 0), a3, voffA);
            PG8_BAR; PG8_WAIT_L(0); PG8_MMA(1, 0, At, B0); PG8_BAR; PG8_SCHED;
            PG8_STAGE(PG8_SB(1, 1), b3 + hstep, voffB);
            PG8_WAIT_V(6); PG8_BAR; PG8_MMA(1, 1, At, B1); PG8_BAR;
            }
        }
        if constexpr (ALIGN_EPI) { if (wr == 0) PG8_BAR; }
        if constexpr (!Epi::AFTER_DRAIN) { E(acc, cur, wr, wc, fr, fq); S.done(cur); }
        if (!has_next) break;
#pragma unroll
        for (int a = 0; a < 2; ++a)
#pragma unroll
            for (int b = 0; b < 2; ++b)
#pragma unroll
                for (int m = 0; m < 4; ++m)
#pragma unroll
                    for (int n = 0; n < 2; ++n) acc[a][b][m][n] = (f32x4){0.f, 0.f, 0.f, 0.f};
        cur = nxt; cA = nA; cB = nB; ++ui;
        if constexpr (ALIGN_EPI) { if (wr == 1) PG8_BAR; }
    }
    PG8_WAIT_V(0);
    if constexpr (!ALIGN_EPI) { if (wr == 0) PG8_BAR; }
    PG8_BAR;
    if constexpr (Epi::AFTER_DRAIN) { E.fused(acc, cur, wr, wc, fr, fq, lds, wid, lane); S.done(cur); }
#undef PG8_SA
#undef PG8_SB
#undef PG8_STAGE
#undef PG8_LDA
#undef PG8_LDB
#undef PG8_MMA
#undef PG8_WAIT_V
#undef PG8_WAIT_L
#undef PG8_BAR
#undef PG8_SCHED
}
}

#define LAS __attribute__((address_space(3)))
typedef unsigned short bf16_t;
typedef unsigned u32x4 __attribute__((ext_vector_type(4)));
constexpr int DM = 2048, NB = 4, SEQ = 2048, NH = 16, HD = 128, MTOK = NB * SEQ;
constexpr int NCMP = 127;
constexpr float ATT_SCALE = 0.08838834764831845f;
constexpr float NEGF = -1e30f;
constexpr size_t MiB = 1u << 20;
constexpr size_t WS_QKVA = 0, WS_ZA = 96 * MiB;
constexpr size_t WS_QB = 0, WS_ZB = 32 * MiB;
constexpr size_t WS_Y1 = 0;
constexpr size_t WS_B = 128 * MiB;
constexpr size_t WS_WB = 160 * MiB;
constexpr size_t WS_WOA = 205 * MiB, WS_WOB = 213 * MiB;
constexpr size_t WS_Y0 = 221 * MiB;
constexpr size_t WS_SSQ0 = 253 * MiB, WS_SSQ1 = 254 * MiB, WS_RSTD0 = 255 * MiB;
constexpr size_t WS_END = 256 * MiB;
constexpr size_t DO_XHAT0 = 0;
constexpr size_t DO_KVB = 0;
constexpr size_t DO_GB = 48 * MiB;
constexpr size_t DO_KCMP = 52 * MiB, DO_VCMP = 53 * MiB;
constexpr int NWB = 11520;

struct Params { const float* in[16]; float* out; unsigned char* ws; };

__device__ __forceinline__ float bf2f(unsigned u16) { return __uint_as_float(u16 << 16); }
__device__ __forceinline__ float bflo(unsigned w) { return __uint_as_float(w << 16); }
__device__ __forceinline__ float bfhi(unsigned w) { return __uint_as_float(w & 0xffff0000u); }
__device__ __forceinline__ unsigned f2bf(float f) { unsigned u = __float_as_uint(f); return (u + 0x7fffu + ((u >> 16) & 1u)) >> 16; }
__device__ __forceinline__ unsigned pk2(float lo, float hi) { return f2bf(lo) | (f2bf(hi) << 16); }
__device__ __forceinline__ float wave_sum(float v) {
#pragma unroll
    for (int o = 32; o >= 1; o >>= 1) v += __shfl_xor(v, o);
    return v;
}
__device__ __forceinline__ float wave_max(float v) {
#pragma unroll
    for (int o = 32; o >= 1; o >>= 1) v = fmaxf(v, __shfl_xor(v, o));
    return v;
}
__device__ __forceinline__ int rel_bucket(int dist) {
    int n = dist > 0 ? dist : 0;
    if (n < 16) return n;
    int b = 16;
    b += (n >= 22); b += (n >= 30); b += (n >= 40); b += (n >= 54); b += (n >= 73); b += (n >= 99); b += (n >= 134); b += (n >= 182);
    b += (n >= 246); b += (n >= 332); b += (n >= 450); b += (n >= 609); b += (n >= 825); b += (n >= 1117); b += (n >= 1513);
    return b;
}
__device__ __forceinline__ float silu(float z) { return z / (1.f + __expf(-z)); }

__device__ __forceinline__ void transpose_item(const float* W, int ldw, int c0, int ncv, int k0, const float* g, bf16_t* WT, int K, int r0, LAS float* scr, int lane) {
#pragma unroll 8
    for (int i = 0; i < 32; ++i) {
        const int kk = 2 * i + (lane >> 5), c = c0 + (lane & 31);
        float v = (c < ncv) ? W[(size_t)(k0 + kk) * ldw + c] : 0.f;
        if (g) v *= g[k0 + kk];
        scr[kk * 33 + (lane & 31)] = v;
    }
    asm volatile("s_waitcnt lgkmcnt(0)" ::: "memory");
    const int c = lane & 7;
#pragma unroll
    for (int j = 0; j < 4; ++j) {
        const int n = (lane >> 3) + 8 * j; const LAS float* s = scr + (8 * c) * 33 + n;
        u32x4 o; o.x = pk2(s[0 * 33], s[1 * 33]); o.y = pk2(s[2 * 33], s[3 * 33]); o.z = pk2(s[4 * 33], s[5 * 33]); o.w = pk2(s[6 * 33], s[7 * 33]);
        *(u32x4*)(WT + (size_t)(r0 + n) * K + k0 + 8 * c) = o;
    }
    asm volatile("s_waitcnt lgkmcnt(0)" ::: "memory");
}
__device__ __forceinline__ void rms_row_bf16(const float* xrow, bf16_t* orow, int lane) {
    const float4* xr = (const float4*)xrow + lane;
    float4 v[8]; float ss = 0.f;
#pragma unroll
    for (int j = 0; j < 8; ++j) { v[j] = xr[64 * j]; ss += (v[j].x * v[j].x + v[j].y * v[j].y) + (v[j].z * v[j].z + v[j].w * v[j].w); }
    const float r = rsqrtf(wave_sum(ss) * (1.f / DM) + 1e-6f);
    uint2* o8 = (uint2*)orow + lane;
#pragma unroll
    for (int j = 0; j < 8; ++j) o8[64 * j] = make_uint2(pk2(v[j].x * r, v[j].y * r), pk2(v[j].z * r, v[j].w * r));
}

__device__ __forceinline__ float dot_row(const LAS float* qs, const bf16_t* krow) {
    const uint4* kp = (const uint4*)krow; float acc = 0.f;
#pragma unroll 4
    for (int i = 0; i < 16; ++i) {
        const uint4 w = kp[i]; const LAS float* q = qs + 8 * i;
        acc += q[0] * bflo(w.x) + q[1] * bfhi(w.x) + q[2] * bflo(w.y) + q[3] * bfhi(w.y) + q[4] * bflo(w.z) + q[5] * bfhi(w.z) + q[6] * bflo(w.w) + q[7] * bfhi(w.w);
    }
    return acc;
}
__device__ __forceinline__ void wave_chunk(const LAS float* qs, const bf16_t* Kb, const bf16_t* Vb, bool valid, int row, float bias,
                                           float& m, float& l, float& o0, float& o1, int lane) {
    float s = NEGF;
    if (valid) s = dot_row(qs, Kb + (size_t)row * HD) * ATT_SCALE + bias;
    const float cm = wave_max(s);
    const float mn = fmaxf(m, cm);
    const float p = valid ? __expf(s - mn) : 0.f;
    const float alpha = __expf(m - mn);
    l = l * alpha + wave_sum(p);
    o0 *= alpha; o1 *= alpha; m = mn;
    const float pb = bf2f(f2bf(p));
    const unsigned long long act = __ballot(pb != 0.f);
    for (int j = 0; j < 64; ++j) {
        if (!((act >> j) & 1ull)) continue;
        const float pj = __shfl(pb, j); const int rj = __shfl(row, j);
        const unsigned w = ((const unsigned*)(Vb + (size_t)rj * HD))[lane];
        o0 += pj * bflo(w); o1 += pj * bfhi(w);
    }
}
__device__ __forceinline__ void load_q(LAS float* qs, const bf16_t* qrow, int lane) {
    const unsigned w = ((const unsigned*)qrow)[lane];
    qs[2 * lane] = bflo(w); qs[2 * lane + 1] = bfhi(w);
    asm volatile("s_waitcnt lgkmcnt(0)" ::: "memory");
}

constexpr int NWAVES = 8, NTHREADS = 512;
constexpr int LDS_BYTES = 147456;

__global__ void __launch_bounds__(NTHREADS, 2) yoco_fwd(Params p) {
    extern __shared__ __attribute__((aligned(16))) unsigned char lds_raw[];
    LAS unsigned char* lds = (LAS unsigned char*)lds_raw;
    cg::grid_group grid = cg::this_grid();
    const int tid = threadIdx.x, lane = tid & 63, wave = __builtin_amdgcn_readfirstlane(tid >> 6);
    const int G = gridDim.x, gw = blockIdx.x * NWAVES + wave, NGW = G * NWAVES;
    unsigned char* ws = p.ws; unsigned char* dob = (unsigned char*)p.out;
    const float* x = p.in[0]; const float* norm_pre = p.in[1]; const float* norm_post = p.in[2]; const float* table = p.in[3];
    const float* w_in_a = p.in[4]; const float* w_out_a = p.in[5]; const float* kv_norm = p.in[6]; const float* w_kv = p.in[7];
    const float* pos_k = p.in[8]; const float* pos_v = p.in[9]; const float* w1k = p.in[10]; const float* w2k = p.in[11];
    const float* w1v = p.in[12]; const float* w2v = p.in[13]; const float* w_in_b = p.in[14]; const float* w_out_b = p.in[15];
    bf16_t* WA_t = (bf16_t*)(ws + WS_B); bf16_t* WoA_t = (bf16_t*)(ws + WS_WOA); bf16_t* WB_t = (bf16_t*)(ws + WS_WB); bf16_t* WoB_t = (bf16_t*)(ws + WS_WOB);
    bf16_t* xhat0 = (bf16_t*)(dob + DO_XHAT0);
    bf16_t* qkvA = (bf16_t*)(ws + WS_QKVA); bf16_t* zA = (bf16_t*)(ws + WS_ZA); bf16_t* a0 = (bf16_t*)(ws + WS_B);
    bf16_t* y0b = (bf16_t*)(ws + WS_Y0); float* ssq0 = (float*)(ws + WS_SSQ0); float* ssq1 = (float*)(ws + WS_SSQ1); float* rstd0 = (float*)(ws + WS_RSTD0);
    bf16_t* xhat1 = (bf16_t*)(ws + WS_B); bf16_t* qB = (bf16_t*)(ws + WS_QB); bf16_t* zB = (bf16_t*)(ws + WS_ZB);
    bf16_t* kvb = (bf16_t*)(dob + DO_KVB); bf16_t* gB = (bf16_t*)(dob + DO_GB); float* kcmp = (float*)(dob + DO_KCMP); float* vcmp = (float*)(dob + DO_VCMP);
    bf16_t* a1 = (bf16_t*)(ws + WS_B); bf16_t* y1b = (bf16_t*)(ws + WS_Y1);

    {
        LAS float* scr = (LAS float*)(lds + wave * 16384);
        constexpr int I_A = 32 * 256, I_OA = 32 * 64, I_B = 32 * (NWB / 32), I_OB = 32 * 64;
        constexpr int NIT = I_A + I_OA + I_B + I_OB;
        for (int it = gw; it < NIT; it += NGW) {
            int r = it;
            if (r < I_A) { const int kb = r / 256, nb = r % 256; transpose_item(w_in_a, 8192, nb * 32, 8192, kb * 64, norm_pre, WA_t, DM, nb * 32, scr, lane); continue; } r -= I_A;
            if (r < I_OA) { const int kb = r / 64, nb = r % 64; transpose_item(w_out_a, 2048, nb * 32, 2048, kb * 64, nullptr, WoA_t, DM, nb * 32, scr, lane); continue; } r -= I_OA;
            if (r < I_B) { const int kb = r / (NWB / 32), nb = r % (NWB / 32); const int n0 = nb * 32;
                if (n0 < 8192) transpose_item(w_in_b, 8240, n0, 8240, kb * 64, norm_pre + DM, WB_t, DM, n0, scr, lane);
                else if (n0 < 11264) transpose_item(w_kv, 3072, n0 - 8192, 3072, kb * 64, kv_norm, WB_t, DM, n0, scr, lane);
                else transpose_item(w_in_b, 8240, 8192 + (n0 - 11264), 8240, kb * 64, norm_pre + DM, WB_t, DM, n0, scr, lane);
                continue; } r -= I_B;
            { const int kb = r / 64, nb = r % 64; transpose_item(w_out_b, 2048, nb * 32, 2048, kb * 64, nullptr, WoB_t, DM, nb * 32, scr, lane); }
        }
        for (int m = gw; m < MTOK; m += NGW) rms_row_bf16(x + (size_t)m * DM, xhat0 + (size_t)m * DM, lane);
    }
    grid.sync();
    {
        pg8::Gemm g{xhat0, WA_t, MTOK, 8192, DM}; pg8::StaticOrder S; S.init(MTOK, 8192, G, (int)blockIdx.x);
        pg8::EpiK<1> E{qkvA, zA};
        pg8::gemm_phase<pg8::EpiK<1>, pg8::StaticOrder, true, true>(lds, g, S, E);
    }
    grid.sync();
    {
        LAS float* qs = (LAS float*)(lds + wave * 4096);
        for (int it = gw; it < MTOK * NH; it += NGW) {
            const int h = it & 15, row = it >> 4, b = row >> 11, t = row & 2047;
            load_q(qs, qkvA + ((size_t)h * MTOK + row) * HD, lane);
            const bf16_t* Kb = qkvA + ((size_t)(16 + h) * MTOK + b * SEQ) * HD; const bf16_t* Vb = qkvA + ((size_t)(32 + h) * MTOK + b * SEQ) * HD;
            float M[3], L[3], O0[3], O1[3];
#pragma unroll
            for (int pp = 0; pp < 3; ++pp) {
                const int d = (pp == 0) ? 1 : (pp == 1 ? 4 : 16); const int li = t / d;
                float m = NEGF, l = 0.f, o0 = 0.f, o1 = 0.f;
                for (int c = 0; c < 3; ++c) {
                    const int delta = c * 64 + lane; const bool valid = (delta <= 128) && (li - delta >= 0);
                    const int krow = valid ? (t - delta * d) : 0; const float bias = table[rel_bucket(delta * d) * NH + h];
                    wave_chunk(qs, Kb, Vb, valid, krow, bias, m, l, o0, o1, lane);
                }
                M[pp] = m; L[pp] = l; O0[pp] = o0; O1[pp] = o1;
            }
            float lse[3], mx = NEGF;
#pragma unroll
            for (int pp = 0; pp < 3; ++pp) { lse[pp] = M[pp] + __logf(L[pp]); mx = fmaxf(mx, lse[pp]); }
            float w[3], wsum = 0.f;
#pragma unroll
            for (int pp = 0; pp < 3; ++pp) { w[pp] = __expf(lse[pp] - mx); wsum += w[pp]; }
            float r0 = 0.f, r1 = 0.f;
#pragma unroll
            for (int pp = 0; pp < 3; ++pp) { const float a = w[pp] / wsum / L[pp]; r0 += a * O0[pp]; r1 += a * O1[pp]; }
            const unsigned zw = ((const unsigned*)(zA + (size_t)row * DM + h * HD))[lane];
            ((unsigned*)(a0 + (size_t)row * DM + h * HD))[lane] = pk2(r0 * silu(bflo(zw)), r1 * silu(bfhi(zw)));
        }
    }
    grid.sync();
    {
        pg8::Gemm g{a0, WoA_t, MTOK, DM, DM}; pg8::StaticOrder S; S.init(MTOK, DM, G, (int)blockIdx.x);
        pg8::EpiK<2> E{y0b, (bf16_t*)ssq0};
        pg8::gemm_phase<pg8::EpiK<2>, pg8::StaticOrder, true, true>(lds, g, S, E);
    }
    grid.sync();
    for (int m = gw; m < MTOK; m += NGW) {
        float sp = (lane < 32) ? ssq0[(size_t)m * 32 + lane] : 0.f;
        const float r0 = rsqrtf(wave_sum(sp) * (1.f / DM) + 1e-6f);
        if (lane == 0) rstd0[m] = r0;
        const float4* xr = (const float4*)(x + (size_t)m * DM) + lane; const uint2* yr = (const uint2*)(y0b + (size_t)m * DM) + lane; const float4* gr = (const float4*)norm_post + lane;
        float4 hv[8]; float ss = 0.f;
#pragma unroll
        for (int j = 0; j < 8; ++j) {
            const float4 xv = xr[64 * j]; const uint2 yv = yr[64 * j]; const float4 gv = gr[64 * j];
            hv[j].x = xv.x + bflo(yv.x) * r0 * gv.x; hv[j].y = xv.y + bfhi(yv.x) * r0 * gv.y; hv[j].z = xv.z + bflo(yv.y) * r0 * gv.z; hv[j].w = xv.w + bfhi(yv.y) * r0 * gv.w;
            ss += (hv[j].x * hv[j].x + hv[j].y * hv[j].y) + (hv[j].z * hv[j].z + hv[j].w * hv[j].w);
        }
        const float rh = rsqrtf(wave_sum(ss) * (1.f / DM) + 1e-6f);
        uint2* o8 = (uint2*)(xhat1 + (size_t)m * DM) + lane;
#pragma unroll
        for (int j = 0; j < 8; ++j) o8[64 * j] = make_uint2(pk2(hv[j].x * rh, hv[j].y * rh), pk2(hv[j].z * rh, hv[j].w * rh));
    }
    grid.sync();
    {
        pg8::Gemm g{xhat1, WB_t, MTOK, NWB, DM}; pg8::StaticOrder S; S.init(MTOK, NWB, G, (int)blockIdx.x);
        pg8::EpiK<3> E{qB, kvb};
        pg8::gemm_phase<pg8::EpiK<3>, pg8::StaticOrder, true, true>(lds, g, S, E);
    }
    grid.sync();
    {
        LAS float* fl = (LAS float*)(lds + wave * 16384);
        LAS float* hid = (LAS float*)(lds + 131072 + wave * 1024);
        for (int it = gw; it < 2 * 16 * 128; it += NGW) {
            const int c = it & 127, bg = (it >> 7) & 15, kvsel = it >> 11, b = bg >> 2, gq = bg & 3;
            float* dst = (kvsel ? vcmp : kcmp) + ((size_t)bg * 128 + c) * HD;
            if (c == 127) { dst[lane] = 0.f; dst[lane + 64] = 0.f; continue; }
            const bf16_t* src = kvb + ((size_t)(kvsel * 4 + gq) * MTOK + b * SEQ + 16 * c) * HD;
            const float* pos = kvsel ? pos_v : pos_k; const float* w1 = kvsel ? w1v : w1k; const float* w2 = kvsel ? w2v : w2k;
            for (int i = lane; i < 2048; i += 64) { const unsigned w = ((const unsigned*)src)[i]; fl[2 * i] = bf2f(f2bf(bflo(w) + pos[2 * i])); fl[2 * i + 1] = bf2f(f2bf(bfhi(w) + pos[2 * i + 1])); }
            asm volatile("s_waitcnt lgkmcnt(0)" ::: "memory");
            float a[4] = {0.f, 0.f, 0.f, 0.f};
            for (int k = 0; k < 4096; ++k) { const float f = fl[k]; const float4 wv = *(const float4*)(w1 + (size_t)k * 256 + 4 * lane);
                a[0] += f * bf2f(f2bf(wv.x)); a[1] += f * bf2f(f2bf(wv.y)); a[2] += f * bf2f(f2bf(wv.z)); a[3] += f * bf2f(f2bf(wv.w)); }
#pragma unroll
            for (int j = 0; j < 4; ++j) { const float v = a[j]; const float u = 0.7978845608028654f * (v + 0.044715f * v * v * v); hid[4 * lane + j] = bf2f(f2bf(0.5f * v * (1.f + tanhf(u)))); }
            asm volatile("s_waitcnt lgkmcnt(0)" ::: "memory");
            float o0 = 0.f, o1 = 0.f;
            for (int k = 0; k < 256; ++k) { const float hv = hid[k]; o0 += hv * bf2f(f2bf(w2[(size_t)k * HD + lane])); o1 += hv * bf2f(f2bf(w2[(size_t)k * HD + lane + 64])); }
            dst[lane] = o0; dst[lane + 64] = o1;
            asm volatile("s_waitcnt lgkmcnt(0)" ::: "memory");
        }
    }
    grid.sync();
    {
        LAS float* qs = (LAS float*)(lds + wave * 4096);
        LAS float* pcs = qs + 128;
        LAS float* ocs = qs + 256;
        LAS float* pcsum = qs + 768;
        for (int it = gw; it < MTOK * 4; it += NGW) {
            const int gq = it & 3, row = it >> 2, b = row >> 11, t = row & 2047, bg = b * 4 + gq;
            const float* Kc = kcmp + (size_t)bg * 128 * HD; const float* Vc = vcmp + (size_t)bg * 128 * HD;
            pcsum[lane] = 0.f; pcsum[lane + 64] = 0.f;
            for (int j = 0; j < 4; ++j) {
                const int h = gq * 4 + j;
                load_q(qs, qB + ((size_t)h * MTOK + row) * HD, lane);
                float s[2]; bool val[2];
#pragma unroll
                for (int cc = 0; cc < 2; ++cc) {
                    const int c = cc * 64 + lane; const int dist = t - (c * 16 + 31);
                    val[cc] = (c < NCMP) && (dist >= 0); s[cc] = NEGF;
                    if (val[cc]) { const float* kr = Kc + (size_t)c * HD; float acc = 0.f;
                        for (int i = 0; i < HD; ++i) acc += qs[i] * bf2f(f2bf(kr[i]));
                        s[cc] = acc * ATT_SCALE + table[rel_bucket(dist) * NH + h]; }
                }
                const float mx = wave_max(fmaxf(s[0], s[1]));
                float p0 = val[0] ? __expf(s[0] - mx) : 0.f, p1 = val[1] ? __expf(s[1] - mx) : 0.f;
                const float inv = 1.f / fmaxf(wave_sum(p0 + p1), 1e-30f);
                p0 *= inv; p1 *= inv;
                pcs[lane] = p0; pcs[lane + 64] = p1; pcsum[lane] += p0; pcsum[lane + 64] += p1;
                asm volatile("s_waitcnt lgkmcnt(0)" ::: "memory");
                float o0 = 0.f, o1 = 0.f;
                for (int c = 0; c < NCMP; ++c) { const float pc = pcs[c]; if (pc != 0.f) { const float pb = bf2f(f2bf(pc)); o0 += pb * bf2f(f2bf(Vc[(size_t)c * HD + 2 * lane])); o1 += pb * bf2f(f2bf(Vc[(size_t)c * HD + 2 * lane + 1])); } }
                ocs[j * 128 + 2 * lane] = o0; ocs[j * 128 + 2 * lane + 1] = o1;
                asm volatile("s_waitcnt lgkmcnt(0)" ::: "memory");
            }
            unsigned mask;
            {
                const int n = lane & 31; float a = 0.f;
                for (int c = 4 * n - 1; c <= 4 * n + 3; ++c) if (c >= 0 && c < NCMP) a += pcsum[c];
                const int cur = t >> 6; const bool forced = (n == 0) || (n == cur) || (n == cur - 1);
                const float myv = forced ? 1e9f : (n > cur ? -1e9f : a);
                int rank = 0;
#pragma unroll
                for (int m2 = 0; m2 < 32; ++m2) { const float ov = __shfl(myv, m2); rank += (ov > myv || (ov == myv && m2 < n)) ? 1 : 0; }
                mask = (unsigned)(__ballot((rank < 16) && (n <= cur)) & 0xffffffffull);
            }
            const bf16_t* Ks = kvb + ((size_t)(2 * 4 + gq) * MTOK + b * SEQ) * HD; const bf16_t* Vs = kvb + ((size_t)(3 * 4 + gq) * MTOK + b * SEQ) * HD;
            const bf16_t* Kw = kvb + ((size_t)(4 * 4 + gq) * MTOK + b * SEQ) * HD; const bf16_t* Vw = kvb + ((size_t)(5 * 4 + gq) * MTOK + b * SEQ) * HD;
            for (int j = 0; j < 4; ++j) {
                const int h = gq * 4 + j;
                load_q(qs, qB + ((size_t)h * MTOK + row) * HD, lane);
                float m = NEGF, l = 0.f, s0 = 0.f, s1 = 0.f;
                for (int n = 0; n < 32; ++n) {
                    if (!((mask >> n) & 1u)) continue;
                    const int key = n * 64 + lane, dist = t - key;
                    wave_chunk(qs, Ks, Vs, dist >= 0, key, table[rel_bucket(dist) * NH + h], m, l, s0, s1, lane);
                }
                s0 /= l; s1 /= l;
                float mw = NEGF, lw = 0.f, w0 = 0.f, w1_ = 0.f;
                for (int c = 0; c < 8; ++c) {
                    const int delta = c * 64 + lane, key = t - delta;
                    wave_chunk(qs, Kw, Vw, key >= 0, key >= 0 ? key : 0, table[rel_bucket(delta) * NH + h], mw, lw, w0, w1_, lane);
                }
                w0 /= lw; w1_ /= lw;
                const float c0 = ocs[j * 128 + 2 * lane], c1 = ocs[j * 128 + 2 * lane + 1];
                const bf16_t* gr = gB + (size_t)row * 256;
                const float gc = 1.f / (1.f + __expf(-bf2f(gr[h]))), gs = 1.f / (1.f + __expf(-bf2f(gr[16 + h]))), gwn = 1.f / (1.f + __expf(-bf2f(gr[32 + h])));
                const unsigned zc = ((const unsigned*)(zB + (size_t)row * 6144 + h * HD))[lane];
                const unsigned zs = ((const unsigned*)(zB + (size_t)row * 6144 + 2048 + h * HD))[lane];
                const unsigned zw = ((const unsigned*)(zB + (size_t)row * 6144 + 4096 + h * HD))[lane];
                const float y0 = gc * c0 * silu(bflo(zc)) + gs * s0 * silu(bflo(zs)) + gwn * w0 * silu(bflo(zw));
                const float y1 = gc * c1 * silu(bfhi(zc)) + gs * s1 * silu(bfhi(zs)) + gwn * w1_ * silu(bfhi(zw));
                ((unsigned*)(a1 + (size_t)row * DM + h * HD))[lane] = pk2(y0, y1);
            }
        }
    }
    grid.sync();
    {
        pg8::Gemm g{a1, WoB_t, MTOK, DM, DM}; pg8::StaticOrder S; S.init(MTOK, DM, G, (int)blockIdx.x);
        pg8::EpiK<2> E{y1b, (bf16_t*)ssq1};
        pg8::gemm_phase<pg8::EpiK<2>, pg8::StaticOrder, true, true>(lds, g, S, E);
    }
    grid.sync();
    for (int m = gw; m < MTOK; m += NGW) {
        float sp = (lane < 32) ? ssq1[(size_t)m * 32 + lane] : 0.f;
        const float r1 = rsqrtf(wave_sum(sp) * (1.f / DM) + 1e-6f), r0 = rstd0[m];
        const float4* xr = (const float4*)(x + (size_t)m * DM) + lane; const uint2* y0r = (const uint2*)(y0b + (size_t)m * DM) + lane; const uint2* y1r = (const uint2*)(y1b + (size_t)m * DM) + lane;
        const float4* g0r = (const float4*)norm_post + lane; const float4* g1r = (const float4*)(norm_post + DM) + lane;
        float4* orow = (float4*)(p.out + (size_t)m * DM) + lane;
#pragma unroll
        for (int j = 0; j < 8; ++j) {
            const float4 xv = xr[64 * j]; const uint2 a = y0r[64 * j], bb = y1r[64 * j]; const float4 g0 = g0r[64 * j], g1 = g1r[64 * j];
            float4 o;
            o.x = xv.x + bflo(a.x) * r0 * g0.x + bflo(bb.x) * r1 * g1.x; o.y = xv.y + bfhi(a.x) * r0 * g0.y + bfhi(bb.x) * r1 * g1.y;
            o.z = xv.z + bflo(a.y) * r0 * g0.z + bflo(bb.y) * r1 * g1.z; o.w = xv.w + bfhi(a.y) * r0 * g0.w + bfhi(bb.y) * r1 * g1.w;
            orow[64 * j] = o;
        }
    }
}

extern "C" void kernel_launch(void* const* d_in, const int* in_sizes, int n_in, void* d_out, int out_size, void* d_ws, size_t ws_size, hipStream_t stream) {
    static int grid = 0;
    if (grid == 0) {
        if (n_in != 16 || ws_size < WS_END) { fprintf(stderr, "kernel_launch: unexpected n_in %d / ws_size %zu\n", n_in, ws_size); grid = -1; return; }
        int dev = 0, cus = 0, per_cu = 0;
        (void)hipGetDevice(&dev); (void)hipDeviceGetAttribute(&cus, hipDeviceAttributeMultiprocessorCount, dev);
        if (hipFuncSetAttribute((const void*)yoco_fwd, hipFuncAttributeMaxDynamicSharedMemorySize, LDS_BYTES) != hipSuccess) { fprintf(stderr, "kernel_launch: hipFuncSetAttribute failed\n"); grid = -1; return; }
        if (hipOccupancyMaxActiveBlocksPerMultiprocessor(&per_cu, (const void*)yoco_fwd, NTHREADS, LDS_BYTES) != hipSuccess || per_cu < 1) { fprintf(stderr, "kernel_launch: occupancy query says %d\n", per_cu); per_cu = 1; }
        (void)hipGetLastError();
        grid = cus;
        if (grid != 256) fprintf(stderr, "kernel_launch: note: %d CUs\n", grid);
    }
    if (grid < 0) return;
    Params prm{};
    for (int i = 0; i < 16; ++i) prm.in[i] = (const float*)d_in[i];
    prm.out = (float*)d_out; prm.ws = (unsigned char*)d_ws;
    void* args[] = {&prm};
    hipError_t e = hipLaunchCooperativeKernel((const void*)yoco_fwd, dim3(grid), dim3(NTHREADS), args, LDS_BYTES, stream);
    if (e != hipSuccess) fprintf(stderr, "kernel_launch: cooperative launch failed: %s (grid %d)\n", hipGetErrorString(e), grid);
}
```

```cpp
#include <hip/hip_runtime.h>
#include <hip/hip_cooperative_groups.h>
#include <cstdio>
#include <cstdint>
namespace cg = cooperative_groups;

namespace pg8 {
#define PG8_LAS __attribute__((address_space(3)))
typedef unsigned short bf16_t;
typedef short bf16x8 __attribute__((ext_vector_type(8)));
typedef float f32x4 __attribute__((ext_vector_type(4)));
typedef unsigned u32x4 __attribute__((ext_vector_type(4)));
constexpr int BM = 256, BK = 64, HALF = 128, HTB = HALF * BK * 2  , STAGE_BYTES = 8 * HTB, NXCD = 8, WGM = 8;

__host__ __device__ __forceinline__ int lds_byte(int r, int c) { const int st = (r >> 4) * 2 + (c >> 5), rr = r & 15, cc = c & 31, ob = rr * 64 + cc * 2; return st * 1024 + (ob ^ (((ob >> 9) & 1) << 5)); }
__host__ __device__ __forceinline__ void stage_rc(int b, int& R, int& C) { const int st = b / 1024, sb = b % 1024, swz = sb ^ (((sb >> 9) & 1) << 5); R = (st >> 1) * 16 + swz / 64; C = (st & 1) * 32 + (swz % 64) / 2; }
__host__ __device__ __forceinline__ int perm32(int rho) { const int n = rho >> 4, i = rho & 15; return 8 * (i >> 2) + 4 * n + (i & 3); }

struct Unit { int pm, pn; };
struct Gemm { const bf16_t* A; const bf16_t* Bt; int M, N, K; };

struct StaticOrder {
    int nM, nN, nwg, G, c;
    __host__ __device__ void init(int M, int N, int G_, int c_) { nM = M / BM; nN = N / BM; nwg = nM * nN; G = G_; c = c_; }
    __host__ __device__ bool next(int i, Unit& u) const {
        const long L = (long)i * G + c; if (L >= nwg) return false;
        int wgid = (int)L; { const int q = nwg / NXCD, r = nwg % NXCD, xcd = wgid % NXCD, off = wgid / NXCD; wgid = (xcd < r ? xcd * (q + 1) : r * (q + 1) + (xcd - r) * q) + off; }
        const int nig = WGM * nN, gid = wgid / nig, fm = gid * WGM, gsz = (nM - fm) < WGM ? (nM - fm) : WGM;
        u.pm = fm + ((wgid % nig) % gsz); u.pn = (wgid % nig) / gsz; return true;
    }
    __device__ __forceinline__ void a_ready(const Unit&) const {}
    __device__ __forceinline__ void done(const Unit&) const {}
};

__device__ __forceinline__ unsigned cvt_pk_bf16(float lo, float hi) { unsigned r; asm volatile("v_cvt_pk_bf16_f32 %0, %1, %2" : "=v"(r) : "v"(lo), "v"(hi)); return r; }
typedef float f32x2 __attribute__((ext_vector_type(2)));

template <int KIND> struct EpiK {
    static constexpr bool PERM = true, AFTER_DRAIN = false;
    bf16_t* b0; bf16_t* b1;
    __device__ __forceinline__ void operator()(const f32x4 (&acc)[2][2][4][2], const Unit& u, int wr, int wc, int fr, int fq) const {
        bf16_t* base; bool hm; int ld = 2048, pr = u.pn;
        if (KIND == 1) { if (u.pn < 24) { base = b0; hm = true; } else { base = b1; hm = false; pr = u.pn - 24; } }
        else if (KIND == 2) { base = b0; hm = false; }
        else { if (u.pn < 8) { base = b0; hm = true; } else if (u.pn < 32) { base = b0 + (size_t)16 * 1024 * 1024; hm = false; ld = 6144; pr = u.pn - 8; }
               else if (u.pn < 44) { base = b1; hm = true; pr = u.pn - 32; } else { base = b1 + (size_t)24 * 1024 * 1024; hm = false; ld = 256; pr = 0; } }
        const int row0 = u.pm * BM + wr * 64 + fr;
        const int cin = wc * 32 + 8 * fq;
#pragma unroll
        for (int ai = 0; ai < 2; ++ai)
#pragma unroll
            for (int m = 0; m < 4; ++m) {
                const int row = row0 + ai * HALF + m * 16;
                float s = 0.f;
#pragma unroll
                for (int bj = 0; bj < 2; ++bj) {
                    const f32x4 v0 = acc[ai][bj][m][0], v1 = acc[ai][bj][m][1];
                    if (KIND == 2) s += (v0[0] * v0[0] + v0[1] * v0[1]) + (v0[2] * v0[2] + v0[3] * v0[3]) + (v1[0] * v1[0] + v1[1] * v1[1]) + (v1[2] * v1[2] + v1[3] * v1[3]);
                    u32x4 w; w.x = cvt_pk_bf16(v0[0], v0[1]); w.y = cvt_pk_bf16(v0[2], v0[3]); w.z = cvt_pk_bf16(v1[0], v1[1]); w.w = cvt_pk_bf16(v1[2], v1[3]);
                    bf16_t* dst = hm ? base + ((size_t)(pr * 2 + bj) * 8192 + row) * 128 + cin
                                     : base + (size_t)row * ld + pr * 256 + bj * HALF + cin;
                    *(u32x4*)dst = w;
                }
                if (KIND == 2) { s += __shfl_xor(s, 16); s += __shfl_xor(s, 32); if (fq == 0) ((float*)b1)[(size_t)row * 32 + u.pn * 4 + wc] = s; }
            }
    }
};
template <class Epi, class Sched, bool ALIGN_EPI = false, bool SP2 = false>
__device__ __forceinline__ void gemm_phase(PG8_LAS unsigned char* lds, const Gemm g, const Sched& S, const Epi& E) {
    int tid_raw = threadIdx.x; asm volatile("" : "+v"(tid_raw));
    const int tid = tid_raw, wid = __builtin_amdgcn_readfirstlane(tid >> 6), lane = tid & 63, wr = wid >> 2, wc = wid & 3, fr = lane & 15, fq = lane >> 4;
    const int K = g.K, nt = K / BK;
    unsigned voffA[2], voffB[2];
#pragma unroll
    for (int i = 0; i < 2; ++i) { int R, C; stage_rc(tid * 16 + i * 8192, R, C); const int Rb = Epi::PERM ? ((R & ~31) + perm32(R & 31)) : R;
        voffA[i] = (unsigned)(R * K + C) * 2u; voffB[i] = (unsigned)(Rb * K + C) * 2u; }
    const size_t kstep = (size_t)(BK * 2);
    const size_t hstep = (size_t)HALF * K * 2;
    const size_t tstep = 2 * hstep;
    const unsigned ldsw = (unsigned)wid * 1024u;
    const int aoff = lds_byte(wr * 64 + fr, fq * 8), boff = lds_byte(wc * 32 + fr, fq * 8);
#define PG8_SA(b, h) (((b) * 2 + (h)) * HTB)
#define PG8_SB(b, h) ((4 + (b) * 2 + (h)) * HTB)
#define PG8_STAGE(bufoff, gbase, voff) do { _Pragma("unroll") for (int _i = 0; _i < 2; ++_i) \
        __builtin_amdgcn_global_load_lds((const unsigned*)((const char*)(gbase) + (voff)[_i]), (PG8_LAS unsigned*)(lds + (bufoff) + ldsw + _i * 8192), 16, 0, 0); } while (0)
#define PG8_LDA(dst, b, h) do { _Pragma("unroll") for (int m = 0; m < 4; ++m) _Pragma("unroll") for (int k = 0; k < 2; ++k) dst[m][k] = *(const PG8_LAS bf16x8*)(lds + PG8_SA(b, h) + aoff + m * 2048 + k * 1024); } while (0)
#define PG8_LDB(dst, b, h) do { _Pragma("unroll") for (int n = 0; n < 2; ++n) _Pragma("unroll") for (int k = 0; k < 2; ++k) dst[n][k] = *(const PG8_LAS bf16x8*)(lds + PG8_SB(b, h) + boff + n * 2048 + k * 1024); } while (0)
#define PG8_MMA(ai, bj, At, Bt) do { __builtin_amdgcn_s_setprio(1); _Pragma("unroll") for (int m = 0; m < 4; ++m) _Pragma("unroll") for (int n = 0; n < 2; ++n) _Pragma("unroll") for (int k = 0; k < 2; ++k) \
        acc[ai][bj][m][n] = __builtin_amdgcn_mfma_f32_16x16x32_bf16(Bt[n][k], At[m][k], acc[ai][bj][m][n], 0, 0, 0); __builtin_amdgcn_s_setprio(0); } while (0)
#define PG8_WAIT_V(n) asm volatile("s_waitcnt vmcnt(" #n ")" ::: "memory")
#define PG8_WAIT_L(n) asm volatile("s_waitcnt lgkmcnt(" #n ")" ::: "memory")
#define PG8_BAR __builtin_amdgcn_s_barrier()
#define PG8_SCHED __builtin_amdgcn_sched_barrier(0)
    Unit cur, nxt; int ui = 0;
    if (!S.next(0, cur)) return;
    f32x4 acc[2][2][4][2];
#pragma unroll
    for (int a = 0; a < 2; ++a)
#pragma unroll
        for (int b = 0; b < 2; ++b)
#pragma unroll
            for (int m = 0; m < 4; ++m)
#pragma unroll
                for (int n = 0; n < 2; ++n) acc[a][b][m][n] = (f32x4){0.f, 0.f, 0.f, 0.f};
    bf16x8 At[4][2], B0[2][2], B1[2][2];
    const char* cA = (const char*)g.A + (size_t)cur.pm * tstep; const char* cB = (const char*)g.Bt + (size_t)cur.pn * tstep;
    S.a_ready(cur);
    if constexpr (SP2) {
        PG8_STAGE(PG8_SB(0, 0), cB, voffB); PG8_STAGE(PG8_SB(0, 1), cB + hstep, voffB); PG8_STAGE(PG8_SA(0, 0), cA, voffA); PG8_STAGE(PG8_SA(0, 1), cA + hstep, voffA);
        if (wr == 1) PG8_BAR;
        PG8_WAIT_V(2); PG8_BAR;
        PG8_STAGE(PG8_SB(1, 0), cB + kstep, voffB); PG8_STAGE(PG8_SA(1, 0), cA + kstep, voffA); PG8_STAGE(PG8_SB(1, 1), cB + hstep + kstep, voffB);
        PG8_WAIT_V(6); PG8_BAR;
    } else {
        PG8_STAGE(PG8_SB(0, 0), cB, voffB); PG8_STAGE(PG8_SA(0, 0), cA, voffA); PG8_STAGE(PG8_SB(0, 1), cB + hstep, voffB); PG8_STAGE(PG8_SA(0, 1), cA + hstep, voffA);
        if (wr == 1) PG8_BAR;
        PG8_WAIT_V(4); PG8_BAR;
        PG8_STAGE(PG8_SB(1, 0), cB + kstep, voffB); PG8_STAGE(PG8_SA(1, 0), cA + kstep, voffA); PG8_STAGE(PG8_SB(1, 1), cB + hstep + kstep, voffB);
        PG8_WAIT_V(6); PG8_BAR;
    }
    for (;;) {
        const bool has_next = S.next(ui + 1, nxt);
        const char* nA = has_next ? (const char*)g.A + (size_t)nxt.pm * tstep : cA; const char* nB = has_next ? (const char*)g.Bt + (size_t)nxt.pn * tstep : cB;
        for (int t = 0; t < nt; t += 2) {
            const bool last = (t == nt - 2);
            const char* a1 = cA + (size_t)(t + 1) * kstep;
            const char* a2 = last ? nA : cA + (size_t)(t + 2) * kstep; const char* b2 = last ? nB : cB + (size_t)(t + 2) * kstep;
            const char* a3 = a2 + kstep; const char* b3 = b2 + kstep;
            if (last && has_next) S.a_ready(nxt);
            if constexpr (SP2) {
            PG8_LDB(B0, 0, 0); PG8_LDB(B1, 0, 1); PG8_SCHED; PG8_LDA(At, 0, 0); PG8_STAGE(PG8_SA(1, 1), a1 + hstep, voffA);
            PG8_WAIT_V(8); PG8_WAIT_L(0); PG8_BAR; PG8_MMA(0, 0, At, B0); PG8_MMA(0, 1, At, B1); PG8_BAR; PG8_SCHED;
            PG8_LDA(At, 0, 1); PG8_STAGE(PG8_SB(0, 0), b2, voffB); PG8_STAGE(PG8_SB(0, 1), b2 + hstep, voffB); PG8_STAGE(PG8_SA(0, 0), a2, voffA);
            PG8_WAIT_V(8); PG8_WAIT_L(0); PG8_BAR; PG8_MMA(1, 0, At, B0); PG8_MMA(1, 1, At, B1); PG8_BAR; PG8_SCHED;
            PG8_LDB(B0, 1, 0); PG8_LDB(B1, 1, 1); PG8_SCHED; PG8_LDA(At, 1, 0); PG8_STAGE(PG8_SA(0, 1), a2 + hstep, voffA);
            PG8_WAIT_V(8); PG8_WAIT_L(0); PG8_BAR; PG8_MMA(0, 0, At, B0); PG8_MMA(0, 1, At, B1); PG8_BAR; PG8_SCHED;
            PG8_LDA(At, 1, 1); PG8_STAGE(PG8_SB(1, 0), b3, voffB); PG8_STAGE(PG8_SB(1, 1), b3 + hstep, voffB); PG8_STAGE(PG8_SA(1, 0), a3, voffA);
            PG8_WAIT_V(8); PG8_WAIT_L(0); PG8_BAR; PG8_MMA(1, 0, At, B0); PG8_MMA(1, 1, At, B1); PG8_BAR; PG8_SCHED;
            } else {
            PG8_LDB(B0, 0, 0); PG8_SCHED; PG8_LDA(At, 0, 0); PG8_STAGE(PG8_SA(1, 1), a1 + hstep, voffA);
            PG8_WAIT_L(8); PG8_BAR; PG8_WAIT_L(0); PG8_MMA(0, 0, At, B0); PG8_BAR; PG8_SCHED;
            PG8_LDB(B1, 0, 1); PG8_STAGE(PG8_SB(0, 0), b2, voffB);
            PG8_BAR; PG8_WAIT_L(0); PG8_MMA(0, 1, At, B1); PG8_BAR;
            PG8_LDA(At, 0, 1); PG8_STAGE(PG8_SA(0, 0), a2, voffA);
            PG8_BAR; PG8_WAIT_L(0); PG8_MMA(1, 0, At, B0); PG8_BAR; PG8_SCHED;
            PG8_STAGE(PG8_SB(0, 1), b2 + hstep, voffB);
            PG8_WAIT_V(6); PG8_BAR; PG8_MMA(1, 1, At, B1); PG8_BAR;
            PG8_LDB(B0, 1, 0); PG8_SCHED; PG8_LDA(At, 1, 0); PG8_STAGE(PG8_SA(0, 1), a2 + hstep, voffA);
            PG8_WAIT_L(8); PG8_BAR; PG8_WAIT_L(0); PG8_MMA(0, 0, At, B0); PG8_BAR; PG8_SCHED;
            PG8_LDB(B1, 1, 1); PG8_STAGE(PG8_SB(1, 0), b3, voffB);
            PG8_BAR; PG8_WAIT_L(0); PG8_MMA(0, 1, At, B1); PG8_BAR;
            PG8_LDA(At, 1, 1); PG8_STAGE(PG8_SA(1, 0), a3, voffA);
            PG8_BAR; PG8_WAIT_L(0); PG8_MMA(1, 0, At, B0); PG8_BAR; PG8_SCHED;
            PG8_STAGE(PG8_SB(1, 1), b3 + hstep, voffB);
            PG8_WAIT_V(6); PG8_BAR; PG8_MMA(1, 1, At, B1); PG8_BAR;
            }
        }
        if constexpr (ALIGN_EPI) { if (wr == 0) PG8_BAR; }
        if constexpr (!Epi::AFTER_DRAIN) { E(acc, cur, wr, wc, fr, fq); S.done(cur); }
        if (!has_next) break;
#pragma unroll
        for (int a = 0; a < 2; ++a)
#pragma unroll
            for (int b = 0; b < 2; ++b)
#pragma unroll
                for (int m = 0; m < 4; ++m)
#pragma unroll
                    for (int n = 0; n < 2; ++n) acc[a][b][m][n] = (f32x4){0.f, 0.f, 0.f, 0.f};
        cur = nxt; cA = nA; cB = nB; ++ui;
        if constexpr (ALIGN_EPI) { if (wr == 1) PG8_BAR; }
    }
    PG8_WAIT_V(0);
    if constexpr (!ALIGN_EPI) { if (wr == 0) PG8_BAR; }
    PG8_BAR;
    if constexpr (Epi::AFTER_DRAIN) { E.fused(acc, cur, wr, wc, fr, fq, lds, wid, lane); S.done(cur); }
#undef PG8_SA
#undef PG8_SB
#undef PG8_STAGE
#undef PG8_LDA
#undef PG8_LDB
#undef PG8_MMA
#undef PG8_WAIT_V
#undef PG8_WAIT_L
#undef PG8_BAR
#undef PG8_SCHED
}
}

#define LAS __attribute__((address_space(3)))
typedef unsigned short bf16_t;
typedef unsigned u32x4 __attribute__((ext_vector_type(4)));
constexpr int DM = 2048, NB = 4, SEQ = 2048, NH = 16, HD = 128, MTOK = NB * SEQ;
constexpr int NCMP = 127;
constexpr float ATT_SCALE = 0.08838834764831845f;
constexpr float NEGF = -1e30f;
constexpr size_t MiB = 1u << 20;
constexpr size_t WS_QKVA = 0, WS_ZA = 96 * MiB;
constexpr size_t WS_QB = 0, WS_ZB = 32 * MiB;
constexpr size_t WS_Y1 = 0;
constexpr size_t WS_B = 128 * MiB;
constexpr size_t WS_WB = 160 * MiB;
constexpr size_t WS_WOA = 205 * MiB, WS_WOB = 213 * MiB;
constexpr size_t WS_Y0 = 221 * MiB;
constexpr size_t WS_SSQ0 = 253 * MiB, WS_SSQ1 = 254 * MiB, WS_RSTD0 = 255 * MiB;
constexpr size_t WS_END = 256 * MiB;
constexpr size_t DO_XHAT0 = 0;
constexpr size_t DO_KVB = 0;
constexpr size_t DO_GB = 48 * MiB;
constexpr size_t DO_KCMP = 52 * MiB, DO_VCMP = 53 * MiB;
constexpr int NWB = 11520;

struct Params { const float* in[16]; float* out; unsigned char* ws; };

__device__ __forceinline__ float bf2f(unsigned u16) { return __uint_as_float(u16 << 16); }
__device__ __forceinline__ float bflo(unsigned w) { return __uint_as_float(w << 16); }
__device__ __forceinline__ float bfhi(unsigned w) { return __uint_as_float(w & 0xffff0000u); }
__device__ __forceinline__ unsigned f2bf(float f) { unsigned u = __float_as_uint(f); return (u + 0x7fffu + ((u >> 16) & 1u)) >> 16; }
__device__ __forceinline__ unsigned pk2(float lo, float hi) { return f2bf(lo) | (f2bf(hi) << 16); }
__device__ __forceinline__ float wave_sum(float v) {
#pragma unroll
    for (int o = 32; o >= 1; o >>= 1) v += __shfl_xor(v, o);
    return v;
}
__device__ __forceinline__ float wave_max(float v) {
#pragma unroll
    for (int o = 32; o >= 1; o >>= 1) v = fmaxf(v, __shfl_xor(v, o));
    return v;
}
__device__ __forceinline__ int rel_bucket(int dist) {
    int n = dist > 0 ? dist : 0;
    if (n < 16) return n;
    int b = 16;
    b += (n >= 22); b += (n >= 30); b += (n >= 40); b += (n >= 54); b += (n >= 73); b += (n >= 99); b += (n >= 134); b += (n >= 182);
    b += (n >= 246); b += (n >= 332); b += (n >= 450); b += (n >= 609); b += (n >= 825); b += (n >= 1117); b += (n >= 1513);
    return b;
}
__device__ __forceinline__ float silu(float z) { return z / (1.f + __expf(-z)); }

__device__ __forceinline__ void transpose_item(const float* W, int ldw, int c0, int ncv, int k0, const float* g, bf16_t* WT, int K, int r0, LAS float* scr, int lane) {
#pragma unroll 8
    for (int i = 0; i < 32; ++i) {
        const int kk = 2 * i + (lane >> 5), c = c0 + (lane & 31);
        float v = (c < ncv) ? W[(size_t)(k0 + kk) * ldw + c] : 0.f;
        if (g) v *= g[k0 + kk];
        scr[kk * 33 + (lane & 31)] = v;
    }
    asm volatile("s_waitcnt lgkmcnt(0)" ::: "memory");
    const int c = lane & 7;
#pragma unroll
    for (int j = 0; j < 4; ++j) {
        const int n = (lane >> 3) + 8 * j; const LAS float* s = scr + (8 * c) * 33 + n;
        u32x4 o; o.x = pk2(s[0 * 33], s[1 * 33]); o.y = pk2(s[2 * 33], s[3 * 33]); o.z = pk2(s[4 * 33], s[5 * 33]); o.w = pk2(s[6 * 33], s[7 * 33]);
        *(u32x4*)(WT + (size_t)(r0 + n) * K + k0 + 8 * c) = o;
    }
    asm volatile("s_waitcnt lgkmcnt(0)" ::: "memory");
}
__device__ __forceinline__ void rms_row_bf16(const float* xrow, bf16_t* orow, int lane) {
    const float4* xr = (const float4*)xrow + lane;
    float4 v[8]; float ss = 0.f;
#pragma unroll
    for (int j = 0; j < 8; ++j) { v[j] = xr[64 * j]; ss += (v[j].x * v[j].x + v[j].y * v[j].y) + (v[j].z * v[j].z + v[j].w * v[j].w); }
    const float r = rsqrtf(wave_sum(ss) * (1.f / DM) + 1e-6f);
    uint2* o8 = (uint2*)orow + lane;
#pragma unroll
    for (int j = 0; j < 8; ++j) o8[64 * j] = make_uint2(pk2(v[j].x * r, v[j].y * r), pk2(v[j].z * r, v[j].w * r));
}

__device__ __forceinline__ float dot_row(const LAS float* qs, const bf16_t* krow) {
    const uint4* kp = (const uint4*)krow; float acc = 0.f;
#pragma unroll 4
    for (int i = 0; i < 16; ++i) {
        const uint4 w = kp[i]; const LAS float* q = qs + 8 * i;
        acc += q[0] * bflo(w.x) + q[1] * bfhi(w.x) + q[2] * bflo(w.y) + q[3] * bfhi(w.y) + q[4] * bflo(w.z) + q[5] * bfhi(w.z) + q[6] * bflo(w.w) + q[7] * bfhi(w.w);
    }
    return acc;
}
__device__ __forceinline__ void wave_chunk(const LAS float* qs, const bf16_t* Kb, const bf16_t* Vb, bool valid, int row, float bias,
                                           float& m, float& l, float& o0, float& o1, int lane) {
    float s = NEGF;
    if (valid) s = dot_row(qs, Kb + (size_t)row * HD) * ATT_SCALE + bias;
    const float cm = wave_max(s);
    const float mn = fmaxf(m, cm);
    const float p = valid ? __expf(s - mn) : 0.f;
    const float alpha = __expf(m - mn);
    l = l * alpha + wave_sum(p);
    o0 *= alpha; o1 *= alpha; m = mn;
    const float pb = bf2f(f2bf(p));
    const unsigned long long act = __ballot(pb != 0.f);
    for (int j = 0; j < 64; ++j) {
        if (!((act >> j) & 1ull)) continue;
        const float pj = __shfl(pb, j); const int rj = __shfl(row, j);
        const unsigned w = ((const unsigned*)(Vb + (size_t)rj * HD))[lane];
        o0 += pj * bflo(w); o1 += pj * bfhi(w);
    }
}
__device__ __forceinline__ void load_q(LAS float* qs, const bf16_t* qrow, int lane) {
    const unsigned w = ((const unsigned*)qrow)[lane];
    qs[2 * lane] = bflo(w); qs[2 * lane + 1] = bfhi(w);
    asm volatile("s_waitcnt lgkmcnt(0)" ::: "memory");
}

namespace att {
typedef short bf16x8 __attribute__((ext_vector_type(8)));
typedef short s16x4 __attribute__((ext_vector_type(4)));
typedef float f32x16 __attribute__((ext_vector_type(16)));
typedef float f32x4 __attribute__((ext_vector_type(4)));
constexpr int SHM_V = 16384, SHM_K = 16384;
constexpr int L_V = 0, L_K = 32768, L_WS = 65536, L_TBL = 67584;
constexpr float SCALE = 0.08838834764831845f, THR = 8.f;
constexpr float C2 = 1.4426950408889634f * SCALE;
#define ATT_KSWZ(row, colB) ((row) * 256 + ((colB) ^ (((row) & 7) << 4)))
#define ATT_SBAR() __builtin_amdgcn_sched_barrier(0)
__device__ __forceinline__ int v_st(int k, int c) { const int kk = (k & ~0xC) | ((k & 4) << 1) | ((k & 8) >> 1); return ((kk >> 3) * 4 + (c >> 5)) * 512 + ((kk & 7) * 32 + (c & 31)) * 2; }
__device__ __forceinline__ int v_rd_base(int lane) { return ((lane & 3) << 3) | (((lane >> 2) & 3) << 6) | (((lane >> 4) & 1) << 5) | (((lane >> 5) & 1) << 8); }
constexpr int v_rd_off(int d0, int ks, int half) { return d0 * 512 + ks * 4096 + half * 2048; }
__device__ __forceinline__ int crow(int r, int hi) { return (r & 3) + 8 * (r >> 2) + 4 * hi; }
__device__ __forceinline__ unsigned cvtpk(float lo, float hi) { unsigned r; asm volatile("v_cvt_pk_bf16_f32 %0, %1, %2" : "=v"(r) : "v"(lo), "v"(hi)); return r; }

__device__ __forceinline__ void partialSM(f32x16& p0, f32x16& p1, float& m_reg, float& alpha) {
    float pmax = p0[0];
#pragma unroll
    for (int r = 1; r < 16; ++r) pmax = fmaxf(pmax, p0[r]);
#pragma unroll
    for (int r = 0; r < 16; ++r) pmax = fmaxf(pmax, p1[r]);
    { auto rr = __builtin_amdgcn_permlane32_swap(__float_as_uint(pmax), __float_as_uint(pmax), false, false);
      pmax = fmaxf(__uint_as_float(rr[0]), __uint_as_float(rr[1])); }
    float mn;
    if (__builtin_expect(__all((pmax - m_reg) * SCALE <= THR), 1)) { mn = m_reg; alpha = 1.f; }
    else { mn = fmaxf(m_reg, pmax); alpha = __builtin_amdgcn_exp2f((m_reg - mn) * C2); m_reg = mn; }
    const float mnL = -mn * C2;
#pragma unroll
    for (int r = 0; r < 16; ++r) p0[r] = fmaf(p0[r], C2, mnL);
#pragma unroll
    for (int r = 0; r < 16; ++r) p1[r] = fmaf(p1[r], C2, mnL);
#pragma unroll
    for (int r = 0; r < 16; ++r) p0[r] = __builtin_amdgcn_exp2f(p0[r]);
}
#define ATT_PK4(P, B_, OUT) do { unsigned a0 = att::cvtpk(P[B_+0], P[B_+1]), a1 = att::cvtpk(P[B_+2], P[B_+3]);                          \
        unsigned b0 = att::cvtpk(P[B_+4], P[B_+5]), b1 = att::cvtpk(P[B_+6], P[B_+7]);                                             \
        auto r0 = __builtin_amdgcn_permlane32_swap(a0, b0, false, false); auto r1 = __builtin_amdgcn_permlane32_swap(a1, b1, false, false); \
        u32x4 w = {r0[0], r1[0], r0[1], r1[1]}; OUT = __builtin_bit_cast(att::bf16x8, w); } while (0)
__device__ __forceinline__ void finishSM(f32x16& p0, f32x16& p1, float alpha, float& l_reg, bf16x8& pa0, bf16x8& pa1, bf16x8& pa2, bf16x8& pa3) {
#pragma unroll
    for (int r = 0; r < 16; ++r) p1[r] = __builtin_amdgcn_exp2f(p1[r]);
    float ps = 0;
#pragma unroll
    for (int r = 0; r < 16; ++r) ps += p0[r];
#pragma unroll
    for (int r = 0; r < 16; ++r) ps += p1[r];
    { auto rr = __builtin_amdgcn_permlane32_swap(__float_as_uint(ps), __float_as_uint(ps), false, false);
      ps = __uint_as_float(rr[0]) + __uint_as_float(rr[1]); }
    l_reg = l_reg * alpha + ps;
    ATT_PK4(p0, 0, pa0); ATT_PK4(p0, 8, pa1); ATT_PK4(p1, 0, pa2); ATT_PK4(p1, 8, pa3);
}
__device__ __forceinline__ void qkt(f32x16& p0, f32x16& p1, const LAS unsigned char* Kt, int r32, int hi, const bf16x8 (&qr)[8], const LAS float* tb) {
#pragma unroll
    for (int r = 0; r < 16; ++r) { p0[r] = tb[59 - ((r & 3) + 8 * (r >> 2))]; p1[r] = tb[27 - ((r & 3) + 8 * (r >> 2))]; }
    const LAS unsigned char* kb[4];
#pragma unroll
    for (int dd = 0; dd < 4; ++dd) kb[dd] = Kt + ATT_KSWZ(r32, (dd * 16 + hi * 8) * 2);
#pragma unroll
    for (int d0 = 0; d0 < 8; ++d0) { const LAS unsigned char* a = kb[d0 & 3] + (d0 >> 2) * 128;
        const bf16x8 b0 = *(const LAS bf16x8*)a;
        const bf16x8 b1 = *(const LAS bf16x8*)(a + 32 * 256);
        p0 = __builtin_amdgcn_mfma_f32_32x32x16_bf16(b0, qr[d0], p0, 0, 0, 0);
        p1 = __builtin_amdgcn_mfma_f32_32x32x16_bf16(b1, qr[d0], p1, 0, 0, 0); }
}
__device__ __forceinline__ void pv_tile(f32x16 (&o)[4], int vb, bf16x8 pa0, bf16x8 pa1, bf16x8 pa2, bf16x8 pa3) {
#define ATT_TRRD(dst, off) asm volatile("ds_read_b64_tr_b16 %0, %1 offset:%2" : "=&v"(dst) : "v"(vb), "i"(off) : "memory")
#define ATT_PV_D0(d0) do { s16x4 l0, l1, l2, l3, h0, h1, h2, h3; constexpr int b_ = v_rd_off(d0, 0, 0); \
        ATT_TRRD(l0, b_); ATT_TRRD(h0, b_ + 2048); ATT_TRRD(l1, b_ + 4096); ATT_TRRD(h1, b_ + 6144); ATT_TRRD(l2, b_ + 8192); ATT_TRRD(h2, b_ + 10240); ATT_TRRD(l3, b_ + 12288); ATT_TRRD(h3, b_ + 14336); \
        asm volatile("s_waitcnt lgkmcnt(0)" ::: "memory"); ATT_SBAR(); \
        o[d0] = __builtin_amdgcn_mfma_f32_32x32x16_bf16(pa0, (bf16x8){l0[0], l0[1], l0[2], l0[3], h0[0], h0[1], h0[2], h0[3]}, o[d0], 0, 0, 0); \
        o[d0] = __builtin_amdgcn_mfma_f32_32x32x16_bf16(pa1, (bf16x8){l1[0], l1[1], l1[2], l1[3], h1[0], h1[1], h1[2], h1[3]}, o[d0], 0, 0, 0); \
        o[d0] = __builtin_amdgcn_mfma_f32_32x32x16_bf16(pa2, (bf16x8){l2[0], l2[1], l2[2], l2[3], h2[0], h2[1], h2[2], h2[3]}, o[d0], 0, 0, 0); \
        o[d0] = __builtin_amdgcn_mfma_f32_32x32x16_bf16(pa3, (bf16x8){l3[0], l3[1], l3[2], l3[3], h3[0], h3[1], h3[2], h3[3]}, o[d0], 0, 0, 0); } while (0)
    ATT_PV_D0(0); ATT_PV_D0(1); ATT_PV_D0(2); ATT_PV_D0(3);
#undef ATT_PV_D0
#undef ATT_TRRD
}
template <class U>
__device__ __forceinline__ void flash_tiles(LAS unsigned char* lds, const U& u, const bf16x8 (&qr)[8], f32x16 (&o)[4], float& m_reg, float& l_reg, int tid, int lane, int wid) {
    const int r32 = lane & 31, hi = lane >> 5;
    const int sr = tid >> 4, sc = (tid & 15) * 8, vst0 = v_st(sr, sc), vst1 = v_st(32 + sr, sc), kws = ATT_KSWZ(sr, sc * 2);
    const int vb0 = L_V + v_rd_base(lane);
    LAS float* al_l = (LAS float*)(lds + L_WS) + wid * 64 + 32;
    const int NT = u.nt();
    bf16x8 sk0, sk1, sv0, sv1;
    if (NT > 0) { u.load(0, sr, sc, sk0, sk1, sv0, sv1);
        *(LAS bf16x8*)(lds + L_K + kws) = sk0; *(LAS bf16x8*)(lds + L_K + kws + 32 * 256) = sk1;
        *(LAS bf16x8*)(lds + L_V + vst0) = sv0; *(LAS bf16x8*)(lds + L_V + vst1) = sv1; }
    __syncthreads();
    for (int t = 0; t < NT; ++t) {
        const int buf = t & 1;
        if (t + 1 < NT) u.load(t + 1, sr, sc, sk0, sk1, sv0, sv1);
        if (u.act(t)) {
            f32x16 p0, p1; float alpha; bf16x8 pa0, pa1, pa2, pa3;
            qkt(p0, p1, lds + L_K + buf * SHM_K, r32, hi, qr, u.tbl(t));
            partialSM(p0, p1, m_reg, alpha);
            if (__any(alpha < 1.f)) { if (hi == 0) al_l[r32] = alpha; asm volatile("s_waitcnt lgkmcnt(0)" ::: "memory");
#pragma unroll
                for (int d_ = 0; d_ < 4; ++d_)
#pragma unroll
                    for (int r = 0; r < 16; ++r) o[d_][r] *= al_l[crow(r, hi)]; }
            finishSM(p0, p1, alpha, l_reg, pa0, pa1, pa2, pa3); ATT_SBAR();
            pv_tile(o, vb0 + buf * SHM_V, pa0, pa1, pa2, pa3);
        }
        if (t + 1 < NT) { const int nb = buf ^ 1;
            *(LAS bf16x8*)(lds + L_K + nb * SHM_K + kws) = sk0; *(LAS bf16x8*)(lds + L_K + nb * SHM_K + kws + 32 * 256) = sk1;
            *(LAS bf16x8*)(lds + L_V + nb * SHM_V + vst0) = sv0; *(LAS bf16x8*)(lds + L_V + nb * SHM_V + vst1) = sv1; }
        __syncthreads();
    }
}
template <class F>
__device__ __forceinline__ void emit(LAS unsigned char* lds, const f32x16 (&o)[4], float l_reg, int lane_in, int wid, const F& f) {
    int lane = lane_in; asm volatile("" : "+v"(lane));
    const int r32 = lane & 31, hi = lane >> 5;
    LAS float* li_l = (LAS float*)(lds + L_WS) + wid * 64;
    if (hi == 0) li_l[r32] = l_reg > 0.f ? 1.f / l_reg : 0.f;
    asm volatile("s_waitcnt lgkmcnt(0)" ::: "memory");
    float rli[16];
#pragma unroll
    for (int r = 0; r < 16; ++r) rli[r] = li_l[crow(r, hi)];
    LAS float* stg = (LAS float*)(lds + wid * 8192);
#pragma unroll
    for (int hf = 0; hf < 2; ++hf) {
#pragma unroll
        for (int r = 0; r < 16; ++r) { const int row = crow(r, hi);
            stg[row * 64 + r32] = o[2 * hf][r] * rli[r]; stg[row * 64 + 32 + r32] = o[2 * hf + 1][r] * rli[r]; }
        asm volatile("s_waitcnt lgkmcnt(0)" ::: "memory");
#pragma unroll
        for (int i = 0; i < 8; ++i) { const int idx = i * 64 + lane, row = idx >> 4, c4 = (idx & 15) * 4;
            const f32x4 v = *(const LAS f32x4*)(stg + row * 64 + c4); f(row, hf * 64 + c4, v); }
        asm volatile("s_waitcnt lgkmcnt(0)" ::: "memory");
    }
    __syncthreads();
}
}

struct DilU {
    const bf16_t* K; const bf16_t* V;
    int d, m16, lbase, res, jlo, ntl, lw0, wsel, lane_off;
    const LAS float* T;
    __device__ __forceinline__ int nt() const { return ntl; }
    __device__ __forceinline__ void tile(int t, int& lk0, int& rt, int& jj) const { const int j = jlo + t; jj = j; if (!m16) { lk0 = lbase + 64 * j; rt = res; } else { lk0 = 64 * (j & 1); rt = res + (j >> 1); } }
    __device__ __forceinline__ void load(int t, int sr, int sc, att::bf16x8& k0, att::bf16x8& k1, att::bf16x8& v0, att::bf16x8& v1) const {
        int lk0, rt, jj; tile(t, lk0, rt, jj);
        const size_t e0 = ((size_t)(lk0 + sr) * d + rt) * HD + sc, e1 = e0 + (size_t)32 * d * HD;
        k0 = *(const att::bf16x8*)(K + e0); k1 = *(const att::bf16x8*)(K + e1); v0 = *(const att::bf16x8*)(V + e0); v1 = *(const att::bf16x8*)(V + e1);
    }
    __device__ __forceinline__ bool act(int t) const { int lk0, rt, jj; tile(t, lk0, rt, jj);
        return m16 ? ((jj >> 1) == wsel && lk0 <= lw0 + 31) : (lk0 <= lw0 + 31 && lk0 + 63 >= lw0 - 128); }
    __device__ __forceinline__ const LAS float* tbl(int t) const { int lk0, rt, jj; tile(t, lk0, rt, jj); return T + (lw0 - lk0 + lane_off); }
};

constexpr int L_TSEL = att::L_TBL, L_TWIN = L_TSEL + 4 * 2112 * 4, L_IMPH = L_TWIN + 4 * 640 * 4, L_SELM = L_IMPH + 4 * 64 * 32 * 4, L_TL = L_SELM + 256;
static_assert(L_TL + 256 <= 155648, "LDS map");
struct SelU {
    const bf16_t* K; const bf16_t* V;
    const LAS int* tl; int ntl; unsigned mymask; int tq_off;
    const LAS float* T;
    __device__ __forceinline__ int nt() const { return ntl; }
    __device__ __forceinline__ void load(int t, int sr, int sc, att::bf16x8& k0, att::bf16x8& k1, att::bf16x8& v0, att::bf16x8& v1) const {
        const int n = __builtin_amdgcn_readfirstlane(tl[t]); const size_t e0 = (size_t)(64 * n + sr) * HD + sc, e1 = e0 + 32 * HD;
        k0 = *(const att::bf16x8*)(K + e0); k1 = *(const att::bf16x8*)(K + e1); v0 = *(const att::bf16x8*)(V + e0); v1 = *(const att::bf16x8*)(V + e1);
    }
    __device__ __forceinline__ bool act(int t) const { const int n = __builtin_amdgcn_readfirstlane(tl[t]); return __any((mymask >> n) & 1u); }
    __device__ __forceinline__ const LAS float* tbl(int t) const { const int n = __builtin_amdgcn_readfirstlane(tl[t]); return ((mymask >> n) & 1u) ? T + (tq_off - 64 * n) : T; }
};
struct WinU {
    const bf16_t* K; const bf16_t* V;
    int tk_base, ntl, tq_off;
    const LAS float* T;
    __device__ __forceinline__ int nt() const { return ntl; }
    __device__ __forceinline__ void load(int t, int sr, int sc, att::bf16x8& k0, att::bf16x8& k1, att::bf16x8& v0, att::bf16x8& v1) const {
        const size_t e0 = (size_t)(tk_base + 64 * t + sr) * HD + sc, e1 = e0 + 32 * HD;
        k0 = *(const att::bf16x8*)(K + e0); k1 = *(const att::bf16x8*)(K + e1); v0 = *(const att::bf16x8*)(V + e0); v1 = *(const att::bf16x8*)(V + e1);
    }
    __device__ __forceinline__ bool act(int) const { return true; }
    __device__ __forceinline__ const LAS float* tbl(int t) const { return T + (tq_off - tk_base - 64 * t); }
};
struct GateF {
    const bf16_t* zrow; const bf16_t* grow; bf16_t* arow;
    int first;
    __device__ __forceinline__ void operator()(int row, int col, att::f32x4 v) const {
        const float gt = 1.f / (1.f + __expf(-bf2f(grow[(size_t)row * 256])));
        const uint2 z = *(const uint2*)(zrow + (size_t)row * 6144 + col);
        float y0 = gt * v[0] * silu(bflo(z.x)), y1 = gt * v[1] * silu(bfhi(z.x)), y2 = gt * v[2] * silu(bflo(z.y)), y3 = gt * v[3] * silu(bfhi(z.y));
        uint2* ap = (uint2*)(arow + (size_t)row * DM + col);
        if (!first) { const uint2 a = *ap; y0 += bflo(a.x); y1 += bfhi(a.x); y2 += bflo(a.y); y3 += bfhi(a.y); }
        *ap = make_uint2(pg8::cvt_pk_bf16(y0, y1), pg8::cvt_pk_bf16(y2, y3));
    }
};

constexpr int NWAVES = 8, NTHREADS = 512;
constexpr int LDS_BYTES = 155648;

__global__ void __launch_bounds__(NTHREADS, 2) yoco_fwd(Params p) {
    extern __shared__ __attribute__((aligned(16))) unsigned char lds_raw[];
    LAS unsigned char* lds = (LAS unsigned char*)lds_raw;
    cg::grid_group grid = cg::this_grid();
    const int G = gridDim.x, NGW = G * NWAVES;
#define PHASE_VARS int tid = threadIdx.x; asm volatile("" : "+v"(tid)); const int lane = tid & 63, wave = __builtin_amdgcn_readfirstlane(tid >> 6), gw = blockIdx.x * NWAVES + wave; (void)lane; (void)gw;
    unsigned char* ws = p.ws; unsigned char* dob = (unsigned char*)p.out;
    const float* x = p.in[0]; const float* norm_pre = p.in[1]; const float* norm_post = p.in[2]; const float* table = p.in[3];
    const float* w_in_a = p.in[4]; const float* w_out_a = p.in[5]; const float* kv_norm = p.in[6]; const float* w_kv = p.in[7];
    const float* pos_k = p.in[8]; const float* pos_v = p.in[9]; const float* w1k = p.in[10]; const float* w2k = p.in[11];
    const float* w1v = p.in[12]; const float* w2v = p.in[13]; const float* w_in_b = p.in[14]; const float* w_out_b = p.in[15];
    bf16_t* WA_t = (bf16_t*)(ws + WS_B); bf16_t* WoA_t = (bf16_t*)(ws + WS_WOA); bf16_t* WB_t = (bf16_t*)(ws + WS_WB); bf16_t* WoB_t = (bf16_t*)(ws + WS_WOB);
    bf16_t* xhat0 = (bf16_t*)(dob + DO_XHAT0);
    bf16_t* qkvA = (bf16_t*)(ws + WS_QKVA); bf16_t* zA = (bf16_t*)(ws + WS_ZA); bf16_t* a0 = (bf16_t*)(ws + WS_B);
    bf16_t* y0b = (bf16_t*)(ws + WS_Y0); float* ssq0 = (float*)(ws + WS_SSQ0); float* ssq1 = (float*)(ws + WS_SSQ1); float* rstd0 = (float*)(ws + WS_RSTD0);
    bf16_t* xhat1 = (bf16_t*)(ws + WS_B); bf16_t* qB = (bf16_t*)(ws + WS_QB); bf16_t* zB = (bf16_t*)(ws + WS_ZB);
    bf16_t* kvb = (bf16_t*)(dob + DO_KVB); bf16_t* gB = (bf16_t*)(dob + DO_GB); bf16_t* kcmp = (bf16_t*)(dob + DO_KCMP); bf16_t* vcmp = (bf16_t*)(dob + DO_VCMP);
    bf16_t* a1 = (bf16_t*)(ws + WS_B); bf16_t* y1b = (bf16_t*)(ws + WS_Y1);

    {
        PHASE_VARS
        LAS float* scr = (LAS float*)(lds + wave * 16384);
        constexpr int I_A = 32 * 256, I_OA = 32 * 64, I_B = 32 * (NWB / 32), I_OB = 32 * 64;
        constexpr int NIT = I_A + I_OA + I_B + I_OB;
        for (int it = gw; it < NIT; it += NGW) {
            int r = it;
            if (r < I_A) { const int kb = r / 256, nb = r % 256; transpose_item(w_in_a, 8192, nb * 32, 8192, kb * 64, norm_pre, WA_t, DM, nb * 32, scr, lane); continue; } r -= I_A;
            if (r < I_OA) { const int kb = r / 64, nb = r % 64; transpose_item(w_out_a, 2048, nb * 32, 2048, kb * 64, nullptr, WoA_t, DM, nb * 32, scr, lane); continue; } r -= I_OA;
            if (r < I_B) { const int kb = r / (NWB / 32), nb = r % (NWB / 32); const int n0 = nb * 32;
                if (n0 < 8192) transpose_item(w_in_b, 8240, n0, 8240, kb * 64, norm_pre + DM, WB_t, DM, n0, scr, lane);
                else if (n0 < 11264) transpose_item(w_kv, 3072, n0 - 8192, 3072, kb * 64, kv_norm, WB_t, DM, n0, scr, lane);
                else transpose_item(w_in_b, 8240, 8192 + (n0 - 11264), 8240, kb * 64, norm_pre + DM, WB_t, DM, n0, scr, lane);
                continue; } r -= I_B;
            { const int kb = r / 64, nb = r % 64; transpose_item(w_out_b, 2048, nb * 32, 2048, kb * 64, nullptr, WoB_t, DM, nb * 32, scr, lane); }
        }
        for (int m = gw; m < MTOK; m += NGW) rms_row_bf16(x + (size_t)m * DM, xhat0 + (size_t)m * DM, lane);
    }
    grid.sync();
    {
        pg8::Gemm g{xhat0, WA_t, MTOK, 8192, DM}; pg8::StaticOrder S; S.init(MTOK, 8192, G, (int)blockIdx.x);
        pg8::EpiK<1> E{qkvA, zA};
        pg8::gemm_phase<pg8::EpiK<1>, pg8::StaticOrder, true, true>(lds, g, S, E);
    }
    grid.sync();
    {
        PHASE_VARS
        bf16_t* op0 = (bf16_t*)(ws + WS_B); bf16_t* op1 = (bf16_t*)(dob); bf16_t* op2 = (bf16_t*)(dob + 32 * MiB);
        float* lseb = (float*)(ws + WS_SSQ0);
        LAS float* T = (LAS float*)(lds + att::L_TBL);
        const int r32 = lane & 31, hi = lane >> 5;
        const int vcu = (G % 8 == 0) ? ((int)blockIdx.x % 8) * (G / 8) + (int)blockIdx.x / 8 : (int)blockIdx.x;
        constexpr int NU = 64 * 24; const int per = (NU + G - 1) / G;
        for (int ui = vcu * per; ui < (vcu + 1) * per && ui < NU; ++ui) {
            const int bh = ui / 24, kk = ui % 24, pat = kk >> 3, idx = kk & 7, b = bh >> 4, h = bh & 15;
            const int d = pat == 0 ? 1 : (pat == 1 ? 4 : 16);
            DilU U; U.d = d; U.m16 = (pat == 2); U.T = T; U.lane_off = r32 - 4 * hi + 37;
            int rw;
            if (pat == 2) { U.res = 2 * idx; U.lbase = 0; U.jlo = 0; U.ntl = 4; U.lw0 = 32 * (wave & 3); U.wsel = wave >> 2; rw = 2 * idx + (wave >> 2); }
            else { const int mm = (pat == 0) ? idx : (idx & 1); U.res = (pat == 0) ? 0 : (idx >> 1); U.lbase = 256 * mm - 128; U.jlo = (mm == 0) ? 2 : 0; U.ntl = 6 - U.jlo; U.lw0 = 256 * mm + 32 * wave; U.wsel = 0; rw = U.res; }
            U.K = qkvA + ((size_t)(16 + h) * MTOK + b * SEQ) * HD; U.V = qkvA + ((size_t)(32 + h) * MTOK + b * SEQ) * HD;
            if (tid < 320) { const int delta = tid - 96; T[tid] = (delta >= 0 && delta <= 128) ? table[rel_bucket(delta * d) * NH + h] * (1.f / ATT_SCALE) : -__builtin_inff(); }
            const int grow_l = b * SEQ + (U.lw0 + r32) * d + rw;
            att::bf16x8 qr[8];
            { const bf16_t* qp = qkvA + ((size_t)h * MTOK + grow_l) * HD + hi * 8;
#pragma unroll
              for (int d0 = 0; d0 < 8; ++d0) qr[d0] = *(const att::bf16x8*)(qp + d0 * 16); }
            att::f32x16 o[4];
#pragma unroll
            for (int d_ = 0; d_ < 4; ++d_)
#pragma unroll
                for (int r = 0; r < 16; ++r) o[d_][r] = 0.f;
            float m_reg = -1e30f, l_reg = 0.f;
            att::flash_tiles(lds, U, qr, o, m_reg, l_reg, tid, lane, wave);
            bf16_t* opp = (pat == 0 ? op0 : (pat == 1 ? op1 : op2)) + h * HD;
            if (hi == 0) lseb[((size_t)pat * MTOK + grow_l) * NH + h] = m_reg * ATT_SCALE + __logf(l_reg);
            const int rbase = b * SEQ + U.lw0 * d + rw;
            att::emit(lds, o, l_reg, lane, wave, [=](int row, int col, att::f32x4 v) {
                *(uint2*)(opp + (size_t)(rbase + row * d) * DM + col) = make_uint2(pg8::cvt_pk_bf16(v[0], v[1]), pg8::cvt_pk_bf16(v[2], v[3])); });
        }
    }
    grid.sync();
    {
        PHASE_VARS
        const bf16_t* op1 = (const bf16_t*)(dob); const bf16_t* op2 = (const bf16_t*)(dob + 32 * MiB);
        const float* lseb = (const float*)(ws + WS_SSQ0);
        for (int m = gw; m < MTOK; m += NGW) {
#pragma unroll
            for (int j = 0; j < 8; ++j) {
                const int col = (j * 64 + lane) * 4, h = col >> 7;
                const float l0 = lseb[((size_t)0 * MTOK + m) * NH + h], l1 = lseb[((size_t)1 * MTOK + m) * NH + h], l2 = lseb[((size_t)2 * MTOK + m) * NH + h];
                const float mx = fmaxf(l0, fmaxf(l1, l2));
                float w0 = __expf(l0 - mx), w1 = __expf(l1 - mx), w2 = __expf(l2 - mx); const float inv = 1.f / (w0 + w1 + w2); w0 *= inv; w1 *= inv; w2 *= inv;
                const uint2 a = *(const uint2*)(a0 + (size_t)m * DM + col), bq = *(const uint2*)(op1 + (size_t)m * DM + col), c = *(const uint2*)(op2 + (size_t)m * DM + col), z = *(const uint2*)(zA + (size_t)m * DM + col);
                const float r0 = (w0 * bflo(a.x) + w1 * bflo(bq.x) + w2 * bflo(c.x)) * silu(bflo(z.x)), r1 = (w0 * bfhi(a.x) + w1 * bfhi(bq.x) + w2 * bfhi(c.x)) * silu(bfhi(z.x));
                const float r2 = (w0 * bflo(a.y) + w1 * bflo(bq.y) + w2 * bflo(c.y)) * silu(bflo(z.y)), r3 = (w0 * bfhi(a.y) + w1 * bfhi(bq.y) + w2 * bfhi(c.y)) * silu(bfhi(z.y));
                *(uint2*)(a0 + (size_t)m * DM + col) = make_uint2(pk2(r0, r1), pk2(r2, r3));
            }
        }
    }
    grid.sync();
    {
        pg8::Gemm g{a0, WoA_t, MTOK, DM, DM}; pg8::StaticOrder S; S.init(MTOK, DM, G, (int)blockIdx.x);
        pg8::EpiK<2> E{y0b, (bf16_t*)ssq0};
        pg8::gemm_phase<pg8::EpiK<2>, pg8::StaticOrder, true, true>(lds, g, S, E);
    }
    grid.sync();
    { PHASE_VARS
    for (int m = gw; m < MTOK; m += NGW) {
        float sp = (lane < 32) ? ssq0[(size_t)m * 32 + lane] : 0.f;
        const float r0 = rsqrtf(wave_sum(sp) * (1.f / DM) + 1e-6f);
        if (lane == 0) rstd0[m] = r0;
        const float4* xr = (const float4*)(x + (size_t)m * DM) + lane; const uint2* yr = (const uint2*)(y0b + (size_t)m * DM) + lane; const float4* gr = (const float4*)norm_post + lane;
        float4 hv[8]; float ss = 0.f;
#pragma unroll
        for (int j = 0; j < 8; ++j) {
            const float4 xv = xr[64 * j]; const uint2 yv = yr[64 * j]; const float4 gv = gr[64 * j];
            hv[j].x = xv.x + bflo(yv.x) * r0 * gv.x; hv[j].y = xv.y + bfhi(yv.x) * r0 * gv.y; hv[j].z = xv.z + bflo(yv.y) * r0 * gv.z; hv[j].w = xv.w + bfhi(yv.y) * r0 * gv.w;
            ss += (hv[j].x * hv[j].x + hv[j].y * hv[j].y) + (hv[j].z * hv[j].z + hv[j].w * hv[j].w);
        }
        const float rh = rsqrtf(wave_sum(ss) * (1.f / DM) + 1e-6f);
        uint2* o8 = (uint2*)(xhat1 + (size_t)m * DM) + lane;
#pragma unroll
        for (int j = 0; j < 8; ++j) o8[64 * j] = make_uint2(pk2(hv[j].x * rh, hv[j].y * rh), pk2(hv[j].z * rh, hv[j].w * rh));
    } }
    grid.sync();
    {
        pg8::Gemm g{xhat1, WB_t, MTOK, NWB, DM}; pg8::StaticOrder S; S.init(MTOK, NWB, G, (int)blockIdx.x);
        pg8::EpiK<3> E{qB, kvb};
        pg8::gemm_phase<pg8::EpiK<3>, pg8::StaticOrder, true, true>(lds, g, S, E);
    }
    grid.sync();
    {
        PHASE_VARS
        LAS float* fl = (LAS float*)(lds + wave * 16384);
        LAS float* hid = (LAS float*)(lds + 131072 + wave * 1024);
        for (int it = gw; it < 2 * 16 * 128; it += NGW) {
            const int c = it & 127, bg = (it >> 7) & 15, kvsel = it >> 11, b = bg >> 2, gq = bg & 3;
            bf16_t* dst = (kvsel ? vcmp : kcmp) + ((size_t)bg * 128 + c) * HD;
            if (c == 127) { dst[lane] = 0; dst[lane + 64] = 0; continue; }
            const bf16_t* src = kvb + ((size_t)(kvsel * 4 + gq) * MTOK + b * SEQ + 16 * c) * HD;
            const float* pos = kvsel ? pos_v : pos_k; const float* w1 = kvsel ? w1v : w1k; const float* w2 = kvsel ? w2v : w2k;
            for (int i = lane; i < 2048; i += 64) { const unsigned w = ((const unsigned*)src)[i]; fl[2 * i] = bf2f(f2bf(bflo(w) + pos[2 * i])); fl[2 * i + 1] = bf2f(f2bf(bfhi(w) + pos[2 * i + 1])); }
            asm volatile("s_waitcnt lgkmcnt(0)" ::: "memory");
            float a[4] = {0.f, 0.f, 0.f, 0.f};
            for (int k = 0; k < 4096; ++k) { const float f = fl[k]; const float4 wv = *(const float4*)(w1 + (size_t)k * 256 + 4 * lane);
                a[0] += f * bf2f(f2bf(wv.x)); a[1] += f * bf2f(f2bf(wv.y)); a[2] += f * bf2f(f2bf(wv.z)); a[3] += f * bf2f(f2bf(wv.w)); }
#pragma unroll
            for (int j = 0; j < 4; ++j) { const float v = a[j]; const float u = 0.7978845608028654f * (v + 0.044715f * v * v * v); hid[4 * lane + j] = bf2f(f2bf(0.5f * v * (1.f + tanhf(u)))); }
            asm volatile("s_waitcnt lgkmcnt(0)" ::: "memory");
            float o0 = 0.f, o1 = 0.f;
            for (int k = 0; k < 256; ++k) { const float hv = hid[k]; o0 += hv * bf2f(f2bf(w2[(size_t)k * HD + lane])); o1 += hv * bf2f(f2bf(w2[(size_t)k * HD + lane + 64])); }
            dst[lane] = (bf16_t)f2bf(o0); dst[lane + 64] = (bf16_t)f2bf(o1);
            asm volatile("s_waitcnt lgkmcnt(0)" ::: "memory");
        }
    }
    grid.sync();
    {
        const int tid_ph = threadIdx.x; const int wave = __builtin_amdgcn_readfirstlane(tid_ph >> 6);
        const int jh = wave >> 1, sub = wave & 1;
        const int vcu = (G % 8 == 0) ? ((int)blockIdx.x % 8) * (G / 8) + (int)blockIdx.x / 8 : (int)blockIdx.x;
        LAS float* Tsel = (LAS float*)(lds + L_TSEL); LAS float* Twin = (LAS float*)(lds + L_TWIN);
        LAS float* impH = (LAS float*)(lds + L_IMPH);
        LAS unsigned* selm = (LAS unsigned*)(lds + L_SELM); LAS int* tl = (LAS int*)(lds + L_TL);
        const float NINF = -__builtin_inff();
        for (int pi = vcu; pi < 256; pi += G)
        for (int pass = 0; pass < 2; ++pass) {
            int tid = tid_ph; asm volatile("" : "+v"(tid));
            const int lane = tid & 63, r32 = lane & 31, hi = lane >> 5;
            const int bg = pi >> 4, qb = pass ? 31 - (pi & 15) : (pi & 15), b = bg >> 2, gq = bg & 3, h = gq * 4 + jh;
            const int tq = 64 * qb + 32 * sub + r32;
            const int grow0 = b * SEQ + 64 * qb + 32 * sub;
            for (int i = tid; i < 4 * 2112; i += NTHREADS) { const int hh = i / 2112, xx = i - hh * 2112, dist = xx - 64;
                Tsel[i] = dist >= 0 ? table[rel_bucket(dist) * NH + gq * 4 + hh] * (1.f / ATT_SCALE) : NINF; }
            for (int i = tid; i < 4 * 640; i += NTHREADS) { const int hh = i / 640, xx = i - hh * 640, delta = xx - 64;
                Twin[i] = (delta >= 0 && delta < 512) ? table[rel_bucket(delta) * NH + gq * 4 + hh] * (1.f / ATT_SCALE) : NINF; }
            const LAS float* Tsh = Tsel + jh * 2112; const LAS float* Twh = Twin + jh * 640;
            att::bf16x8 qr[8];
            { const bf16_t* qp = qB + ((size_t)h * MTOK + grow0 + r32) * HD + hi * 8;
#pragma unroll
              for (int d0 = 0; d0 < 8; ++d0) qr[d0] = *(const att::bf16x8*)(qp + d0 * 16); }
            att::f32x16 o[4];
            {
                const int sr = tid >> 4, sc = (tid & 15) * 8, vst0 = att::v_st(sr, sc), vst1 = att::v_st(32 + sr, sc), kws = ATT_KSWZ(sr, sc * 2);
                const bf16_t* Kc = kcmp + (size_t)bg * 128 * HD; const bf16_t* Vc = vcmp + (size_t)bg * 128 * HD;
#pragma unroll
                for (int tt = 0; tt < 2; ++tt) {
                    const size_t e0 = (size_t)(64 * tt + sr) * HD + sc, e1 = e0 + 32 * HD;
                    *(LAS att::bf16x8*)(lds + att::L_K + tt * att::SHM_K + kws) = *(const att::bf16x8*)(Kc + e0); *(LAS att::bf16x8*)(lds + att::L_K + tt * att::SHM_K + kws + 32 * 256) = *(const att::bf16x8*)(Kc + e1);
                    *(LAS att::bf16x8*)(lds + att::L_V + tt * att::SHM_V + vst0) = *(const att::bf16x8*)(Vc + e0); *(LAS att::bf16x8*)(lds + att::L_V + tt * att::SHM_V + vst1) = *(const att::bf16x8*)(Vc + e1);
                }
                __syncthreads();
                att::f32x16 pA0, pA1, pB0, pB1;
                const int xb = tq + 33 - 64 * hi;
#pragma unroll
                for (int r = 0; r < 16; ++r) { const int cr = 16 * ((r & 3) + 8 * (r >> 2));
                    pA0[r] = Tsh[max(xb - cr, 0)]; pA1[r] = Tsh[max(xb - cr - 512, 0)]; pB0[r] = Tsh[max(xb - cr - 1024, 0)]; pB1[r] = Tsh[max(xb - cr - 1536, 0)]; }
                {
                    const LAS unsigned char* kb[4];
#pragma unroll
                    for (int dd = 0; dd < 4; ++dd) kb[dd] = lds + att::L_K + ATT_KSWZ(r32, (dd * 16 + hi * 8) * 2);
#pragma unroll
                    for (int d0 = 0; d0 < 8; ++d0) { const LAS unsigned char* a = kb[d0 & 3] + (d0 >> 2) * 128;
                        pA0 = __builtin_amdgcn_mfma_f32_32x32x16_bf16(*(const LAS att::bf16x8*)a, qr[d0], pA0, 0, 0, 0);
                        pA1 = __builtin_amdgcn_mfma_f32_32x32x16_bf16(*(const LAS att::bf16x8*)(a + 32 * 256), qr[d0], pA1, 0, 0, 0);
                        pB0 = __builtin_amdgcn_mfma_f32_32x32x16_bf16(*(const LAS att::bf16x8*)(a + att::SHM_K), qr[d0], pB0, 0, 0, 0);
                        pB1 = __builtin_amdgcn_mfma_f32_32x32x16_bf16(*(const LAS att::bf16x8*)(a + att::SHM_K + 32 * 256), qr[d0], pB1, 0, 0, 0); }
                }
                float mx = NINF;
#pragma unroll
                for (int r = 0; r < 16; ++r) mx = fmaxf(fmaxf(mx, pA0[r]), fmaxf(fmaxf(pA1[r], pB0[r]), pB1[r]));
                { auto rr = __builtin_amdgcn_permlane32_swap(__float_as_uint(mx), __float_as_uint(mx), false, false); mx = fmaxf(__uint_as_float(rr[0]), __uint_as_float(rr[1])); }
                if (mx == NINF) mx = 0.f;
                const float mnL = -mx * att::C2; float ps = 0.f;
#pragma unroll
                for (int r = 0; r < 16; ++r) { pA0[r] = __builtin_amdgcn_exp2f(fmaf(pA0[r], att::C2, mnL)); pA1[r] = __builtin_amdgcn_exp2f(fmaf(pA1[r], att::C2, mnL));
                    pB0[r] = __builtin_amdgcn_exp2f(fmaf(pB0[r], att::C2, mnL)); pB1[r] = __builtin_amdgcn_exp2f(fmaf(pB1[r], att::C2, mnL)); ps += (pA0[r] + pA1[r]) + (pB0[r] + pB1[r]); }
                { auto rr = __builtin_amdgcn_permlane32_swap(__float_as_uint(ps), __float_as_uint(ps), false, false); ps = __uint_as_float(rr[0]) + __uint_as_float(rr[1]); }
                const float l_c = ps, inv = ps > 0.f ? 1.f / ps : 0.f;
                {
                    const int qrow = 32 * sub + r32; LAS float* ip = impH + (jh * 64 + qrow) * 32 + hi;
                    float eprev = 0.f;
#define IMP_GRP(P, U0) do { _Pragma("unroll") for (int q4 = 0; q4 < 4; ++q4) { \
                        const float gsum = ((P[4 * q4] + P[4 * q4 + 1]) + (P[4 * q4 + 2] + P[4 * q4 + 3])) * inv, e3 = P[4 * q4 + 3] * inv; \
                        const float eo = __uint_as_float(__builtin_amdgcn_permlane32_swap(__float_as_uint(e3), __float_as_uint(e3), false, false)[hi ? 0 : 1]);     \
                        const float ein = hi ? eo : eprev; eprev = eo; ip[2 * ((U0) + q4)] = gsum + ein; } } while (0)
                    IMP_GRP(pA0, 0); IMP_GRP(pA1, 4); IMP_GRP(pB0, 8); IMP_GRP(pB1, 12);
#undef IMP_GRP
                }
                att::bf16x8 pa0, pa1, pa2, pa3, pb0, pb1, pb2, pb3;
                ATT_PK4(pA0, 0, pa0); ATT_PK4(pA0, 8, pa1); ATT_PK4(pA1, 0, pa2); ATT_PK4(pA1, 8, pa3);
                ATT_PK4(pB0, 0, pb0); ATT_PK4(pB0, 8, pb1); ATT_PK4(pB1, 0, pb2); ATT_PK4(pB1, 8, pb3);
#pragma unroll
                for (int d_ = 0; d_ < 4; ++d_)
#pragma unroll
                    for (int r = 0; r < 16; ++r) o[d_][r] = 0.f;
                const int vb0 = att::L_V + att::v_rd_base(lane);
                att::pv_tile(o, vb0, pa0, pa1, pa2, pa3);
                att::pv_tile(o, vb0 + att::SHM_V, pb0, pb1, pb2, pb3);
                __syncthreads();
                GateF F{zB + (size_t)grow0 * 6144 + 0 * 2048 + h * HD, gB + (size_t)grow0 * 256 + 0 * 16 + h, a1 + (size_t)grow0 * DM + h * HD, 1};
                att::emit(lds, o, l_c, lane, wave, F);
                {
                    const int q = tid >> 3, n4 = (tid & 7) * 4, cur = qb;
                    float vals[32];
#pragma unroll
                    for (int i = 0; i < 8; ++i) {
                        att::f32x4 gv = *(const LAS att::f32x4*)(impH + (0 * 64 + q) * 32 + 4 * i);
                        gv += *(const LAS att::f32x4*)(impH + (1 * 64 + q) * 32 + 4 * i); gv += *(const LAS att::f32x4*)(impH + (2 * 64 + q) * 32 + 4 * i); gv += *(const LAS att::f32x4*)(impH + (3 * 64 + q) * 32 + 4 * i);
#pragma unroll
                        for (int e = 0; e < 4; ++e) { const int n = 4 * i + e; const bool forced = (n == 0) || (n == cur) || (n == cur - 1);
                            vals[n] = forced ? 1e9f : (n > cur ? -1e9f : gv[e]); } }
                    att::f32x4 mine = *(const LAS att::f32x4*)(impH + (0 * 64 + q) * 32 + n4);
                    mine += *(const LAS att::f32x4*)(impH + (1 * 64 + q) * 32 + n4); mine += *(const LAS att::f32x4*)(impH + (2 * 64 + q) * 32 + n4); mine += *(const LAS att::f32x4*)(impH + (3 * 64 + q) * 32 + n4);
                    unsigned bits = 0u;
#pragma unroll
                    for (int e = 0; e < 4; ++e) {
                        const int n = n4 + e; const bool forced = (n == 0) || (n == cur) || (n == cur - 1);
                        const float myv = forced ? 1e9f : (n > cur ? -1e9f : mine[e]);
                        int rank = 0;
#pragma unroll
                        for (int m2 = 0; m2 < 32; ++m2) rank += (vals[m2] > myv || (vals[m2] == myv && m2 < n)) ? 1 : 0;
                        if (rank < 16 && n <= cur) bits |= 1u << n;
                    }
                    bits |= __shfl_xor(bits, 1); bits |= __shfl_xor(bits, 2); bits |= __shfl_xor(bits, 4);
                    if ((tid & 7) == 0) selm[q] = bits;
                }
                __syncthreads();
                if (tid < 64) {
                    unsigned un = selm[lane];
#pragma unroll
                    for (int off = 1; off < 64; off <<= 1) un |= __shfl_xor(un, off);
                    if (lane < 32 && ((un >> lane) & 1u)) tl[__popc(un & ((1u << lane) - 1u))] = lane;
                    if (lane == 0) tl[32] = __popc(un);
                }
                __syncthreads();
            }
            {
                SelU U; U.K = kvb + ((size_t)(2 * 4 + gq) * MTOK + b * SEQ) * HD; U.V = kvb + ((size_t)(3 * 4 + gq) * MTOK + b * SEQ) * HD;
                U.tl = tl; U.ntl = __builtin_amdgcn_readfirstlane(tl[32]); U.mymask = selm[32 * sub + r32]; U.tq_off = tq - 4 * hi + 5; U.T = Tsh;
#pragma unroll
                for (int d_ = 0; d_ < 4; ++d_)
#pragma unroll
                    for (int r = 0; r < 16; ++r) o[d_][r] = 0.f;
                float m_reg = -1e30f, l_reg = 0.f;
                att::flash_tiles(lds, U, qr, o, m_reg, l_reg, tid, lane, wave);
                GateF F{zB + (size_t)grow0 * 6144 + 1 * 2048 + h * HD, gB + (size_t)grow0 * 256 + 1 * 16 + h, a1 + (size_t)grow0 * DM + h * HD, 0};
                att::emit(lds, o, l_reg, lane, wave, F);
            }
            {
                WinU U; U.K = kvb + ((size_t)(4 * 4 + gq) * MTOK + b * SEQ) * HD; U.V = kvb + ((size_t)(5 * 4 + gq) * MTOK + b * SEQ) * HD;
                const int jlo = qb < 8 ? 8 - qb : 0; U.tk_base = 64 * qb - 512 + 64 * jlo; U.ntl = 9 - jlo; U.tq_off = tq - 4 * hi + 5; U.T = Twh;
#pragma unroll
                for (int d_ = 0; d_ < 4; ++d_)
#pragma unroll
                    for (int r = 0; r < 16; ++r) o[d_][r] = 0.f;
                float m_reg = -1e30f, l_reg = 0.f;
                att::flash_tiles(lds, U, qr, o, m_reg, l_reg, tid, lane, wave);
                GateF F{zB + (size_t)grow0 * 6144 + 2 * 2048 + h * HD, gB + (size_t)grow0 * 256 + 2 * 16 + h, a1 + (size_t)grow0 * DM + h * HD, 0};
                att::emit(lds, o, l_reg, lane, wave, F);
            }
        }
    }
    grid.sync();
    {
        pg8::Gemm g{a1, WoB_t, MTOK, DM, DM}; pg8::StaticOrder S; S.init(MTOK, DM, G, (int)blockIdx.x);
        pg8::EpiK<2> E{y1b, (bf16_t*)ssq1};
        pg8::gemm_phase<pg8::EpiK<2>, pg8::StaticOrder, true, true>(lds, g, S, E);
    }
    grid.sync();
    { PHASE_VARS
    for (int m = gw; m < MTOK; m += NGW) {
        float sp = (lane < 32) ? ssq1[(size_t)m * 32 + lane] : 0.f;
        const float r1 = rsqrtf(wave_sum(sp) * (1.f / DM) + 1e-6f), r0 = rstd0[m];
        const float4* xr = (const float4*)(x + (size_t)m * DM) + lane; const uint2* y0r = (const uint2*)(y0b + (size_t)m * DM) + lane; const uint2* y1r = (const uint2*)(y1b + (size_t)m * DM) + lane;
        const float4* g0r = (const float4*)norm_post + lane; const float4* g1r = (const float4*)(norm_post + DM) + lane;
        float4* orow = (float4*)(p.out + (size_t)m * DM) + lane;
#pragma unroll
        for (int j = 0; j < 8; ++j) {
            const float4 xv = xr[64 * j]; const uint2 a = y0r[64 * j], bb = y1r[64 * j]; const float4 g0 = g0r[64 * j], g1 = g1r[64 * j];
            float4 o;
            o.x = xv.x + bflo(a.x) * r0 * g0.x + bflo(bb.x) * r1 * g1.x; o.y = xv.y + bfhi(a.x) * r0 * g0.y + bfhi(bb.x) * r1 * g1.y;
            o.z = xv.z + bflo(a.y) * r0 * g0.z + bflo(bb.y) * r1 * g1.z; o.w = xv.w + bfhi(a.y) * r0 * g0.w + bfhi(bb.y) * r1 * g1.w;
            orow[64 * j] = o;
        }
    } }
}

extern "C" void kernel_launch(void* const* d_in, const int* in_sizes, int n_in, void* d_out, int out_size, void* d_ws, size_t ws_size, hipStream_t stream) {
    static int grid = 0;
    if (grid == 0) {
        if (n_in != 16 || ws_size < WS_END) { fprintf(stderr, "kernel_launch: unexpected n_in %d / ws_size %zu\n", n_in, ws_size); grid = -1; return; }
        int dev = 0, cus = 0, per_cu = 0;
        (void)hipGetDevice(&dev); (void)hipDeviceGetAttribute(&cus, hipDeviceAttributeMultiprocessorCount, dev);
        if (hipFuncSetAttribute((const void*)yoco_fwd, hipFuncAttributeMaxDynamicSharedMemorySize, LDS_BYTES) != hipSuccess) { fprintf(stderr, "kernel_launch: hipFuncSetAttribute failed\n"); grid = -1; return; }
        if (hipOccupancyMaxActiveBlocksPerMultiprocessor(&per_cu, (const void*)yoco_fwd, NTHREADS, LDS_BYTES) != hipSuccess || per_cu < 1) { fprintf(stderr, "kernel_launch: occupancy query says %d\n", per_cu); per_cu = 1; }
        (void)hipGetLastError();
        grid = cus;
        if (grid != 256) fprintf(stderr, "kernel_launch: note: %d CUs\n", grid);
    }
    if (grid < 0) return;
    Params prm{};
    for (int i = 0; i < 16; ++i) prm.in[i] = (const float*)d_in[i];
    prm.out = (float*)d_out; prm.ws = (unsigned char*)d_ws;
    void* args[] = {&prm};
    hipError_t e = hipLaunchCooperativeKernel((const void*)yoco_fwd, dim3(grid), dim3(NTHREADS), args, LDS_BYTES, stream);
    if (e != hipSuccess) fprintf(stderr, "kernel_launch: cooperative launch failed: %s (grid %d)\n", hipGetErrorString(e), grid);
}
```

```cpp
#include <hip/hip_runtime.h>
#include <hip/hip_cooperative_groups.h>
#include <cstdio>
#include <cstdint>
namespace cg = cooperative_groups;

namespace pg8 {
#define PG8_LAS __attribute__((address_space(3)))
typedef unsigned short bf16_t;
typedef short bf16x8 __attribute__((ext_vector_type(8)));
typedef float f32x4 __attribute__((ext_vector_type(4)));
typedef unsigned u32x4 __attribute__((ext_vector_type(4)));
constexpr int BM = 256, BK = 64, HALF = 128, HTB = HALF * BK * 2  , STAGE_BYTES = 8 * HTB, NXCD = 8, WGM = 8;

__host__ __device__ __forceinline__ int lds_byte(int r, int c) { const int st = (r >> 4) * 2 + (c >> 5), rr = r & 15, cc = c & 31, ob = rr * 64 + cc * 2; return st * 1024 + (ob ^ (((ob >> 9) & 1) << 5)); }
__host__ __device__ __forceinline__ void stage_rc(int b, int& R, int& C) { const int st = b / 1024, sb = b % 1024, swz = sb ^ (((sb >> 9) & 1) << 5); R = (st >> 1) * 16 + swz / 64; C = (st & 1) * 32 + (swz % 64) / 2; }
__host__ __device__ __forceinline__ int perm32(int rho) { const int n = rho >> 4, i = rho & 15; return 8 * (i >> 2) + 4 * n + (i & 3); }

struct Unit { int pm, pn; };
struct Gemm { const bf16_t* A; const bf16_t* Bt; int M, N, K, lda, ldb; };

struct StaticOrder {
    int nM, nN, nwg, G, c;
    __host__ __device__ void init(int M, int N, int G_, int c_) { nM = M / BM; nN = N / BM; nwg = nM * nN; G = G_; c = c_; }
    __host__ __device__ bool next(int i, Unit& u) const {
        const long L = (long)i * G + c; if (L >= nwg) return false;
        int wgid = (int)L; { const int q = nwg / NXCD, r = nwg % NXCD, xcd = wgid % NXCD, off = wgid / NXCD; wgid = (xcd < r ? xcd * (q + 1) : r * (q + 1) + (xcd - r) * q) + off; }
        const int nig = WGM * nN, gid = wgid / nig, fm = gid * WGM, gsz = (nM - fm) < WGM ? (nM - fm) : WGM;
        u.pm = fm + ((wgid % nig) % gsz); u.pn = (wgid % nig) / gsz; return true;
    }
    __device__ __forceinline__ void a_ready(const Unit&) const {}
    __device__ __forceinline__ void done(const Unit&) const {}
    __device__ __forceinline__ const char* abase(const Gemm& g, const Unit& u) const { return (const char*)g.A + (size_t)u.pm * BM * g.lda * 2; }
    __device__ __forceinline__ const char* bbase(const Gemm& g, const Unit& u) const { return (const char*)g.Bt + (size_t)u.pn * BM * g.ldb * 2; }
};

__device__ __forceinline__ unsigned cvt_pk_bf16(float lo, float hi) { unsigned r; asm volatile("v_cvt_pk_bf16_f32 %0, %1, %2" : "=v"(r) : "v"(lo), "v"(hi)); return r; }
typedef float f32x2 __attribute__((ext_vector_type(2)));

template <int KIND> struct EpiK {
    static constexpr bool PERM = true, AFTER_DRAIN = false;
    bf16_t* b0; bf16_t* b1;
    __device__ __forceinline__ void operator()(const f32x4 (&acc)[2][2][4][2], const Unit& u, int wr, int wc, int fr, int fq) const {
        bf16_t* base; bool hm; int ld = 2048, pr = u.pn;
        if (KIND == 1) { if (u.pn < 24) { base = b0; hm = true; } else { base = b1; hm = false; pr = u.pn - 24; } }
        else if (KIND == 2) { base = b0; hm = false; }
        else { if (u.pn < 8) { base = b0; hm = true; } else if (u.pn < 32) { base = b0 + (size_t)16 * 1024 * 1024; hm = false; ld = 6144; pr = u.pn - 8; }
               else if (u.pn < 44) { base = b1; hm = true; pr = u.pn - 32; } else { base = b1 + (size_t)24 * 1024 * 1024; hm = false; ld = 256; pr = 0; } }
        const int row0 = u.pm * BM + wr * 64 + fr;
        const int cin = wc * 32 + 8 * fq;
#pragma unroll
        for (int ai = 0; ai < 2; ++ai)
#pragma unroll
            for (int m = 0; m < 4; ++m) {
                const int row = row0 + ai * HALF + m * 16;
                float s = 0.f;
#pragma unroll
                for (int bj = 0; bj < 2; ++bj) {
                    const f32x4 v0 = acc[ai][bj][m][0], v1 = acc[ai][bj][m][1];
                    if (KIND == 2) s += (v0[0] * v0[0] + v0[1] * v0[1]) + (v0[2] * v0[2] + v0[3] * v0[3]) + (v1[0] * v1[0] + v1[1] * v1[1]) + (v1[2] * v1[2] + v1[3] * v1[3]);
                    u32x4 w; w.x = cvt_pk_bf16(v0[0], v0[1]); w.y = cvt_pk_bf16(v0[2], v0[3]); w.z = cvt_pk_bf16(v1[0], v1[1]); w.w = cvt_pk_bf16(v1[2], v1[3]);
                    bf16_t* dst = hm ? base + ((size_t)(pr * 2 + bj) * 8192 + row) * 128 + cin
                                     : base + (size_t)row * ld + pr * 256 + bj * HALF + cin;
                    *(u32x4*)dst = w;
                }
                if (KIND == 2) { s += __shfl_xor(s, 16); s += __shfl_xor(s, 32); if (fq == 0) ((float*)b1)[(size_t)row * 32 + u.pn * 4 + wc] = s; }
            }
    }
};

struct EpiPart {
    static constexpr bool PERM = false, AFTER_DRAIN = false;
    float* part;
    __device__ __forceinline__ void operator()(const f32x4 (&acc)[2][2][4][2], const Unit& u, int wr, int wc, int fr, int fq) const {
        float* base = part + ((size_t)u.pn * 4096 + (size_t)u.pm * BM + wr * 64 + fr) * 256 + wc * 32 + 4 * fq;
#pragma unroll
        for (int ai = 0; ai < 2; ++ai)
#pragma unroll
            for (int m = 0; m < 4; ++m)
#pragma unroll
                for (int bj = 0; bj < 2; ++bj)
#pragma unroll
                    for (int n = 0; n < 2; ++n) *(f32x4*)(base + (size_t)(ai * HALF + m * 16) * 256 + bj * HALF + n * 16) = acc[ai][bj][m][n];
    }
};
struct CmpOrder {
    int c;
    __device__ __forceinline__ bool next(int i, Unit& u) const { if (i > 0 || c >= 128) return false; u.pm = c >> 3; u.pn = c & 7; return true; }
    __device__ __forceinline__ void a_ready(const Unit&) const {}
    __device__ __forceinline__ void done(const Unit&) const {}
    __device__ __forceinline__ const char* abase(const Gemm& g, const Unit& u) const { const int cb = u.pm >> 1, mt = u.pm & 1; return (const char*)g.A + ((size_t)cb * 8192 * 128 + (size_t)mt * 256 * 2048 + (size_t)u.pn * 512) * 2; }
    __device__ __forceinline__ const char* bbase(const Gemm& g, const Unit& u) const { const int sec = u.pm >> 3; return (const char*)g.Bt + ((size_t)sec * 256 * 4096 + (size_t)u.pn * 512) * 2; }
};
template <class Epi, class Sched, bool ALIGN_EPI = false, bool SP2 = false>
__device__ __forceinline__ void gemm_phase(PG8_LAS unsigned char* lds, const Gemm g, const Sched& S, const Epi& E) {
    int tid_raw = threadIdx.x; asm volatile("" : "+v"(tid_raw));
    const int tid = tid_raw, wid = __builtin_amdgcn_readfirstlane(tid >> 6), lane = tid & 63, wr = wid >> 2, wc = wid & 3, fr = lane & 15, fq = lane >> 4;
    const int K = g.K, nt = K / BK;
    unsigned voffA[2], voffB[2];
#pragma unroll
    for (int i = 0; i < 2; ++i) { int R, C; stage_rc(tid * 16 + i * 8192, R, C); const int Rb = Epi::PERM ? ((R & ~31) + perm32(R & 31)) : R;
        voffA[i] = (unsigned)(R * g.lda + C) * 2u; voffB[i] = (unsigned)(Rb * g.ldb + C) * 2u; }
    const size_t kstep = (size_t)(BK * 2);
    const size_t hstepA = (size_t)HALF * g.lda * 2, hstepB = (size_t)HALF * g.ldb * 2;
    const unsigned ldsw = (unsigned)wid * 1024u;
    const int aoff = lds_byte(wr * 64 + fr, fq * 8), boff = lds_byte(wc * 32 + fr, fq * 8);
#define PG8_SA(b, h) (((b) * 2 + (h)) * HTB)
#define PG8_SB(b, h) ((4 + (b) * 2 + (h)) * HTB)
#define PG8_STAGE(bufoff, gbase, voff) do { _Pragma("unroll") for (int _i = 0; _i < 2; ++_i) \
        __builtin_amdgcn_global_load_lds((const unsigned*)((const char*)(gbase) + (voff)[_i]), (PG8_LAS unsigned*)(lds + (bufoff) + ldsw + _i * 8192), 16, 0, 0); } while (0)
#define PG8_LDA(dst, b, h) do { _Pragma("unroll") for (int m = 0; m < 4; ++m) _Pragma("unroll") for (int k = 0; k < 2; ++k) dst[m][k] = *(const PG8_LAS bf16x8*)(lds + PG8_SA(b, h) + aoff + m * 2048 + k * 1024); } while (0)
#define PG8_LDB(dst, b, h) do { _Pragma("unroll") for (int n = 0; n < 2; ++n) _Pragma("unroll") for (int k = 0; k < 2; ++k) dst[n][k] = *(const PG8_LAS bf16x8*)(lds + PG8_SB(b, h) + boff + n * 2048 + k * 1024); } while (0)
#define PG8_MMA(ai, bj, At, Bt) do { __builtin_amdgcn_s_setprio(1); _Pragma("unroll") for (int m = 0; m < 4; ++m) _Pragma("unroll") for (int n = 0; n < 2; ++n) _Pragma("unroll") for (int k = 0; k < 2; ++k) \
        acc[ai][bj][m][n] = __builtin_amdgcn_mfma_f32_16x16x32_bf16(Bt[n][k], At[m][k], acc[ai][bj][m][n], 0, 0, 0); __builtin_amdgcn_s_setprio(0); } while (0)
#define PG8_WAIT_V(n) asm volatile("s_waitcnt vmcnt(" #n ")" ::: "memory")
#define PG8_WAIT_L(n) asm volatile("s_waitcnt lgkmcnt(" #n ")" ::: "memory")
#define PG8_BAR __builtin_amdgcn_s_barrier()
#define PG8_SCHED __builtin_amdgcn_sched_barrier(0)
    Unit cur, nxt; int ui = 0;
    if (!S.next(0, cur)) return;
    f32x4 acc[2][2][4][2];
#pragma unroll
    for (int a = 0; a < 2; ++a)
#pragma unroll
        for (int b = 0; b < 2; ++b)
#pragma unroll
            for (int m = 0; m < 4; ++m)
#pragma unroll
                for (int n = 0; n < 2; ++n) acc[a][b][m][n] = (f32x4){0.f, 0.f, 0.f, 0.f};
    bf16x8 At[4][2], B0[2][2], B1[2][2];
    const char* cA = S.abase(g, cur); const char* cB = S.bbase(g, cur);
    S.a_ready(cur);
    if constexpr (SP2) {
        PG8_STAGE(PG8_SB(0, 0), cB, voffB); PG8_STAGE(PG8_SB(0, 1), cB + hstepB, voffB); PG8_STAGE(PG8_SA(0, 0), cA, voffA); PG8_STAGE(PG8_SA(0, 1), cA + hstepA, voffA);
        if (wr == 1) PG8_BAR;
        PG8_WAIT_V(2); PG8_BAR;
        PG8_STAGE(PG8_SB(1, 0), cB + kstep, voffB); PG8_STAGE(PG8_SA(1, 0), cA + kstep, voffA); PG8_STAGE(PG8_SB(1, 1), cB + hstepB + kstep, voffB);
        PG8_WAIT_V(6); PG8_BAR;
    } else {
        PG8_STAGE(PG8_SB(0, 0), cB, voffB); PG8_STAGE(PG8_SA(0, 0), cA, voffA); PG8_STAGE(PG8_SB(0, 1), cB + hstepB, voffB); PG8_STAGE(PG8_SA(0, 1), cA + hstepA, voffA);
        if (wr == 1) PG8_BAR;
        PG8_WAIT_V(4); PG8_BAR;
        PG8_STAGE(PG8_SB(1, 0), cB + kstep, voffB); PG8_STAGE(PG8_SA(1, 0), cA + kstep, voffA); PG8_STAGE(PG8_SB(1, 1), cB + hstepB + kstep, voffB);
        PG8_WAIT_V(6); PG8_BAR;
    }
    for (;;) {
        const bool has_next = S.next(ui + 1, nxt);
        const char* nA = has_next ? S.abase(g, nxt) : cA; const char* nB = has_next ? S.bbase(g, nxt) : cB;
        for (int t = 0; t < nt; t += 2) {
            const bool last = (t == nt - 2);
            const char* a1 = cA + (size_t)(t + 1) * kstep;
            const char* a2 = last ? nA : cA + (size_t)(t + 2) * kstep; const char* b2 = last ? nB : cB + (size_t)(t + 2) * kstep;
            const char* a3 = a2 + kstep; const char* b3 = b2 + kstep;
            if (last && has_next) S.a_ready(nxt);
            if constexpr (SP2) {
            PG8_LDB(B0, 0, 0); PG8_LDB(B1, 0, 1); PG8_SCHED; PG8_LDA(At, 0, 0); PG8_STAGE(PG8_SA(1, 1), a1 + hstepA, voffA);
            PG8_WAIT_V(8); PG8_WAIT_L(0); PG8_BAR; PG8_MMA(0, 0, At, B0); PG8_MMA(0, 1, At, B1); PG8_BAR; PG8_SCHED;
            PG8_LDA(At, 0, 1); PG8_STAGE(PG8_SB(0, 0), b2, voffB); PG8_STAGE(PG8_SB(0, 1), b2 + hstepB, voffB); PG8_STAGE(PG8_SA(0, 0), a2, voffA);
            PG8_WAIT_V(8); PG8_WAIT_L(0); PG8_BAR; PG8_MMA(1, 0, At, B0); PG8_MMA(1, 1, At, B1); PG8_BAR; PG8_SCHED;
            PG8_LDB(B0, 1, 0); PG8_LDB(B1, 1, 1); PG8_SCHED; PG8_LDA(At, 1, 0); PG8_STAGE(PG8_SA(0, 1), a2 + hstepA, voffA);
            PG8_WAIT_V(8); PG8_WAIT_L(0); PG8_BAR; PG8_MMA(0, 0, At, B0); PG8_MMA(0, 1, At, B1); PG8_BAR; PG8_SCHED;
            PG8_LDA(At, 1, 1); PG8_STAGE(PG8_SB(1, 0), b3, voffB); PG8_STAGE(PG8_SB(1, 1), b3 + hstepB, voffB); PG8_STAGE(PG8_SA(1, 0), a3, voffA);
            PG8_WAIT_V(8); PG8_WAIT_L(0); PG8_BAR; PG8_MMA(1, 0, At, B0); PG8_MMA(1, 1, At, B1); PG8_BAR; PG8_SCHED;
            } else {
            PG8_LDB(B0, 0, 0); PG8_SCHED; PG8_LDA(At, 0, 0); PG8_STAGE(PG8_SA(1, 1), a1 + hstepA, voffA);
            PG8_WAIT_L(8); PG8_BAR; PG8_WAIT_L(0); PG8_MMA(0, 0, At, B0); PG8_BAR; PG8_SCHED;
            PG8_LDB(B1, 0, 1); PG8_STAGE(PG8_SB(0, 0), b2, voffB);
            PG8_BAR; PG8_WAIT_L(0); PG8_MMA(0, 1, At, B1); PG8_BAR;
            PG8_LDA(At, 0, 1); PG8_STAGE(PG8_SA(0, 0), a2, voffA);
            PG8_BAR; PG8_WAIT_L(0); PG8_MMA(1, 0, At, B0); PG8_BAR; PG8_SCHED;
            PG8_STAGE(PG8_SB(0, 1), b2 + hstepB, voffB);
            PG8_WAIT_V(6); PG8_BAR; PG8_MMA(1, 1, At, B1); PG8_BAR;
            PG8_LDB(B0, 1, 0); PG8_SCHED; PG8_LDA(At, 1, 0); PG8_STAGE(PG8_SA(0, 1), a2 + hstepA, voffA);
            PG8_WAIT_L(8); PG8_BAR; PG8_WAIT_L(0); PG8_MMA(0, 0, At, B0); PG8_BAR; PG8_SCHED;
            PG8_LDB(B1, 1, 1); PG8_STAGE(PG8_SB(1, 0), b3, voffB);
            PG8_BAR; PG8_WAIT_L(0); PG8_MMA(0, 1, At, B1); PG8_BAR;
            PG8_LDA(At, 1, 1); PG8_STAGE(PG8_SA(1, 0), a3, voffA);
            PG8_BAR; PG8_WAIT_L(0); PG8_MMA(1, 0, At, B0); PG8_BAR; PG8_SCHED;
            PG8_STAGE(PG8_SB(1, 1), b3 + hstepB, voffB);
            PG8_WAIT_V(6); PG8_BAR; PG8_MMA(1, 1, At, B1); PG8_BAR;
            }
        }
        if constexpr (ALIGN_EPI) { if (wr == 0) PG8_BAR; }
        if constexpr (!Epi::AFTER_DRAIN) { E(acc, cur, wr, wc, fr, fq); S.done(cur); }
        if (!has_next) break;
#pragma unroll
        for (int a = 0; a < 2; ++a)
#pragma unroll
            for (int b = 0; b < 2; ++b)
#pragma unroll
                for (int m = 0; m < 4; ++m)
#pragma unroll
                    for (int n = 0; n < 2; ++n) acc[a][b][m][n] = (f32x4){0.f, 0.f, 0.f, 0.f};
        cur = nxt; cA = nA; cB = nB; ++ui;
        if constexpr (ALIGN_EPI) { if (wr == 1) PG8_BAR; }
    }
    PG8_WAIT_V(0);
    if constexpr (!ALIGN_EPI) { if (wr == 0) PG8_BAR; }
    PG8_BAR;
    if constexpr (Epi::AFTER_DRAIN) { E.fused(acc, cur, wr, wc, fr, fq, lds, wid, lane); S.done(cur); }
#undef PG8_SA
#undef PG8_SB
#undef PG8_STAGE
#undef PG8_LDA
#undef PG8_LDB
#undef PG8_MMA
#undef PG8_WAIT_V
#undef PG8_WAIT_L
#undef PG8_BAR
#undef PG8_SCHED
}
}

#define LAS __attribute__((address_space(3)))
typedef unsigned short bf16_t;
typedef unsigned u32x4 __attribute__((ext_vector_type(4)));
constexpr int DM = 2048, NB = 4, SEQ = 2048, NH = 16, HD = 128, MTOK = NB * SEQ;
constexpr int NCMP = 127;
constexpr float ATT_SCALE = 0.08838834764831845f;
constexpr float NEGF = -1e30f;
constexpr size_t MiB = 1u << 20;
constexpr size_t WS_QKVA = 0, WS_ZA = 96 * MiB;
constexpr size_t WS_QB = 0, WS_ZB = 32 * MiB;
constexpr size_t WS_Y1 = 0;
constexpr size_t WS_B = 128 * MiB;
constexpr size_t WS_WB = 160 * MiB;
constexpr size_t WS_WOA = 205 * MiB, WS_WOB = 213 * MiB;
constexpr size_t WS_Y0 = 221 * MiB;
constexpr size_t WS_SSQ0 = 253 * MiB, WS_SSQ1 = 254 * MiB, WS_RSTD0 = 255 * MiB;
constexpr size_t WS_END = 256 * MiB;
constexpr size_t DO_XHAT0 = 0;
constexpr size_t DO_KVB = 0;
constexpr size_t DO_GB = 48 * MiB;
constexpr size_t DO_KCMP = 52 * MiB, DO_VCMP = 53 * MiB;
constexpr int NWB = 11520;

struct Params { const float* in[16]; float* out; unsigned char* ws; };

__device__ __forceinline__ float bf2f(unsigned u16) { return __uint_as_float(u16 << 16); }
__device__ __forceinline__ float bflo(unsigned w) { return __uint_as_float(w << 16); }
__device__ __forceinline__ float bfhi(unsigned w) { return __uint_as_float(w & 0xffff0000u); }
__device__ __forceinline__ unsigned f2bf(float f) { unsigned u = __float_as_uint(f); return (u + 0x7fffu + ((u >> 16) & 1u)) >> 16; }
__device__ __forceinline__ unsigned pk2(float lo, float hi) { return f2bf(lo) | (f2bf(hi) << 16); }
__device__ __forceinline__ float wave_sum(float v) {
#pragma unroll
    for (int o = 32; o >= 1; o >>= 1) v += __shfl_xor(v, o);
    return v;
}
__device__ __forceinline__ float wave_max(float v) {
#pragma unroll
    for (int o = 32; o >= 1; o >>= 1) v = fmaxf(v, __shfl_xor(v, o));
    return v;
}
__device__ __forceinline__ int rel_bucket(int dist) {
    int n = dist > 0 ? dist : 0;
    if (n < 16) return n;
    int b = 16;
    b += (n >= 22); b += (n >= 30); b += (n >= 40); b += (n >= 54); b += (n >= 73); b += (n >= 99); b += (n >= 134); b += (n >= 182);
    b += (n >= 246); b += (n >= 332); b += (n >= 450); b += (n >= 609); b += (n >= 825); b += (n >= 1117); b += (n >= 1513);
    return b;
}
__device__ __forceinline__ float silu(float z) { return z / (1.f + __expf(-z)); }

__device__ __forceinline__ void transpose_item(const float* W, int ldw, int c0, int ncv, int k0, const float* g, bf16_t* WT, int K, int r0, LAS float* scr, int lane) {
#pragma unroll 8
    for (int i = 0; i < 32; ++i) {
        const int kk = 2 * i + (lane >> 5), c = c0 + (lane & 31);
        float v = (c < ncv) ? W[(size_t)(k0 + kk) * ldw + c] : 0.f;
        if (g) v *= g[k0 + kk];
        scr[kk * 33 + (lane & 31)] = v;
    }
    asm volatile("s_waitcnt lgkmcnt(0)" ::: "memory");
    const int c = lane & 7;
#pragma unroll
    for (int j = 0; j < 4; ++j) {
        const int n = (lane >> 3) + 8 * j; const LAS float* s = scr + (8 * c) * 33 + n;
        u32x4 o; o.x = pk2(s[0 * 33], s[1 * 33]); o.y = pk2(s[2 * 33], s[3 * 33]); o.z = pk2(s[4 * 33], s[5 * 33]); o.w = pk2(s[6 * 33], s[7 * 33]);
        *(u32x4*)(WT + (size_t)(r0 + n) * K + k0 + 8 * c) = o;
    }
    asm volatile("s_waitcnt lgkmcnt(0)" ::: "memory");
}
__device__ __forceinline__ void rms_row_bf16(const float* xrow, bf16_t* orow, int lane) {
    const float4* xr = (const float4*)xrow + lane;
    float4 v[8]; float ss = 0.f;
#pragma unroll
    for (int j = 0; j < 8; ++j) { v[j] = xr[64 * j]; ss += (v[j].x * v[j].x + v[j].y * v[j].y) + (v[j].z * v[j].z + v[j].w * v[j].w); }
    const float r = rsqrtf(wave_sum(ss) * (1.f / DM) + 1e-6f);
    uint2* o8 = (uint2*)orow + lane;
#pragma unroll
    for (int j = 0; j < 8; ++j) o8[64 * j] = make_uint2(pk2(v[j].x * r, v[j].y * r), pk2(v[j].z * r, v[j].w * r));
}

__device__ __forceinline__ float dot_row(const LAS float* qs, const bf16_t* krow) {
    const uint4* kp = (const uint4*)krow; float acc = 0.f;
#pragma unroll 4
    for (int i = 0; i < 16; ++i) {
        const uint4 w = kp[i]; const LAS float* q = qs + 8 * i;
        acc += q[0] * bflo(w.x) + q[1] * bfhi(w.x) + q[2] * bflo(w.y) + q[3] * bfhi(w.y) + q[4] * bflo(w.z) + q[5] * bfhi(w.z) + q[6] * bflo(w.w) + q[7] * bfhi(w.w);
    }
    return acc;
}
__device__ __forceinline__ void wave_chunk(const LAS float* qs, const bf16_t* Kb, const bf16_t* Vb, bool valid, int row, float bias,
                                           float& m, float& l, float& o0, float& o1, int lane) {
    float s = NEGF;
    if (valid) s = dot_row(qs, Kb + (size_t)row * HD) * ATT_SCALE + bias;
    const float cm = wave_max(s);
    const float mn = fmaxf(m, cm);
    const float p = valid ? __expf(s - mn) : 0.f;
    const float alpha = __expf(m - mn);
    l = l * alpha + wave_sum(p);
    o0 *= alpha; o1 *= alpha; m = mn;
    const float pb = bf2f(f2bf(p));
    const unsigned long long act = __ballot(pb != 0.f);
    for (int j = 0; j < 64; ++j) {
        if (!((act >> j) & 1ull)) continue;
        const float pj = __shfl(pb, j); const int rj = __shfl(row, j);
        const unsigned w = ((const unsigned*)(Vb + (size_t)rj * HD))[lane];
        o0 += pj * bflo(w); o1 += pj * bfhi(w);
    }
}
__device__ __forceinline__ void load_q(LAS float* qs, const bf16_t* qrow, int lane) {
    const unsigned w = ((const unsigned*)qrow)[lane];
    qs[2 * lane] = bflo(w); qs[2 * lane + 1] = bfhi(w);
    asm volatile("s_waitcnt lgkmcnt(0)" ::: "memory");
}

namespace att {
typedef short bf16x8 __attribute__((ext_vector_type(8)));
typedef short s16x4 __attribute__((ext_vector_type(4)));
typedef float f32x16 __attribute__((ext_vector_type(16)));
typedef float f32x4 __attribute__((ext_vector_type(4)));
constexpr int SHM_V = 16384, SHM_K = 16384;
constexpr int L_V = 0, L_K = 32768, L_WS = 65536, L_TBL = 67584;
constexpr float SCALE = 0.08838834764831845f, THR = 8.f;
constexpr float C2 = 1.4426950408889634f * SCALE;
#define ATT_KSWZ(row, colB) ((row) * 256 + ((colB) ^ (((row) & 7) << 4)))
#define ATT_SBAR() __builtin_amdgcn_sched_barrier(0)
__device__ __forceinline__ int v_st(int k, int c) { const int kk = (k & ~0xC) | ((k & 4) << 1) | ((k & 8) >> 1); return ((kk >> 3) * 4 + (c >> 5)) * 512 + ((kk & 7) * 32 + (c & 31)) * 2; }
__device__ __forceinline__ int v_rd_base(int lane) { return ((lane & 3) << 3) | (((lane >> 2) & 3) << 6) | (((lane >> 4) & 1) << 5) | (((lane >> 5) & 1) << 8); }
constexpr int v_rd_off(int d0, int ks, int half) { return d0 * 512 + ks * 4096 + half * 2048; }
__device__ __forceinline__ int crow(int r, int hi) { return (r & 3) + 8 * (r >> 2) + 4 * hi; }
__device__ __forceinline__ unsigned cvtpk(float lo, float hi) { unsigned r; asm volatile("v_cvt_pk_bf16_f32 %0, %1, %2" : "=v"(r) : "v"(lo), "v"(hi)); return r; }

__device__ __forceinline__ void partialSM(f32x16& p0, f32x16& p1, float& m_reg, float& alpha) {
    float pmax = p0[0];
#pragma unroll
    for (int r = 1; r < 16; ++r) pmax = fmaxf(pmax, p0[r]);
#pragma unroll
    for (int r = 0; r < 16; ++r) pmax = fmaxf(pmax, p1[r]);
    { auto rr = __builtin_amdgcn_permlane32_swap(__float_as_uint(pmax), __float_as_uint(pmax), false, false);
      pmax = fmaxf(__uint_as_float(rr[0]), __uint_as_float(rr[1])); }
    float mn;
    if (__builtin_expect(__all((pmax - m_reg) * SCALE <= THR), 1)) { mn = m_reg; alpha = 1.f; }
    else { mn = fmaxf(m_reg, pmax); alpha = __builtin_amdgcn_exp2f((m_reg - mn) * C2); m_reg = mn; }
    const float mnL = -mn * C2;
#pragma unroll
    for (int r = 0; r < 16; ++r) p0[r] = fmaf(p0[r], C2, mnL);
#pragma unroll
    for (int r = 0; r < 16; ++r) p1[r] = fmaf(p1[r], C2, mnL);
#pragma unroll
    for (int r = 0; r < 16; ++r) p0[r] = __builtin_amdgcn_exp2f(p0[r]);
}
#define ATT_PK4(P, B_, OUT) do { unsigned a0 = att::cvtpk(P[B_+0], P[B_+1]), a1 = att::cvtpk(P[B_+2], P[B_+3]);                          \
        unsigned b0 = att::cvtpk(P[B_+4], P[B_+5]), b1 = att::cvtpk(P[B_+6], P[B_+7]);                                             \
        auto r0 = __builtin_amdgcn_permlane32_swap(a0, b0, false, false); auto r1 = __builtin_amdgcn_permlane32_swap(a1, b1, false, false); \
        u32x4 w = {r0[0], r1[0], r0[1], r1[1]}; OUT = __builtin_bit_cast(att::bf16x8, w); } while (0)
__device__ __forceinline__ void finishSM(f32x16& p0, f32x16& p1, float alpha, float& l_reg, bf16x8& pa0, bf16x8& pa1, bf16x8& pa2, bf16x8& pa3) {
#pragma unroll
    for (int r = 0; r < 16; ++r) p1[r] = __builtin_amdgcn_exp2f(p1[r]);
    float ps = 0;
#pragma unroll
    for (int r = 0; r < 16; ++r) ps += p0[r];
#pragma unroll
    for (int r = 0; r < 16; ++r) ps += p1[r];
    { auto rr = __builtin_amdgcn_permlane32_swap(__float_as_uint(ps), __float_as_uint(ps), false, false);
      ps = __uint_as_float(rr[0]) + __uint_as_float(rr[1]); }
    l_reg = l_reg * alpha + ps;
    ATT_PK4(p0, 0, pa0); ATT_PK4(p0, 8, pa1); ATT_PK4(p1, 0, pa2); ATT_PK4(p1, 8, pa3);
}
__device__ __forceinline__ void qkt(f32x16& p0, f32x16& p1, const LAS unsigned char* Kt, int r32, int hi, const bf16x8 (&qr)[8], const LAS float* tb) {
#pragma unroll
    for (int r = 0; r < 16; ++r) { p0[r] = tb[59 - ((r & 3) + 8 * (r >> 2))]; p1[r] = tb[27 - ((r & 3) + 8 * (r >> 2))]; }
    const LAS unsigned char* kb[4];
#pragma unroll
    for (int dd = 0; dd < 4; ++dd) kb[dd] = Kt + ATT_KSWZ(r32, (dd * 16 + hi * 8) * 2);
#pragma unroll
    for (int d0 = 0; d0 < 8; ++d0) { const LAS unsigned char* a = kb[d0 & 3] + (d0 >> 2) * 128;
        const bf16x8 b0 = *(const LAS bf16x8*)a;
        const bf16x8 b1 = *(const LAS bf16x8*)(a + 32 * 256);
        p0 = __builtin_amdgcn_mfma_f32_32x32x16_bf16(b0, qr[d0], p0, 0, 0, 0);
        p1 = __builtin_amdgcn_mfma_f32_32x32x16_bf16(b1, qr[d0], p1, 0, 0, 0); }
}
__device__ __forceinline__ void pv_tile(f32x16 (&o)[4], int vb, bf16x8 pa0, bf16x8 pa1, bf16x8 pa2, bf16x8 pa3) {
#define ATT_TRRD(dst, off) asm volatile("ds_read_b64_tr_b16 %0, %1 offset:%2" : "=&v"(dst) : "v"(vb), "i"(off) : "memory")
#define ATT_PV_D0(d0) do { s16x4 l0, l1, l2, l3, h0, h1, h2, h3; constexpr int b_ = v_rd_off(d0, 0, 0); \
        ATT_TRRD(l0, b_); ATT_TRRD(h0, b_ + 2048); ATT_TRRD(l1, b_ + 4096); ATT_TRRD(h1, b_ + 6144); ATT_TRRD(l2, b_ + 8192); ATT_TRRD(h2, b_ + 10240); ATT_TRRD(l3, b_ + 12288); ATT_TRRD(h3, b_ + 14336); \
        asm volatile("s_waitcnt lgkmcnt(0)" ::: "memory"); ATT_SBAR(); \
        o[d0] = __builtin_amdgcn_mfma_f32_32x32x16_bf16(pa0, (bf16x8){l0[0], l0[1], l0[2], l0[3], h0[0], h0[1], h0[2], h0[3]}, o[d0], 0, 0, 0); \
        o[d0] = __builtin_amdgcn_mfma_f32_32x32x16_bf16(pa1, (bf16x8){l1[0], l1[1], l1[2], l1[3], h1[0], h1[1], h1[2], h1[3]}, o[d0], 0, 0, 0); \
        o[d0] = __builtin_amdgcn_mfma_f32_32x32x16_bf16(pa2, (bf16x8){l2[0], l2[1], l2[2], l2[3], h2[0], h2[1], h2[2], h2[3]}, o[d0], 0, 0, 0); \
        o[d0] = __builtin_amdgcn_mfma_f32_32x32x16_bf16(pa3, (bf16x8){l3[0], l3[1], l3[2], l3[3], h3[0], h3[1], h3[2], h3[3]}, o[d0], 0, 0, 0); } while (0)
    ATT_PV_D0(0); ATT_PV_D0(1); ATT_PV_D0(2); ATT_PV_D0(3);
#undef ATT_PV_D0
#undef ATT_TRRD
}
template <class U>
__device__ __forceinline__ void flash_tiles(LAS unsigned char* lds, const U& u, const bf16x8 (&qr)[8], f32x16 (&o)[4], float& m_reg, float& l_reg, int tid, int lane, int wid) {
    const int r32 = lane & 31, hi = lane >> 5;
    const int sr = tid >> 4, sc = (tid & 15) * 8, vst0 = v_st(sr, sc), vst1 = v_st(32 + sr, sc), kws = ATT_KSWZ(sr, sc * 2);
    const int vb0 = L_V + v_rd_base(lane);
    LAS float* al_l = (LAS float*)(lds + L_WS) + wid * 64 + 32;
    const int NT = u.nt();
    bf16x8 sk0, sk1, sv0, sv1;
    if (NT > 0) { u.load(0, sr, sc, sk0, sk1, sv0, sv1);
        *(LAS bf16x8*)(lds + L_K + kws) = sk0; *(LAS bf16x8*)(lds + L_K + kws + 32 * 256) = sk1;
        *(LAS bf16x8*)(lds + L_V + vst0) = sv0; *(LAS bf16x8*)(lds + L_V + vst1) = sv1; }
    __syncthreads();
    for (int t = 0; t < NT; ++t) {
        const int buf = t & 1;
        if (t + 1 < NT) u.load(t + 1, sr, sc, sk0, sk1, sv0, sv1);
        if (u.act(t)) {
            f32x16 p0, p1; float alpha; bf16x8 pa0, pa1, pa2, pa3;
            qkt(p0, p1, lds + L_K + buf * SHM_K, r32, hi, qr, u.tbl(t));
            partialSM(p0, p1, m_reg, alpha);
            if (__any(alpha < 1.f)) { if (hi == 0) al_l[r32] = alpha; asm volatile("s_waitcnt lgkmcnt(0)" ::: "memory");
#pragma unroll
                for (int d_ = 0; d_ < 4; ++d_)
#pragma unroll
                    for (int r = 0; r < 16; ++r) o[d_][r] *= al_l[crow(r, hi)]; }
            finishSM(p0, p1, alpha, l_reg, pa0, pa1, pa2, pa3); ATT_SBAR();
            pv_tile(o, vb0 + buf * SHM_V, pa0, pa1, pa2, pa3);
        }
        if (t + 1 < NT) { const int nb = buf ^ 1;
            *(LAS bf16x8*)(lds + L_K + nb * SHM_K + kws) = sk0; *(LAS bf16x8*)(lds + L_K + nb * SHM_K + kws + 32 * 256) = sk1;
            *(LAS bf16x8*)(lds + L_V + nb * SHM_V + vst0) = sv0; *(LAS bf16x8*)(lds + L_V + nb * SHM_V + vst1) = sv1; }
        __syncthreads();
    }
}
template <class F>
__device__ __forceinline__ void emit(LAS unsigned char* lds, const f32x16 (&o)[4], float l_reg, int lane_in, int wid, const F& f) {
    int lane = lane_in; asm volatile("" : "+v"(lane));
    const int r32 = lane & 31, hi = lane >> 5;
    LAS float* li_l = (LAS float*)(lds + L_WS) + wid * 64;
    if (hi == 0) li_l[r32] = l_reg > 0.f ? 1.f / l_reg : 0.f;
    asm volatile("s_waitcnt lgkmcnt(0)" ::: "memory");
    float rli[16];
#pragma unroll
    for (int r = 0; r < 16; ++r) rli[r] = li_l[crow(r, hi)];
    LAS float* stg = (LAS float*)(lds + wid * 8192);
#pragma unroll
    for (int hf = 0; hf < 2; ++hf) {
#pragma unroll
        for (int r = 0; r < 16; ++r) { const int row = crow(r, hi);
            stg[row * 64 + r32] = o[2 * hf][r] * rli[r]; stg[row * 64 + 32 + r32] = o[2 * hf + 1][r] * rli[r]; }
        asm volatile("s_waitcnt lgkmcnt(0)" ::: "memory");
#pragma unroll
        for (int i = 0; i < 8; ++i) { const int idx = i * 64 + lane, row = idx >> 4, c4 = (idx & 15) * 4;
            const f32x4 v = *(const LAS f32x4*)(stg + row * 64 + c4); f(row, hf * 64 + c4, v); }
        asm volatile("s_waitcnt lgkmcnt(0)" ::: "memory");
    }
    __syncthreads();
}
}

struct DilU {
    const bf16_t* K; const bf16_t* V;
    int d, m16, lbase, res, jlo, ntl, lw0, wsel, lane_off;
    const LAS float* T;
    __device__ __forceinline__ int nt() const { return ntl; }
    __device__ __forceinline__ void tile(int t, int& lk0, int& rt, int& jj) const { const int j = jlo + t; jj = j; if (!m16) { lk0 = lbase + 64 * j; rt = res; } else { lk0 = 64 * (j & 1); rt = res + (j >> 1); } }
    __device__ __forceinline__ void load(int t, int sr, int sc, att::bf16x8& k0, att::bf16x8& k1, att::bf16x8& v0, att::bf16x8& v1) const {
        int lk0, rt, jj; tile(t, lk0, rt, jj);
        const size_t e0 = ((size_t)(lk0 + sr) * d + rt) * HD + sc, e1 = e0 + (size_t)32 * d * HD;
        k0 = *(const att::bf16x8*)(K + e0); k1 = *(const att::bf16x8*)(K + e1); v0 = *(const att::bf16x8*)(V + e0); v1 = *(const att::bf16x8*)(V + e1);
    }
    __device__ __forceinline__ bool act(int t) const { int lk0, rt, jj; tile(t, lk0, rt, jj);
        return m16 ? ((jj >> 1) == wsel && lk0 <= lw0 + 31) : (lk0 <= lw0 + 31 && lk0 + 63 >= lw0 - 128); }
    __device__ __forceinline__ const LAS float* tbl(int t) const { int lk0, rt, jj; tile(t, lk0, rt, jj); return T + (lw0 - lk0 + lane_off); }
};

constexpr int L_TSEL = att::L_TBL, L_TWIN = L_TSEL + 4 * 2112 * 4, L_IMPH = L_TWIN + 4 * 640 * 4, L_SELM = L_IMPH + 4 * 64 * 32 * 4, L_TL = L_SELM + 256;
static_assert(L_TL + 256 <= 155648, "LDS map");
struct SelU {
    const bf16_t* K; const bf16_t* V;
    const LAS int* tl; int ntl; unsigned mymask; int tq_off;
    const LAS float* T;
    __device__ __forceinline__ int nt() const { return ntl; }
    __device__ __forceinline__ void load(int t, int sr, int sc, att::bf16x8& k0, att::bf16x8& k1, att::bf16x8& v0, att::bf16x8& v1) const {
        const int n = __builtin_amdgcn_readfirstlane(tl[t]); const size_t e0 = (size_t)(64 * n + sr) * HD + sc, e1 = e0 + 32 * HD;
        k0 = *(const att::bf16x8*)(K + e0); k1 = *(const att::bf16x8*)(K + e1); v0 = *(const att::bf16x8*)(V + e0); v1 = *(const att::bf16x8*)(V + e1);
    }
    __device__ __forceinline__ bool act(int t) const { const int n = __builtin_amdgcn_readfirstlane(tl[t]); return __any((mymask >> n) & 1u); }
    __device__ __forceinline__ const LAS float* tbl(int t) const { const int n = __builtin_amdgcn_readfirstlane(tl[t]); return ((mymask >> n) & 1u) ? T + (tq_off - 64 * n) : T; }
};
struct WinU {
    const bf16_t* K; const bf16_t* V;
    int tk_base, ntl, tq_off;
    const LAS float* T;
    __device__ __forceinline__ int nt() const { return ntl; }
    __device__ __forceinline__ void load(int t, int sr, int sc, att::bf16x8& k0, att::bf16x8& k1, att::bf16x8& v0, att::bf16x8& v1) const {
        const size_t e0 = (size_t)(tk_base + 64 * t + sr) * HD + sc, e1 = e0 + 32 * HD;
        k0 = *(const att::bf16x8*)(K + e0); k1 = *(const att::bf16x8*)(K + e1); v0 = *(const att::bf16x8*)(V + e0); v1 = *(const att::bf16x8*)(V + e1);
    }
    __device__ __forceinline__ bool act(int) const { return true; }
    __device__ __forceinline__ const LAS float* tbl(int t) const { return T + (tq_off - tk_base - 64 * t); }
};
struct GateF {
    const bf16_t* zrow; const bf16_t* grow; bf16_t* arow;
    int first;
    __device__ __forceinline__ void operator()(int row, int col, att::f32x4 v) const {
        const float gt = 1.f / (1.f + __expf(-bf2f(grow[(size_t)row * 256])));
        const uint2 z = *(const uint2*)(zrow + (size_t)row * 6144 + col);
        float y0 = gt * v[0] * silu(bflo(z.x)), y1 = gt * v[1] * silu(bfhi(z.x)), y2 = gt * v[2] * silu(bflo(z.y)), y3 = gt * v[3] * silu(bfhi(z.y));
        uint2* ap = (uint2*)(arow + (size_t)row * DM + col);
        if (!first) { const uint2 a = *ap; y0 += bflo(a.x); y1 += bfhi(a.x); y2 += bflo(a.y); y3 += bfhi(a.y); }
        *ap = make_uint2(pg8::cvt_pk_bf16(y0, y1), pg8::cvt_pk_bf16(y2, y3));
    }
};

constexpr int NWAVES = 8, NTHREADS = 512;
constexpr int LDS_BYTES = 155648;

__global__ void __launch_bounds__(NTHREADS, 2) yoco_fwd(Params p) {
    extern __shared__ __attribute__((aligned(16))) unsigned char lds_raw[];
    LAS unsigned char* lds = (LAS unsigned char*)lds_raw;
    cg::grid_group grid = cg::this_grid();
    const int G = gridDim.x, NGW = G * NWAVES;
#define PHASE_VARS int tid = threadIdx.x; asm volatile("" : "+v"(tid)); const int lane = tid & 63, wave = __builtin_amdgcn_readfirstlane(tid >> 6), gw = blockIdx.x * NWAVES + wave; (void)lane; (void)gw;
    unsigned char* ws = p.ws; unsigned char* dob = (unsigned char*)p.out;
    const float* x = p.in[0]; const float* norm_pre = p.in[1]; const float* norm_post = p.in[2]; const float* table = p.in[3];
    const float* w_in_a = p.in[4]; const float* w_out_a = p.in[5]; const float* kv_norm = p.in[6]; const float* w_kv = p.in[7];
    const float* pos_k = p.in[8]; const float* pos_v = p.in[9]; const float* w1k = p.in[10]; const float* w2k = p.in[11];
    const float* w1v = p.in[12]; const float* w2v = p.in[13]; const float* w_in_b = p.in[14]; const float* w_out_b = p.in[15];
    bf16_t* WA_t = (bf16_t*)(ws + WS_B); bf16_t* WoA_t = (bf16_t*)(ws + WS_WOA); bf16_t* WB_t = (bf16_t*)(ws + WS_WB); bf16_t* WoB_t = (bf16_t*)(ws + WS_WOB);
    bf16_t* xhat0 = (bf16_t*)(dob + DO_XHAT0);
    bf16_t* qkvA = (bf16_t*)(ws + WS_QKVA); bf16_t* zA = (bf16_t*)(ws + WS_ZA); bf16_t* a0 = (bf16_t*)(ws + WS_B);
    bf16_t* y0b = (bf16_t*)(ws + WS_Y0); float* ssq0 = (float*)(ws + WS_SSQ0); float* ssq1 = (float*)(ws + WS_SSQ1); float* rstd0 = (float*)(ws + WS_RSTD0);
    bf16_t* xhat1 = (bf16_t*)(ws + WS_B); bf16_t* qB = (bf16_t*)(ws + WS_QB); bf16_t* zB = (bf16_t*)(ws + WS_ZB);
    bf16_t* kvb = (bf16_t*)(dob + DO_KVB); bf16_t* gB = (bf16_t*)(dob + DO_GB); bf16_t* kcmp = (bf16_t*)(dob + DO_KCMP); bf16_t* vcmp = (bf16_t*)(dob + DO_VCMP);
    bf16_t* a1 = (bf16_t*)(ws + WS_B); bf16_t* y1b = (bf16_t*)(ws + WS_Y1);
    float* posvec = (float*)(ws + WS_RSTD0 + 65536); bf16_t* W1t = (bf16_t*)(dob + 54 * MiB); float* cpart = (float*)(ws + WS_WB);

    {
        PHASE_VARS
        LAS float* scr = (LAS float*)(lds + wave * 16384);
        constexpr int I_A = 32 * 256, I_OA = 32 * 64, I_B = 32 * (NWB / 32), I_OB = 32 * 64;
        constexpr int NIT = I_A + I_OA + I_B + I_OB;
        for (int it = gw; it < NIT; it += NGW) {
            int r = it;
            if (r < I_A) { const int kb = r / 256, nb = r % 256; transpose_item(w_in_a, 8192, nb * 32, 8192, kb * 64, norm_pre, WA_t, DM, nb * 32, scr, lane); continue; } r -= I_A;
            if (r < I_OA) { const int kb = r / 64, nb = r % 64; transpose_item(w_out_a, 2048, nb * 32, 2048, kb * 64, nullptr, WoA_t, DM, nb * 32, scr, lane); continue; } r -= I_OA;
            if (r < I_B) { const int kb = r / (NWB / 32), nb = r % (NWB / 32); const int n0 = nb * 32;
                if (n0 < 8192) transpose_item(w_in_b, 8240, n0, 8240, kb * 64, norm_pre + DM, WB_t, DM, n0, scr, lane);
                else if (n0 < 11264) transpose_item(w_kv, 3072, n0 - 8192, 3072, kb * 64, kv_norm, WB_t, DM, n0, scr, lane);
                else transpose_item(w_in_b, 8240, 8192 + (n0 - 11264), 8240, kb * 64, norm_pre + DM, WB_t, DM, n0, scr, lane);
                continue; } r -= I_B;
            { const int kb = r / 64, nb = r % 64; transpose_item(w_out_b, 2048, nb * 32, 2048, kb * 64, nullptr, WoB_t, DM, nb * 32, scr, lane); }
        }
        for (int m = gw; m < MTOK; m += NGW) rms_row_bf16(x + (size_t)m * DM, xhat0 + (size_t)m * DM, lane);
        for (int it = gw; it < 512; it += NGW) {
            const int sec = it >> 8, n = it & 255; const float* pos = sec ? pos_v : pos_k; const float* w1 = sec ? w1v : w1k; float a = 0.f;
            for (int kq = lane; kq < 4096; kq += 64) a += pos[kq] * w1[(size_t)kq * 256 + n];
            a = wave_sum(a); if (lane == 0) posvec[it] = a;
        }
    }
    grid.sync();
    {
        pg8::Gemm g{xhat0, WA_t, MTOK, 8192, DM, DM, DM}; pg8::StaticOrder S; S.init(MTOK, 8192, G, (int)blockIdx.x);
        pg8::EpiK<1> E{qkvA, zA};
        pg8::gemm_phase<pg8::EpiK<1>, pg8::StaticOrder, true, true>(lds, g, S, E);
    }
    grid.sync();
    {
        PHASE_VARS
        bf16_t* op0 = (bf16_t*)(ws + WS_B); bf16_t* op1 = (bf16_t*)(dob); bf16_t* op2 = (bf16_t*)(dob + 32 * MiB);
        float* lseb = (float*)(ws + WS_SSQ0);
        LAS float* T = (LAS float*)(lds + att::L_TBL);
        const int r32 = lane & 31, hi = lane >> 5;
        const int vcu = (G % 8 == 0) ? ((int)blockIdx.x % 8) * (G / 8) + (int)blockIdx.x / 8 : (int)blockIdx.x;
        constexpr int NU = 64 * 24; const int per = (NU + G - 1) / G;
        for (int ui = vcu * per; ui < (vcu + 1) * per && ui < NU; ++ui) {
            const int bh = ui / 24, kk = ui % 24, pat = kk >> 3, idx = kk & 7, b = bh >> 4, h = bh & 15;
            const int d = pat == 0 ? 1 : (pat == 1 ? 4 : 16);
            DilU U; U.d = d; U.m16 = (pat == 2); U.T = T; U.lane_off = r32 - 4 * hi + 37;
            int rw;
            if (pat == 2) { U.res = 2 * idx; U.lbase = 0; U.jlo = 0; U.ntl = 4; U.lw0 = 32 * (wave & 3); U.wsel = wave >> 2; rw = 2 * idx + (wave >> 2); }
            else { const int mm = (pat == 0) ? idx : (idx & 1); U.res = (pat == 0) ? 0 : (idx >> 1); U.lbase = 256 * mm - 128; U.jlo = (mm == 0) ? 2 : 0; U.ntl = 6 - U.jlo; U.lw0 = 256 * mm + 32 * wave; U.wsel = 0; rw = U.res; }
            U.K = qkvA + ((size_t)(16 + h) * MTOK + b * SEQ) * HD; U.V = qkvA + ((size_t)(32 + h) * MTOK + b * SEQ) * HD;
            if (tid < 320) { const int delta = tid - 96; T[tid] = (delta >= 0 && delta <= 128) ? table[rel_bucket(delta * d) * NH + h] * (1.f / ATT_SCALE) : -__builtin_inff(); }
            const int grow_l = b * SEQ + (U.lw0 + r32) * d + rw;
            att::bf16x8 qr[8];
            { const bf16_t* qp = qkvA + ((size_t)h * MTOK + grow_l) * HD + hi * 8;
#pragma unroll
              for (int d0 = 0; d0 < 8; ++d0) qr[d0] = *(const att::bf16x8*)(qp + d0 * 16); }
            att::f32x16 o[4];
#pragma unroll
            for (int d_ = 0; d_ < 4; ++d_)
#pragma unroll
                for (int r = 0; r < 16; ++r) o[d_][r] = 0.f;
            float m_reg = -1e30f, l_reg = 0.f;
            att::flash_tiles(lds, U, qr, o, m_reg, l_reg, tid, lane, wave);
            bf16_t* opp = (pat == 0 ? op0 : (pat == 1 ? op1 : op2)) + h * HD;
            if (hi == 0) lseb[((size_t)pat * MTOK + grow_l) * NH + h] = m_reg * ATT_SCALE + __logf(l_reg);
            const int rbase = b * SEQ + U.lw0 * d + rw;
            att::emit(lds, o, l_reg, lane, wave, [=](int row, int col, att::f32x4 v) {
                *(uint2*)(opp + (size_t)(rbase + row * d) * DM + col) = make_uint2(pg8::cvt_pk_bf16(v[0], v[1]), pg8::cvt_pk_bf16(v[2], v[3])); });
        }
    }
    grid.sync();
    {
        PHASE_VARS
        const bf16_t* op1 = (const bf16_t*)(dob); const bf16_t* op2 = (const bf16_t*)(dob + 32 * MiB);
        const float* lseb = (const float*)(ws + WS_SSQ0);
        for (int m = gw; m < MTOK; m += NGW) {
#pragma unroll
            for (int j = 0; j < 8; ++j) {
                const int col = (j * 64 + lane) * 4, h = col >> 7;
                const float l0 = lseb[((size_t)0 * MTOK + m) * NH + h], l1 = lseb[((size_t)1 * MTOK + m) * NH + h], l2 = lseb[((size_t)2 * MTOK + m) * NH + h];
                const float mx = fmaxf(l0, fmaxf(l1, l2));
                float w0 = __expf(l0 - mx), w1 = __expf(l1 - mx), w2 = __expf(l2 - mx); const float inv = 1.f / (w0 + w1 + w2); w0 *= inv; w1 *= inv; w2 *= inv;
                const uint2 a = *(const uint2*)(a0 + (size_t)m * DM + col), bq = *(const uint2*)(op1 + (size_t)m * DM + col), c = *(const uint2*)(op2 + (size_t)m * DM + col), z = *(const uint2*)(zA + (size_t)m * DM + col);
                const float r0 = (w0 * bflo(a.x) + w1 * bflo(bq.x) + w2 * bflo(c.x)) * silu(bflo(z.x)), r1 = (w0 * bfhi(a.x) + w1 * bfhi(bq.x) + w2 * bfhi(c.x)) * silu(bfhi(z.x));
                const float r2 = (w0 * bflo(a.y) + w1 * bflo(bq.y) + w2 * bflo(c.y)) * silu(bflo(z.y)), r3 = (w0 * bfhi(a.y) + w1 * bfhi(bq.y) + w2 * bfhi(c.y)) * silu(bfhi(z.y));
                *(uint2*)(a0 + (size_t)m * DM + col) = make_uint2(pk2(r0, r1), pk2(r2, r3));
            }
        }
    }
    grid.sync();
    {
        pg8::Gemm g{a0, WoA_t, MTOK, DM, DM, DM, DM}; pg8::StaticOrder S; S.init(MTOK, DM, G, (int)blockIdx.x);
        pg8::EpiK<2> E{y0b, (bf16_t*)ssq0};
        pg8::gemm_phase<pg8::EpiK<2>, pg8::StaticOrder, true, true>(lds, g, S, E);
    }
    grid.sync();
    { PHASE_VARS
    {   LAS float* scr = (LAS float*)(lds + wave * 16384);
        for (int it = gw; it < 1024; it += NGW) { const int sec = it >> 9, r = it & 511, kb = r >> 3, nb = r & 7;
            transpose_item(sec ? w1v : w1k, 256, nb * 32, 256, kb * 64, nullptr, W1t + (size_t)sec * 256 * 4096, 4096, nb * 32, scr, lane); } }
    for (int m = gw; m < MTOK; m += NGW) {
        float sp = (lane < 32) ? ssq0[(size_t)m * 32 + lane] : 0.f;
        const float r0 = rsqrtf(wave_sum(sp) * (1.f / DM) + 1e-6f);
        if (lane == 0) rstd0[m] = r0;
        const float4* xr = (const float4*)(x + (size_t)m * DM) + lane; const uint2* yr = (const uint2*)(y0b + (size_t)m * DM) + lane; const float4* gr = (const float4*)norm_post + lane;
        float4 hv[8]; float ss = 0.f;
#pragma unroll
        for (int j = 0; j < 8; ++j) {
            const float4 xv = xr[64 * j]; const uint2 yv = yr[64 * j]; const float4 gv = gr[64 * j];
            hv[j].x = xv.x + bflo(yv.x) * r0 * gv.x; hv[j].y = xv.y + bfhi(yv.x) * r0 * gv.y; hv[j].z = xv.z + bflo(yv.y) * r0 * gv.z; hv[j].w = xv.w + bfhi(yv.y) * r0 * gv.w;
            ss += (hv[j].x * hv[j].x + hv[j].y * hv[j].y) + (hv[j].z * hv[j].z + hv[j].w * hv[j].w);
        }
        const float rh = rsqrtf(wave_sum(ss) * (1.f / DM) + 1e-6f);
        uint2* o8 = (uint2*)(xhat1 + (size_t)m * DM) + lane;
#pragma unroll
        for (int j = 0; j < 8; ++j) o8[64 * j] = make_uint2(pk2(hv[j].x * rh, hv[j].y * rh), pk2(hv[j].z * rh, hv[j].w * rh));
    } }
    grid.sync();
    {
        pg8::Gemm g{xhat1, WB_t, MTOK, NWB, DM, DM, DM}; pg8::StaticOrder S; S.init(MTOK, NWB, G, (int)blockIdx.x);
        pg8::EpiK<3> E{qB, kvb};
        pg8::gemm_phase<pg8::EpiK<3>, pg8::StaticOrder, true, true>(lds, g, S, E);
    }
    grid.sync();
    {
        pg8::Gemm g{kvb, W1t, 4096, 256, 512, 2048, 4096}; pg8::CmpOrder S{(int)blockIdx.x};
        pg8::EpiPart E{cpart};
        pg8::gemm_phase<pg8::EpiPart, pg8::CmpOrder, false, true>(lds, g, S, E);
    }
    grid.sync();
    {
        PHASE_VARS
        const int sec = ((int)blockIdx.x * 2 >= G) ? 1 : 0, bl = (int)blockIdx.x - sec * (G / 2), nbl = G / 2;
        LAS float* W2s = (LAS float*)lds;
        { const float* w2 = sec ? w2v : w2k; for (int i = tid; i < 256 * 128 / 4; i += NTHREADS) *(LAS att::f32x4*)(W2s + 4 * i) = *(const att::f32x4*)(w2 + 4 * i); }
        __syncthreads();
        LAS float* hid = (LAS float*)(lds + 131072 + wave * 1024);
        for (int rr = bl * NWAVES + wave; rr < 2048; rr += nbl * NWAVES) {
            const int cbl = rr >> 9, b = (rr >> 7) & 3, c = rr & 127, row = (sec * 4 + cbl) * 512 + (rr & 511);
            bf16_t* dst = (sec ? vcmp : kcmp) + ((size_t)(b * 4 + cbl) * 128 + c) * HD;
            if (c == 127) { ((unsigned*)dst)[lane] = 0u; continue; }
            float4 a = *(const float4*)(posvec + sec * 256 + 4 * lane);
#pragma unroll
            for (int ks = 0; ks < 8; ++ks) { const float4 pv = *(const float4*)(cpart + ((size_t)ks * 4096 + row) * 256 + 4 * lane); a.x += pv.x; a.y += pv.y; a.z += pv.z; a.w += pv.w; }
            float hv[4] = {a.x, a.y, a.z, a.w};
#pragma unroll
            for (int j = 0; j < 4; ++j) { const float v = hv[j]; const float u = 0.7978845608028654f * (v + 0.044715f * v * v * v); hv[j] = 0.5f * v * (1.f + tanhf(u)); }
            *(LAS att::f32x4*)(hid + 4 * lane) = (att::f32x4){hv[0], hv[1], hv[2], hv[3]};
            asm volatile("s_waitcnt lgkmcnt(0)" ::: "memory");
            float o0 = 0.f, o1 = 0.f;
#pragma unroll 8
            for (int kq = 0; kq < 256; ++kq) { const float hq = hid[kq]; const pg8::f32x2 w = *(const LAS pg8::f32x2*)(W2s + kq * 128 + 2 * lane); o0 += hq * w[0]; o1 += hq * w[1]; }
            ((unsigned*)dst)[lane] = pk2(o0, o1);
            asm volatile("s_waitcnt lgkmcnt(0)" ::: "memory");
        }
    }
    grid.sync();
    {
        const int tid_ph = threadIdx.x; const int wave = __builtin_amdgcn_readfirstlane(tid_ph >> 6);
        const int jh = wave >> 1, sub = wave & 1;
        const int vcu = (G % 8 == 0) ? ((int)blockIdx.x % 8) * (G / 8) + (int)blockIdx.x / 8 : (int)blockIdx.x;
        LAS float* Tsel = (LAS float*)(lds + L_TSEL); LAS float* Twin = (LAS float*)(lds + L_TWIN);
        LAS float* impH = (LAS float*)(lds + L_IMPH);
        LAS unsigned* selm = (LAS unsigned*)(lds + L_SELM); LAS int* tl = (LAS int*)(lds + L_TL);
        const float NINF = -__builtin_inff();
        for (int pi = vcu; pi < 256; pi += G)
        for (int pass = 0; pass < 2; ++pass) {
            int tid = tid_ph; asm volatile("" : "+v"(tid));
            const int lane = tid & 63, r32 = lane & 31, hi = lane >> 5;
            const int bg = pi >> 4, qb = pass ? 31 - (pi & 15) : (pi & 15), b = bg >> 2, gq = bg & 3, h = gq * 4 + jh;
            const int tq = 64 * qb + 32 * sub + r32;
            const int grow0 = b * SEQ + 64 * qb + 32 * sub;
            for (int i = tid; i < 4 * 2112; i += NTHREADS) { const int hh = i / 2112, xx = i - hh * 2112, dist = xx - 64;
                Tsel[i] = dist >= 0 ? table[rel_bucket(dist) * NH + gq * 4 + hh] * (1.f / ATT_SCALE) : NINF; }
            for (int i = tid; i < 4 * 640; i += NTHREADS) { const int hh = i / 640, xx = i - hh * 640, delta = xx - 64;
                Twin[i] = (delta >= 0 && delta < 512) ? table[rel_bucket(delta) * NH + gq * 4 + hh] * (1.f / ATT_SCALE) : NINF; }
            const LAS float* Tsh = Tsel + jh * 2112; const LAS float* Twh = Twin + jh * 640;
            att::bf16x8 qr[8];
            { const bf16_t* qp = qB + ((size_t)h * MTOK + grow0 + r32) * HD + hi * 8;
#pragma unroll
              for (int d0 = 0; d0 < 8; ++d0) qr[d0] = *(const att::bf16x8*)(qp + d0 * 16); }
            att::f32x16 o[4];
            {
                const int sr = tid >> 4, sc = (tid & 15) * 8, vst0 = att::v_st(sr, sc), vst1 = att::v_st(32 + sr, sc), kws = ATT_KSWZ(sr, sc * 2);
                const bf16_t* Kc = kcmp + (size_t)bg * 128 * HD; const bf16_t* Vc = vcmp + (size_t)bg * 128 * HD;
#pragma unroll
                for (int tt = 0; tt < 2; ++tt) {
                    const size_t e0 = (size_t)(64 * tt + sr) * HD + sc, e1 = e0 + 32 * HD;
                    *(LAS att::bf16x8*)(lds + att::L_K + tt * att::SHM_K + kws) = *(const att::bf16x8*)(Kc + e0); *(LAS att::bf16x8*)(lds + att::L_K + tt * att::SHM_K + kws + 32 * 256) = *(const att::bf16x8*)(Kc + e1);
                    *(LAS att::bf16x8*)(lds + att::L_V + tt * att::SHM_V + vst0) = *(const att::bf16x8*)(Vc + e0); *(LAS att::bf16x8*)(lds + att::L_V + tt * att::SHM_V + vst1) = *(const att::bf16x8*)(Vc + e1);
                }
                __syncthreads();
                att::f32x16 pA0, pA1, pB0, pB1;
                const int xb = tq + 33 - 64 * hi;
#pragma unroll
                for (int r = 0; r < 16; ++r) { const int cr = 16 * ((r & 3) + 8 * (r >> 2));
                    pA0[r] = Tsh[max(xb - cr, 0)]; pA1[r] = Tsh[max(xb - cr - 512, 0)]; pB0[r] = Tsh[max(xb - cr - 1024, 0)]; pB1[r] = Tsh[max(xb - cr - 1536, 0)]; }
                {
                    const LAS unsigned char* kb[4];
#pragma unroll
                    for (int dd = 0; dd < 4; ++dd) kb[dd] = lds + att::L_K + ATT_KSWZ(r32, (dd * 16 + hi * 8) * 2);
#pragma unroll
                    for (int d0 = 0; d0 < 8; ++d0) { const LAS unsigned char* a = kb[d0 & 3] + (d0 >> 2) * 128;
                        pA0 = __builtin_amdgcn_mfma_f32_32x32x16_bf16(*(const LAS att::bf16x8*)a, qr[d0], pA0, 0, 0, 0);
                        pA1 = __builtin_amdgcn_mfma_f32_32x32x16_bf16(*(const LAS att::bf16x8*)(a + 32 * 256), qr[d0], pA1, 0, 0, 0);
                        pB0 = __builtin_amdgcn_mfma_f32_32x32x16_bf16(*(const LAS att::bf16x8*)(a + att::SHM_K), qr[d0], pB0, 0, 0, 0);
                        pB1 = __builtin_amdgcn_mfma_f32_32x32x16_bf16(*(const LAS att::bf16x8*)(a + att::SHM_K + 32 * 256), qr[d0], pB1, 0, 0, 0); }
                }
                float mx = NINF;
#pragma unroll
                for (int r = 0; r < 16; ++r) mx = fmaxf(fmaxf(mx, pA0[r]), fmaxf(fmaxf(pA1[r], pB0[r]), pB1[r]));
                { auto rr = __builtin_amdgcn_permlane32_swap(__float_as_uint(mx), __float_as_uint(mx), false, false); mx = fmaxf(__uint_as_float(rr[0]), __uint_as_float(rr[1])); }
                if (mx == NINF) mx = 0.f;
                const float mnL = -mx * att::C2; float ps = 0.f;
#pragma unroll
                for (int r = 0; r < 16; ++r) { pA0[r] = __builtin_amdgcn_exp2f(fmaf(pA0[r], att::C2, mnL)); pA1[r] = __builtin_amdgcn_exp2f(fmaf(pA1[r], att::C2, mnL));
                    pB0[r] = __builtin_amdgcn_exp2f(fmaf(pB0[r], att::C2, mnL)); pB1[r] = __builtin_amdgcn_exp2f(fmaf(pB1[r], att::C2, mnL)); ps += (pA0[r] + pA1[r]) + (pB0[r] + pB1[r]); }
                { auto rr = __builtin_amdgcn_permlane32_swap(__float_as_uint(ps), __float_as_uint(ps), false, false); ps = __uint_as_float(rr[0]) + __uint_as_float(rr[1]); }
                const float l_c = ps, inv = ps > 0.f ? 1.f / ps : 0.f;
                {
                    const int qrow = 32 * sub + r32; LAS float* ip = impH + (jh * 64 + qrow) * 32 + hi;
                    float eprev = 0.f;
#define IMP_GRP(P, U0) do { _Pragma("unroll") for (int q4 = 0; q4 < 4; ++q4) { \
                        const float gsum = ((P[4 * q4] + P[4 * q4 + 1]) + (P[4 * q4 + 2] + P[4 * q4 + 3])) * inv, e3 = P[4 * q4 + 3] * inv; \
                        const float eo = __uint_as_float(__builtin_amdgcn_permlane32_swap(__float_as_uint(e3), __float_as_uint(e3), false, false)[hi ? 0 : 1]);     \
                        const float ein = hi ? eo : eprev; eprev = eo; ip[2 * ((U0) + q4)] = gsum + ein; } } while (0)
                    IMP_GRP(pA0, 0); IMP_GRP(pA1, 4); IMP_GRP(pB0, 8); IMP_GRP(pB1, 12);
#undef IMP_GRP
                }
                att::bf16x8 pa0, pa1, pa2, pa3, pb0, pb1, pb2, pb3;
                ATT_PK4(pA0, 0, pa0); ATT_PK4(pA0, 8, pa1); ATT_PK4(pA1, 0, pa2); ATT_PK4(pA1, 8, pa3);
                ATT_PK4(pB0, 0, pb0); ATT_PK4(pB0, 8, pb1); ATT_PK4(pB1, 0, pb2); ATT_PK4(pB1, 8, pb3);
#pragma unroll
                for (int d_ = 0; d_ < 4; ++d_)
#pragma unroll
                    for (int r = 0; r < 16; ++r) o[d_][r] = 0.f;
                const int vb0 = att::L_V + att::v_rd_base(lane);
                att::pv_tile(o, vb0, pa0, pa1, pa2, pa3);
                att::pv_tile(o, vb0 + att::SHM_V, pb0, pb1, pb2, pb3);
                __syncthreads();
                GateF F{zB + (size_t)grow0 * 6144 + 0 * 2048 + h * HD, gB + (size_t)grow0 * 256 + 0 * 16 + h, a1 + (size_t)grow0 * DM + h * HD, 1};
                att::emit(lds, o, l_c, lane, wave, F);
                {
                    const int q = tid >> 3, n4 = (tid & 7) * 4, cur = qb;
                    float vals[32];
#pragma unroll
                    for (int i = 0; i < 8; ++i) {
                        att::f32x4 gv = *(const LAS att::f32x4*)(impH + (0 * 64 + q) * 32 + 4 * i);
                        gv += *(const LAS att::f32x4*)(impH + (1 * 64 + q) * 32 + 4 * i); gv += *(const LAS att::f32x4*)(impH + (2 * 64 + q) * 32 + 4 * i); gv += *(const LAS att::f32x4*)(impH + (3 * 64 + q) * 32 + 4 * i);
#pragma unroll
                        for (int e = 0; e < 4; ++e) { const int n = 4 * i + e; const bool forced = (n == 0) || (n == cur) || (n == cur - 1);
                            vals[n] = forced ? 1e9f : (n > cur ? -1e9f : gv[e]); } }
                    att::f32x4 mine = *(const LAS att::f32x4*)(impH + (0 * 64 + q) * 32 + n4);
                    mine += *(const LAS att::f32x4*)(impH + (1 * 64 + q) * 32 + n4); mine += *(const LAS att::f32x4*)(impH + (2 * 64 + q) * 32 + n4); mine += *(const LAS att::f32x4*)(impH + (3 * 64 + q) * 32 + n4);
                    unsigned bits = 0u;
#pragma unroll
                    for (int e = 0; e < 4; ++e) {
                        const int n = n4 + e; const bool forced = (n == 0) || (n == cur) || (n == cur - 1);
                        const float myv = forced ? 1e9f : (n > cur ? -1e9f : mine[e]);
                        int rank = 0;
#pragma unroll
                        for (int m2 = 0; m2 < 32; ++m2) rank += (vals[m2] > myv || (vals[m2] == myv && m2 < n)) ? 1 : 0;
                        if (rank < 16 && n <= cur) bits |= 1u << n;
                    }
                    bits |= __shfl_xor(bits, 1); bits |= __shfl_xor(bits, 2); bits |= __shfl_xor(bits, 4);
                    if ((tid & 7) == 0) selm[q] = bits;
                }
                __syncthreads();
                if (tid < 64) {
                    unsigned un = selm[lane];
#pragma unroll
                    for (int off = 1; off < 64; off <<= 1) un |= __shfl_xor(un, off);
                    if (lane < 32 && ((un >> lane) & 1u)) tl[__popc(un & ((1u << lane) - 1u))] = lane;
                    if (lane == 0) tl[32] = __popc(un);
                }
                __syncthreads();
            }
            {
                SelU U; U.K = kvb + ((size_t)(2 * 4 + gq) * MTOK + b * SEQ) * HD; U.V = kvb + ((size_t)(3 * 4 + gq) * MTOK + b * SEQ) * HD;
                U.tl = tl; U.ntl = __builtin_amdgcn_readfirstlane(tl[32]); U.mymask = selm[32 * sub + r32]; U.tq_off = tq - 4 * hi + 5; U.T = Tsh;
#pragma unroll
                for (int d_ = 0; d_ < 4; ++d_)
#pragma unroll
                    for (int r = 0; r < 16; ++r) o[d_][r] = 0.f;
                float m_reg = -1e30f, l_reg = 0.f;
                att::flash_tiles(lds, U, qr, o, m_reg, l_reg, tid, lane, wave);
                GateF F{zB + (size_t)grow0 * 6144 + 1 * 2048 + h * HD, gB + (size_t)grow0 * 256 + 1 * 16 + h, a1 + (size_t)grow0 * DM + h * HD, 0};
                att::emit(lds, o, l_reg, lane, wave, F);
            }
            {
                WinU U; U.K = kvb + ((size_t)(4 * 4 + gq) * MTOK + b * SEQ) * HD; U.V = kvb + ((size_t)(5 * 4 + gq) * MTOK + b * SEQ) * HD;
                const int jlo = qb < 8 ? 8 - qb : 0; U.tk_base = 64 * qb - 512 + 64 * jlo; U.ntl = 9 - jlo; U.tq_off = tq - 4 * hi + 5; U.T = Twh;
#pragma unroll
                for (int d_ = 0; d_ < 4; ++d_)
#pragma unroll
                    for (int r = 0; r < 16; ++r) o[d_][r] = 0.f;
                float m_reg = -1e30f, l_reg = 0.f;
                att::flash_tiles(lds, U, qr, o, m_reg, l_reg, tid, lane, wave);
                GateF F{zB + (size_t)grow0 * 6144 + 2 * 2048 + h * HD, gB + (size_t)grow0 * 256 + 2 * 16 + h, a1 + (size_t)grow0 * DM + h * HD, 0};
                att::emit(lds, o, l_reg, lane, wave, F);
            }
        }
    }
    grid.sync();
    {
        pg8::Gemm g{a1, WoB_t, MTOK, DM, DM, DM, DM}; pg8::StaticOrder S; S.init(MTOK, DM, G, (int)blockIdx.x);
        pg8::EpiK<2> E{y1b, (bf16_t*)ssq1};
        pg8::gemm_phase<pg8::EpiK<2>, pg8::StaticOrder, true, true>(lds, g, S, E);
    }
    grid.sync();
    { PHASE_VARS
    for (int m = gw; m < MTOK; m += NGW) {
        float sp = (lane < 32) ? ssq1[(size_t)m * 32 + lane] : 0.f;
        const float r1 = rsqrtf(wave_sum(sp) * (1.f / DM) + 1e-6f), r0 = rstd0[m];
        const float4* xr = (const float4*)(x + (size_t)m * DM) + lane; const uint2* y0r = (const uint2*)(y0b + (size_t)m * DM) + lane; const uint2* y1r = (const uint2*)(y1b + (size_t)m * DM) + lane;
        const float4* g0r = (const float4*)norm_post + lane; const float4* g1r = (const float4*)(norm_post + DM) + lane;
        float4* orow = (float4*)(p.out + (size_t)m * DM) + lane;
#pragma unroll
        for (int j = 0; j < 8; ++j) {
            const float4 xv = xr[64 * j]; const uint2 a = y0r[64 * j], bb = y1r[64 * j]; const float4 g0 = g0r[64 * j], g1 = g1r[64 * j];
            float4 o;
            o.x = xv.x + bflo(a.x) * r0 * g0.x + bflo(bb.x) * r1 * g1.x; o.y = xv.y + bfhi(a.x) * r0 * g0.y + bfhi(bb.x) * r1 * g1.y;
            o.z = xv.z + bflo(a.y) * r0 * g0.z + bflo(bb.y) * r1 * g1.z; o.w = xv.w + bfhi(a.y) * r0 * g0.w + bfhi(bb.y) * r1 * g1.w;
            orow[64 * j] = o;
        }
    } }
}

extern "C" void kernel_launch(void* const* d_in, const int* in_sizes, int n_in, void* d_out, int out_size, void* d_ws, size_t ws_size, hipStream_t stream) {
    static int grid = 0;
    if (grid == 0) {
        if (n_in != 16 || ws_size < WS_END) { fprintf(stderr, "kernel_launch: unexpected n_in %d / ws_size %zu\n", n_in, ws_size); grid = -1; return; }
        int dev = 0, cus = 0, per_cu = 0;
        (void)hipGetDevice(&dev); (void)hipDeviceGetAttribute(&cus, hipDeviceAttributeMultiprocessorCount, dev);
        if (hipFuncSetAttribute((const void*)yoco_fwd, hipFuncAttributeMaxDynamicSharedMemorySize, LDS_BYTES) != hipSuccess) { fprintf(stderr, "kernel_launch: hipFuncSetAttribute failed\n"); grid = -1; return; }
        if (hipOccupancyMaxActiveBlocksPerMultiprocessor(&per_cu, (const void*)yoco_fwd, NTHREADS, LDS_BYTES) != hipSuccess || per_cu < 1) { fprintf(stderr, "kernel_launch: occupancy query says %d\n", per_cu); per_cu = 1; }
        (void)hipGetLastError();
        grid = cus;
        if (grid != 256) fprintf(stderr, "kernel_launch: note: %d CUs\n", grid);
    }
    if (grid < 0) return;
    Params prm{};
    for (int i = 0; i < 16; ++i) prm.in[i] = (const float*)d_in[i];
    prm.out = (float*)d_out; prm.ws = (unsigned char*)d_ws;
    void* args[] = {&prm};
    hipError_t e = hipLaunchCooperativeKernel((const void*)yoco_fwd, dim3(grid), dim3(NTHREADS), args, LDS_BYTES, stream);
    if (e != hipSuccess) fprintf(stderr, "kernel_launch: cooperative launch failed: %s (grid %d)\n", hipGetErrorString(e), grid);
}
```

```cpp
#include <hip/hip_runtime.h>
#include <hip/hip_cooperative_groups.h>
#include <cstdio>
#include <cstdint>
namespace cg = cooperative_groups;

namespace pg8 {
#define PG8_LAS __attribute__((address_space(3)))
typedef unsigned short bf16_t;
typedef short bf16x8 __attribute__((ext_vector_type(8)));
typedef float f32x4 __attribute__((ext_vector_type(4)));
typedef unsigned u32x4 __attribute__((ext_vector_type(4)));
constexpr int BM = 256, BK = 64, HALF = 128, HTB = HALF * BK * 2  , STAGE_BYTES = 8 * HTB, NXCD = 8, WGM = 8;

__host__ __device__ __forceinline__ int lds_byte(int r, int c) { const int st = (r >> 4) * 2 + (c >> 5), rr = r & 15, cc = c & 31, ob = rr * 64 + cc * 2; return st * 1024 + (ob ^ (((ob >> 9) & 1) << 5)); }
__host__ __device__ __forceinline__ void stage_rc(int b, int& R, int& C) { const int st = b / 1024, sb = b % 1024, swz = sb ^ (((sb >> 9) & 1) << 5); R = (st >> 1) * 16 + swz / 64; C = (st & 1) * 32 + (swz % 64) / 2; }
__host__ __device__ __forceinline__ int perm32(int rho) { const int n = rho >> 4, i = rho & 15; return 8 * (i >> 2) + 4 * n + (i & 3); }

struct Unit { int pm, pn; };
struct Gemm { const bf16_t* A; const bf16_t* Bt; int M, N, K, lda, ldb; };

struct StaticOrder {
    int nM, nN, nwg, G, c;
    __host__ __device__ void init(int M, int N, int G_, int c_) { nM = M / BM; nN = N / BM; nwg = nM * nN; G = G_; c = c_; }
    __host__ __device__ bool next(int i, Unit& u) const {
        const long L = (long)i * G + c; if (L >= nwg) return false;
        int wgid = (int)L; { const int q = nwg / NXCD, r = nwg % NXCD, xcd = wgid % NXCD, off = wgid / NXCD; wgid = (xcd < r ? xcd * (q + 1) : r * (q + 1) + (xcd - r) * q) + off; }
        const int nig = WGM * nN, gid = wgid / nig, fm = gid * WGM, gsz = (nM - fm) < WGM ? (nM - fm) : WGM;
        u.pm = fm + ((wgid % nig) % gsz); u.pn = (wgid % nig) / gsz; return true;
    }
    __device__ __forceinline__ void a_ready(const Unit&) const {}
    __device__ __forceinline__ void done(const Unit&) const {}
    __device__ __forceinline__ const char* abase(const Gemm& g, const Unit& u) const { return (const char*)g.A + (size_t)u.pm * BM * g.lda * 2; }
    __device__ __forceinline__ const char* bbase(const Gemm& g, const Unit& u) const { return (const char*)g.Bt + (size_t)u.pn * BM * g.ldb * 2; }
};

__device__ __forceinline__ unsigned cvt_pk_bf16(float lo, float hi) { unsigned r; asm volatile("v_cvt_pk_bf16_f32 %0, %1, %2" : "=v"(r) : "v"(lo), "v"(hi)); return r; }
typedef float f32x2 __attribute__((ext_vector_type(2)));

template <int KIND> struct EpiK {
    static constexpr bool PERM = true, AFTER_DRAIN = false;
    bf16_t* b0; bf16_t* b1;
    __device__ __forceinline__ void operator()(const f32x4 (&acc)[2][2][4][2], const Unit& u, int wr, int wc, int fr, int fq) const {
        bf16_t* base; bool hm; int ld = 2048, pr = u.pn;
        if (KIND == 1) { if (u.pn < 24) { base = b0; hm = true; } else { base = b1; hm = false; pr = u.pn - 24; } }
        else if (KIND == 2) { base = b0; hm = false; }
        else { if (u.pn < 8) { base = b0; hm = true; } else if (u.pn < 32) { base = b0 + (size_t)16 * 1024 * 1024; hm = false; ld = 6144; pr = u.pn - 8; }
               else if (u.pn < 44) { base = b1; hm = true; pr = u.pn - 32; } else { base = b1 + (size_t)24 * 1024 * 1024; hm = false; ld = 256; pr = 0; } }
        const int row0 = u.pm * BM + wr * 64 + fr;
        const int cin = wc * 32 + 8 * fq;
#pragma unroll
        for (int ai = 0; ai < 2; ++ai)
#pragma unroll
            for (int m = 0; m < 4; ++m) {
                const int row = row0 + ai * HALF + m * 16;
                float s = 0.f;
#pragma unroll
                for (int bj = 0; bj < 2; ++bj) {
                    const f32x4 v0 = acc[ai][bj][m][0], v1 = acc[ai][bj][m][1];
                    if (KIND == 2) s += (v0[0] * v0[0] + v0[1] * v0[1]) + (v0[2] * v0[2] + v0[3] * v0[3]) + (v1[0] * v1[0] + v1[1] * v1[1]) + (v1[2] * v1[2] + v1[3] * v1[3]);
                    u32x4 w; w.x = cvt_pk_bf16(v0[0], v0[1]); w.y = cvt_pk_bf16(v0[2], v0[3]); w.z = cvt_pk_bf16(v1[0], v1[1]); w.w = cvt_pk_bf16(v1[2], v1[3]);
                    bf16_t* dst = hm ? base + ((size_t)(pr * 2 + bj) * 8192 + row) * 128 + cin
                                     : base + (size_t)row * ld + pr * 256 + bj * HALF + cin;
                    *(u32x4*)dst = w;
                }
                if (KIND == 2) { s += __shfl_xor(s, 16); s += __shfl_xor(s, 32); if (fq == 0) ((float*)b1)[(size_t)row * 32 + u.pn * 4 + wc] = s; }
            }
    }
};

struct EpiPart {
    static constexpr bool PERM = true, AFTER_DRAIN = false;
    bf16_t* part;
    __device__ __forceinline__ void operator()(const f32x4 (&acc)[2][2][4][2], const Unit& u, int wr, int wc, int fr, int fq) const {
        bf16_t* base = part + ((size_t)u.pn * 4096 + (size_t)u.pm * BM + wr * 64 + fr) * 256 + wc * 32 + 8 * fq;
#pragma unroll
        for (int ai = 0; ai < 2; ++ai)
#pragma unroll
            for (int m = 0; m < 4; ++m)
#pragma unroll
                for (int bj = 0; bj < 2; ++bj) {
                    const f32x4 v0 = acc[ai][bj][m][0], v1 = acc[ai][bj][m][1];
                    u32x4 w; w.x = cvt_pk_bf16(v0[0], v0[1]); w.y = cvt_pk_bf16(v0[2], v0[3]); w.z = cvt_pk_bf16(v1[0], v1[1]); w.w = cvt_pk_bf16(v1[2], v1[3]);
                    *(u32x4*)(base + (size_t)(ai * HALF + m * 16) * 256 + bj * HALF) = w; }
    }
};
struct P5Order : StaticOrder {
    unsigned* cnt; int lastkv; mutable int ui; PG8_LAS unsigned* elect;
    __device__ __forceinline__ bool next(int i, Unit& u) const { if (!StaticOrder::next(i, u)) return false; u.pn = u.pn + 32 >= nN ? u.pn + 32 - nN : u.pn + 32; return true; }
    __device__ __forceinline__ void done(const Unit&) const {
        if (ui++ == lastkv) { asm volatile("s_waitcnt vmcnt(0)" ::: "memory");
            unsigned prev = 0u; if ((threadIdx.x & 63) == 0) prev = __hip_atomic_fetch_add(elect, 1u, __ATOMIC_RELAXED, __HIP_MEMORY_SCOPE_WORKGROUP);
            if ((unsigned)__builtin_amdgcn_readfirstlane((int)prev) == 7u) {
                __builtin_amdgcn_fence(__ATOMIC_RELEASE, "agent"); asm volatile("s_waitcnt vmcnt(0)" ::: "memory");
                if ((threadIdx.x & 63) == 0) { (void)__hip_atomic_fetch_add(cnt, 1u, __ATOMIC_RELAXED, __HIP_MEMORY_SCOPE_AGENT); __hip_atomic_store(elect, 0u, __ATOMIC_RELAXED, __HIP_MEMORY_SCOPE_WORKGROUP); } } }
    }
};
struct CmpOrder {
    int c, G, first; const unsigned* cnt; unsigned need; unsigned* tmo;
    __device__ __forceinline__ bool next(int i, Unit& u) const { const int j = (c - first + G) % G + i * G; if (j >= 64) return false; u.pm = j >> 2; u.pn = j & 3; return true; }
    __device__ __forceinline__ void a_ready(const Unit&) const {
        if (threadIdx.x < 64) {
            unsigned sp = 0u;
            while ((unsigned)__builtin_amdgcn_readfirstlane(__hip_atomic_load(cnt, __ATOMIC_RELAXED, __HIP_MEMORY_SCOPE_AGENT)) < need) {
                __builtin_amdgcn_s_sleep(2);
                if ((++sp & 255u) == 0u) { if (__hip_atomic_load(tmo, __ATOMIC_RELAXED, __HIP_MEMORY_SCOPE_AGENT)) break; if (sp > (1u << 18)) { atomicAdd(tmo, 1u); break; } } }
            __builtin_amdgcn_fence(__ATOMIC_ACQUIRE, "agent");
            asm volatile("s_waitcnt vmcnt(0)" ::: "memory");
        }
        asm volatile("" ::: "memory"); __builtin_amdgcn_s_barrier(); asm volatile("" ::: "memory");
    }
    __device__ __forceinline__ void done(const Unit&) const {}
    __device__ __forceinline__ const char* abase(const Gemm& g, const Unit& u) const { const int cb = u.pm >> 1, mt = u.pm & 1; return (const char*)g.A + ((size_t)cb * 8192 * 128 + (size_t)mt * 256 * 2048 + (size_t)u.pn * 1024) * 2; }
    __device__ __forceinline__ const char* bbase(const Gemm& g, const Unit& u) const { const int sec = u.pm >> 3; return (const char*)g.Bt + ((size_t)sec * 256 * 4096 + (size_t)u.pn * 1024) * 2; }
};
template <class Epi, class Sched, bool ALIGN_EPI = false, bool SP2 = false>
__device__ __forceinline__ void gemm_phase(PG8_LAS unsigned char* lds, const Gemm g, const Sched& S, const Epi& E) {
    int tid_raw = threadIdx.x; asm volatile("" : "+v"(tid_raw));
    const int tid = tid_raw, wid = __builtin_amdgcn_readfirstlane(tid >> 6), lane = tid & 63, wr = wid >> 2, wc = wid & 3, fr = lane & 15, fq = lane >> 4;
    const int K = g.K, nt = K / BK;
    unsigned voffA[2], voffB[2];
#pragma unroll
    for (int i = 0; i < 2; ++i) { int R, C; stage_rc(tid * 16 + i * 8192, R, C); const int Rb = Epi::PERM ? ((R & ~31) + perm32(R & 31)) : R;
        voffA[i] = (unsigned)(R * g.lda + C) * 2u; voffB[i] = (unsigned)(Rb * g.ldb + C) * 2u; }
    const size_t kstep = (size_t)(BK * 2);
    const size_t hstepA = (size_t)HALF * g.lda * 2, hstepB = (size_t)HALF * g.ldb * 2;
    const unsigned ldsw = (unsigned)wid * 1024u;
    const int aoff = lds_byte(wr * 64 + fr, fq * 8), boff = lds_byte(wc * 32 + fr, fq * 8);
#define PG8_SA(b, h) (((b) * 2 + (h)) * HTB)
#define PG8_SB(b, h) ((4 + (b) * 2 + (h)) * HTB)
#define PG8_STAGE(bufoff, gbase, voff) do { _Pragma("unroll") for (int _i = 0; _i < 2; ++_i) \
        __builtin_amdgcn_global_load_lds((const unsigned*)((const char*)(gbase) + (voff)[_i]), (PG8_LAS unsigned*)(lds + (bufoff) + ldsw + _i * 8192), 16, 0, 0); } while (0)
#define PG8_LDA(dst, b, h) do { _Pragma("unroll") for (int m = 0; m < 4; ++m) _Pragma("unroll") for (int k = 0; k < 2; ++k) dst[m][k] = *(const PG8_LAS bf16x8*)(lds + PG8_SA(b, h) + aoff + m * 2048 + k * 1024); } while (0)
#define PG8_LDB(dst, b, h) do { _Pragma("unroll") for (int n = 0; n < 2; ++n) _Pragma("unroll") for (int k = 0; k < 2; ++k) dst[n][k] = *(const PG8_LAS bf16x8*)(lds + PG8_SB(b, h) + boff + n * 2048 + k * 1024); } while (0)
#define PG8_MMA(ai, bj, At, Bt) do { __builtin_amdgcn_s_setprio(1); _Pragma("unroll") for (int m = 0; m < 4; ++m) _Pragma("unroll") for (int n = 0; n < 2; ++n) _Pragma("unroll") for (int k = 0; k < 2; ++k) \
        acc[ai][bj][m][n] = __builtin_amdgcn_mfma_f32_16x16x32_bf16(Bt[n][k], At[m][k], acc[ai][bj][m][n], 0, 0, 0); __builtin_amdgcn_s_setprio(0); } while (0)
#define PG8_WAIT_V(n) asm volatile("s_waitcnt vmcnt(" #n ")" ::: "memory")
#define PG8_WAIT_L(n) asm volatile("s_waitcnt lgkmcnt(" #n ")" ::: "memory")
#define PG8_BAR __builtin_amdgcn_s_barrier()
#define PG8_SCHED __builtin_amdgcn_sched_barrier(0)
    Unit cur, nxt; int ui = 0;
    if (!S.next(0, cur)) return;
    f32x4 acc[2][2][4][2];
#pragma unroll
    for (int a = 0; a < 2; ++a)
#pragma unroll
        for (int b = 0; b < 2; ++b)
#pragma unroll
            for (int m = 0; m < 4; ++m)
#pragma unroll
                for (int n = 0; n < 2; ++n) acc[a][b][m][n] = (f32x4){0.f, 0.f, 0.f, 0.f};
    bf16x8 At[4][2], B0[2][2], B1[2][2];
    const char* cA = S.abase(g, cur); const char* cB = S.bbase(g, cur);
    S.a_ready(cur);
    if constexpr (SP2) {
        PG8_STAGE(PG8_SB(0, 0), cB, voffB); PG8_STAGE(PG8_SB(0, 1), cB + hstepB, voffB); PG8_STAGE(PG8_SA(0, 0), cA, voffA); PG8_STAGE(PG8_SA(0, 1), cA + hstepA, voffA);
        if (wr == 1) PG8_BAR;
        PG8_WAIT_V(2); PG8_BAR;
        PG8_STAGE(PG8_SB(1, 0), cB + kstep, voffB); PG8_STAGE(PG8_SA(1, 0), cA + kstep, voffA); PG8_STAGE(PG8_SB(1, 1), cB + hstepB + kstep, voffB);
        PG8_WAIT_V(6); PG8_BAR;
    } else {
        PG8_STAGE(PG8_SB(0, 0), cB, voffB); PG8_STAGE(PG8_SA(0, 0), cA, voffA); PG8_STAGE(PG8_SB(0, 1), cB + hstepB, voffB); PG8_STAGE(PG8_SA(0, 1), cA + hstepA, voffA);
        if (wr == 1) PG8_BAR;
        PG8_WAIT_V(4); PG8_BAR;
        PG8_STAGE(PG8_SB(1, 0), cB + kstep, voffB); PG8_STAGE(PG8_SA(1, 0), cA + kstep, voffA); PG8_STAGE(PG8_SB(1, 1), cB + hstepB + kstep, voffB);
        PG8_WAIT_V(6); PG8_BAR;
    }
    for (;;) {
        const bool has_next = S.next(ui + 1, nxt);
        const char* nA = has_next ? S.abase(g, nxt) : cA; const char* nB = has_next ? S.bbase(g, nxt) : cB;
        for (int t = 0; t < nt; t += 2) {
            const bool last = (t == nt - 2);
            const char* a1 = cA + (size_t)(t + 1) * kstep;
            const char* a2 = last ? nA : cA + (size_t)(t + 2) * kstep; const char* b2 = last ? nB : cB + (size_t)(t + 2) * kstep;
            const char* a3 = a2 + kstep; const char* b3 = b2 + kstep;
            if (last && has_next) S.a_ready(nxt);
            if constexpr (SP2) {
            PG8_LDB(B0, 0, 0); PG8_LDB(B1, 0, 1); PG8_SCHED; PG8_LDA(At, 0, 0); PG8_STAGE(PG8_SA(1, 1), a1 + hstepA, voffA);
            PG8_WAIT_V(8); PG8_WAIT_L(0); PG8_BAR; PG8_MMA(0, 0, At, B0); PG8_MMA(0, 1, At, B1); PG8_BAR; PG8_SCHED;
            PG8_LDA(At, 0, 1); PG8_STAGE(PG8_SB(0, 0), b2, voffB); PG8_STAGE(PG8_SB(0, 1), b2 + hstepB, voffB); PG8_STAGE(PG8_SA(0, 0), a2, voffA);
            PG8_WAIT_V(8); PG8_WAIT_L(0); PG8_BAR; PG8_MMA(1, 0, At, B0); PG8_MMA(1, 1, At, B1); PG8_BAR; PG8_SCHED;
            PG8_LDB(B0, 1, 0); PG8_LDB(B1, 1, 1); PG8_SCHED; PG8_LDA(At, 1, 0); PG8_STAGE(PG8_SA(0, 1), a2 + hstepA, voffA);
            PG8_WAIT_V(8); PG8_WAIT_L(0); PG8_BAR; PG8_MMA(0, 0, At, B0); PG8_MMA(0, 1, At, B1); PG8_BAR; PG8_SCHED;
            PG8_LDA(At, 1, 1); PG8_STAGE(PG8_SB(1, 0), b3, voffB); PG8_STAGE(PG8_SB(1, 1), b3 + hstepB, voffB); PG8_STAGE(PG8_SA(1, 0), a3, voffA);
            PG8_WAIT_V(8); PG8_WAIT_L(0); PG8_BAR; PG8_MMA(1, 0, At, B0); PG8_MMA(1, 1, At, B1); PG8_BAR; PG8_SCHED;
            } else {
            PG8_LDB(B0, 0, 0); PG8_SCHED; PG8_LDA(At, 0, 0); PG8_STAGE(PG8_SA(1, 1), a1 + hstepA, voffA);
            PG8_WAIT_L(8); PG8_BAR; PG8_WAIT_L(0); PG8_MMA(0, 0, At, B0); PG8_BAR; PG8_SCHED;
            PG8_LDB(B1, 0, 1); PG8_STAGE(PG8_SB(0, 0), b2, voffB);
            PG8_BAR; PG8_WAIT_L(0); PG8_MMA(0, 1, At, B1); PG8_BAR;
            PG8_LDA(At, 0, 1); PG8_STAGE(PG8_SA(0, 0), a2, voffA);
            PG8_BAR; PG8_WAIT_L(0); PG8_MMA(1, 0, At, B0); PG8_BAR; PG8_SCHED;
            PG8_STAGE(PG8_SB(0, 1), b2 + hstepB, voffB);
            PG8_WAIT_V(6); PG8_BAR; PG8_MMA(1, 1, At, B1); PG8_BAR;
            PG8_LDB(B0, 1, 0); PG8_SCHED; PG8_LDA(At, 1, 0); PG8_STAGE(PG8_SA(0, 1), a2 + hstepA, voffA);
            PG8_WAIT_L(8); PG8_BAR; PG8_WAIT_L(0); PG8_MMA(0, 0, At, B0); PG8_BAR; PG8_SCHED;
            PG8_LDB(B1, 1, 1); PG8_STAGE(PG8_SB(1, 0), b3, voffB);
            PG8_BAR; PG8_WAIT_L(0); PG8_MMA(0, 1, At, B1); PG8_BAR;
            PG8_LDA(At, 1, 1); PG8_STAGE(PG8_SA(1, 0), a3, voffA);
            PG8_BAR; PG8_WAIT_L(0); PG8_MMA(1, 0, At, B0); PG8_BAR; PG8_SCHED;
            PG8_STAGE(PG8_SB(1, 1), b3 + hstepB, voffB);
            PG8_WAIT_V(6); PG8_BAR; PG8_MMA(1, 1, At, B1); PG8_BAR;
            }
        }
        if constexpr (ALIGN_EPI) { if (wr == 0) PG8_BAR; }
        if constexpr (!Epi::AFTER_DRAIN) { E(acc, cur, wr, wc, fr, fq); S.done(cur); }
        if (!has_next) break;
#pragma unroll
        for (int a = 0; a < 2; ++a)
#pragma unroll
            for (int b = 0; b < 2; ++b)
#pragma unroll
                for (int m = 0; m < 4; ++m)
#pragma unroll
                    for (int n = 0; n < 2; ++n) acc[a][b][m][n] = (f32x4){0.f, 0.f, 0.f, 0.f};
        cur = nxt; cA = nA; cB = nB; ++ui;
        if constexpr (ALIGN_EPI) { if (wr == 1) PG8_BAR; }
    }
    PG8_WAIT_V(0);
    if constexpr (!ALIGN_EPI) { if (wr == 0) PG8_BAR; }
    PG8_BAR;
    if constexpr (Epi::AFTER_DRAIN) { E.fused(acc, cur, wr, wc, fr, fq, lds, wid, lane); S.done(cur); }
#undef PG8_SA
#undef PG8_SB
#undef PG8_STAGE
#undef PG8_LDA
#undef PG8_LDB
#undef PG8_MMA
#undef PG8_WAIT_V
#undef PG8_WAIT_L
#undef PG8_BAR
#undef PG8_SCHED
}
}

#define LAS __attribute__((address_space(3)))
typedef unsigned short bf16_t;
typedef unsigned u32x4 __attribute__((ext_vector_type(4)));
constexpr int DM = 2048, NB = 4, SEQ = 2048, NH = 16, HD = 128, MTOK = NB * SEQ;
constexpr int NCMP = 127;
constexpr float ATT_SCALE = 0.08838834764831845f;
constexpr float QSC = ATT_SCALE * 1.4426950408889634f;
constexpr float NEGF = -1e30f;
constexpr size_t MiB = 1u << 20;
constexpr size_t WS_QKVA = 0, WS_ZA = 96 * MiB;
constexpr size_t WS_QB = 0, WS_ZB = 32 * MiB;
constexpr size_t WS_Y1 = 0;
constexpr size_t WS_B = 128 * MiB;
constexpr size_t WS_WB = 160 * MiB;
constexpr size_t WS_WOA = 205 * MiB, WS_WOB = 213 * MiB;
constexpr size_t WS_Y0 = 221 * MiB;
constexpr size_t WS_SSQ0 = 253 * MiB, WS_SSQ1 = 254 * MiB, WS_RSTD0 = 255 * MiB;
constexpr size_t WS_BAR = 255 * MiB + 131072;
constexpr size_t WS_END = 256 * MiB;
constexpr size_t DO_XHAT0 = 0;
constexpr size_t DO_KVB = 0;
constexpr size_t DO_GB = 48 * MiB;
constexpr size_t DO_KCMP = 52 * MiB, DO_VCMP = 53 * MiB;
constexpr int NWB = 11520;

struct Params { const float* in[16]; float* out; unsigned char* ws; };

__device__ __forceinline__ float4 ldnt4(const float4* p) { typedef float f4v __attribute__((ext_vector_type(4))); const f4v v = __builtin_nontemporal_load((const f4v*)p); return make_float4(v[0], v[1], v[2], v[3]); }
__device__ __forceinline__ uint2 ldnt2(const uint2* p) { typedef unsigned u2v __attribute__((ext_vector_type(2))); const u2v v = __builtin_nontemporal_load((const u2v*)p); return make_uint2(v[0], v[1]); }
__device__ __forceinline__ uint4 ldnt4u(const uint4* p) { typedef unsigned u4v __attribute__((ext_vector_type(4))); const u4v v = __builtin_nontemporal_load((const u4v*)p); return make_uint4(v[0], v[1], v[2], v[3]); }
__device__ __forceinline__ float bf2f(unsigned u16) { return __uint_as_float(u16 << 16); }
__device__ __forceinline__ float bflo(unsigned w) { return __uint_as_float(w << 16); }
__device__ __forceinline__ float bfhi(unsigned w) { return __uint_as_float(w & 0xffff0000u); }
__device__ __forceinline__ unsigned f2bf(float f) { unsigned u = __float_as_uint(f); return (u + 0x7fffu + ((u >> 16) & 1u)) >> 16; }
__device__ __forceinline__ unsigned pk2(float lo, float hi) { return f2bf(lo) | (f2bf(hi) << 16); }
__device__ __forceinline__ float wave_sum(float v) {
#pragma unroll
    for (int o = 32; o >= 1; o >>= 1) v += __shfl_xor(v, o);
    return v;
}
__device__ __forceinline__ float wave_max(float v) {
#pragma unroll
    for (int o = 32; o >= 1; o >>= 1) v = fmaxf(v, __shfl_xor(v, o));
    return v;
}
__device__ __forceinline__ int rel_bucket(int dist) {
    int n = dist > 0 ? dist : 0;
    if (n < 16) return n;
    int b = 16;
    b += (n >= 22); b += (n >= 30); b += (n >= 40); b += (n >= 54); b += (n >= 73); b += (n >= 99); b += (n >= 134); b += (n >= 182);
    b += (n >= 246); b += (n >= 332); b += (n >= 450); b += (n >= 609); b += (n >= 825); b += (n >= 1117); b += (n >= 1513);
    return b;
}
__device__ __forceinline__ float frcp(float x) { return __builtin_amdgcn_rcpf(x); }
__device__ __forceinline__ float silu(float z) { return z * frcp(1.f + __expf(-z)); }

struct TItem { const float* W; const float* g; bf16_t* WT; int ldw, c0, ncv, k0, K, r0; float sc; };
__device__ __forceinline__ void titem_load64(const TItem& t, float (&v)[64], int lane) {
    const int c = t.c0 + lane; const float* p = t.W + (size_t)t.k0 * t.ldw + c; const bool ok = c < t.ncv;
#pragma unroll
    for (int i = 0; i < 64; ++i) v[i] = ok ? __builtin_nontemporal_load(p + (size_t)i * t.ldw) : 0.f;
}
__device__ __forceinline__ void titem_store64(const TItem& t, const float (&v)[64], LAS float* scr, int lane) {
#pragma unroll
    for (int i = 0; i < 64; ++i) scr[i * 65 + lane] = v[i];
    const int c = lane & 7;
    float gk[8];
#pragma unroll
    for (int j = 0; j < 8; ++j) gk[j] = (t.g ? t.g[t.k0 + 8 * c + j] : 1.f) * t.sc;
    asm volatile("s_waitcnt lgkmcnt(0)" ::: "memory");
#pragma unroll
    for (int j = 0; j < 8; ++j) {
        const int n = (lane >> 3) + 8 * j; const LAS float* s = scr + (8 * c) * 65 + n;
        u32x4 o; o.x = pk2(s[0 * 65] * gk[0], s[1 * 65] * gk[1]); o.y = pk2(s[2 * 65] * gk[2], s[3 * 65] * gk[3]); o.z = pk2(s[4 * 65] * gk[4], s[5 * 65] * gk[5]); o.w = pk2(s[6 * 65] * gk[6], s[7 * 65] * gk[7]);
        *(u32x4*)(t.WT + (size_t)(t.r0 + n) * t.K + t.k0 + 8 * c) = o;
    }
    asm volatile("s_waitcnt lgkmcnt(0)" ::: "memory");
}
__device__ __forceinline__ void titem_load(const TItem& t, float (&v)[32], int lane) {
    const int c = t.c0 + (lane & 31); const float* p = t.W + (size_t)(t.k0 + (lane >> 5)) * t.ldw + c; const bool ok = c < t.ncv;
#pragma unroll
    for (int i = 0; i < 32; ++i) v[i] = ok ? p[(size_t)(2 * i) * t.ldw] : 0.f;
}
__device__ __forceinline__ void titem_store(const TItem& t, const float (&v)[32], LAS float* scr, int lane) {
#pragma unroll
    for (int i = 0; i < 32; ++i) scr[(2 * i + (lane >> 5)) * 33 + (lane & 31)] = v[i];
    const int c = lane & 7;
    float gk[8];
#pragma unroll
    for (int j = 0; j < 8; ++j) gk[j] = (t.g ? t.g[t.k0 + 8 * c + j] : 1.f) * t.sc;
    asm volatile("s_waitcnt lgkmcnt(0)" ::: "memory");
#pragma unroll
    for (int j = 0; j < 4; ++j) {
        const int n = (lane >> 3) + 8 * j; const LAS float* s = scr + (8 * c) * 33 + n;
        u32x4 o; o.x = pk2(s[0 * 33] * gk[0], s[1 * 33] * gk[1]); o.y = pk2(s[2 * 33] * gk[2], s[3 * 33] * gk[3]); o.z = pk2(s[4 * 33] * gk[4], s[5 * 33] * gk[5]); o.w = pk2(s[6 * 33] * gk[6], s[7 * 33] * gk[7]);
        *(u32x4*)(t.WT + (size_t)(t.r0 + n) * t.K + t.k0 + 8 * c) = o;
    }
    asm volatile("s_waitcnt lgkmcnt(0)" ::: "memory");
}
__device__ __forceinline__ void transpose_item(const float* W, int ldw, int c0, int ncv, int k0, const float* g, bf16_t* WT, int K, int r0, LAS float* scr, int lane) {
    TItem t{W, g, WT, ldw, c0, ncv, k0, K, r0, 1.f}; float v[32]; titem_load(t, v, lane); titem_store(t, v, scr, lane);
}
__device__ __forceinline__ void rms_row_bf16(const float* xrow, bf16_t* orow, int lane) {
    const float4* xr = (const float4*)xrow + lane;
    float4 v[8]; float ss = 0.f;
#pragma unroll
    for (int j = 0; j < 8; ++j) { v[j] = ldnt4(xr + 64 * j); ss += (v[j].x * v[j].x + v[j].y * v[j].y) + (v[j].z * v[j].z + v[j].w * v[j].w); }
    const float r = rsqrtf(wave_sum(ss) * (1.f / DM) + 1e-6f);
    uint2* o8 = (uint2*)orow + lane;
#pragma unroll
    for (int j = 0; j < 8; ++j) o8[64 * j] = make_uint2(pk2(v[j].x * r, v[j].y * r), pk2(v[j].z * r, v[j].w * r));
}

__device__ __forceinline__ float dot_row(const LAS float* qs, const bf16_t* krow) {
    const uint4* kp = (const uint4*)krow; float acc = 0.f;
#pragma unroll 4
    for (int i = 0; i < 16; ++i) {
        const uint4 w = kp[i]; const LAS float* q = qs + 8 * i;
        acc += q[0] * bflo(w.x) + q[1] * bfhi(w.x) + q[2] * bflo(w.y) + q[3] * bfhi(w.y) + q[4] * bflo(w.z) + q[5] * bfhi(w.z) + q[6] * bflo(w.w) + q[7] * bfhi(w.w);
    }
    return acc;
}
__device__ __forceinline__ void wave_chunk(const LAS float* qs, const bf16_t* Kb, const bf16_t* Vb, bool valid, int row, float bias,
                                           float& m, float& l, float& o0, float& o1, int lane) {
    float s = NEGF;
    if (valid) s = dot_row(qs, Kb + (size_t)row * HD) * ATT_SCALE + bias;
    const float cm = wave_max(s);
    const float mn = fmaxf(m, cm);
    const float p = valid ? __expf(s - mn) : 0.f;
    const float alpha = __expf(m - mn);
    l = l * alpha + wave_sum(p);
    o0 *= alpha; o1 *= alpha; m = mn;
    const float pb = bf2f(f2bf(p));
    const unsigned long long act = __ballot(pb != 0.f);
    for (int j = 0; j < 64; ++j) {
        if (!((act >> j) & 1ull)) continue;
        const float pj = __shfl(pb, j); const int rj = __shfl(row, j);
        const unsigned w = ((const unsigned*)(Vb + (size_t)rj * HD))[lane];
        o0 += pj * bflo(w); o1 += pj * bfhi(w);
    }
}
__device__ __forceinline__ void load_q(LAS float* qs, const bf16_t* qrow, int lane) {
    const unsigned w = ((const unsigned*)qrow)[lane];
    qs[2 * lane] = bflo(w); qs[2 * lane + 1] = bfhi(w);
    asm volatile("s_waitcnt lgkmcnt(0)" ::: "memory");
}

__device__ __forceinline__ unsigned long long rt() { return __builtin_amdgcn_s_memrealtime(); }
#define XB_TMO      128
#define XB_XCNT(j)  (256  + 64 * (j))
#define XB_XSUB(j)  (1280 + 64 * (j))
#define XB_XGEN(j)  (2304 + 64 * (j))
#define XB_TOP      3328
#define XB_TOPGEN   3392
#define XCD_BAR_WORDS 3456
#define XB_SPIN_CAP (1u << 18)

__device__ __forceinline__ unsigned xb_ld(unsigned* p)              { return __hip_atomic_load(p, __ATOMIC_RELAXED, __HIP_MEMORY_SCOPE_AGENT); }
__device__ __forceinline__ unsigned xb_add(unsigned* p, unsigned v) { return __hip_atomic_fetch_add(p, v, __ATOMIC_RELAXED, __HIP_MEMORY_SCOPE_AGENT); }
__device__ __forceinline__ unsigned xb_xcc_id() { return (unsigned)__builtin_amdgcn_s_getreg((3 << 11) | 20) & 0xFu; }
#define XB_SPIN(cond, bar) do { unsigned _sp = 0; while (cond) { __builtin_amdgcn_s_sleep(1); \
    if ((++_sp & 255u) == 0u) { if (xb_ld(&(bar)[XB_TMO])) break; if (_sp > XB_SPIN_CAP) { atomicAdd(&(bar)[XB_TMO], 1u); break; } } } } while (0)

struct XcdBarrier {
    unsigned* bar; unsigned x;
    volatile LAS unsigned* st;
};

__device__ __forceinline__ XcdBarrier xcd_barrier_post(unsigned* bar, volatile LAS unsigned* st) {
    XcdBarrier b; b.bar = bar; b.x = xb_xcc_id(); b.st = st;
    if (threadIdx.x == 0) (void)xb_add(&bar[XB_XCNT(b.x)], 1u);
    return b;
}
__device__ __forceinline__ void xcd_barrier_complete(unsigned* bar, unsigned x, unsigned& nloc, unsigned& nx) {
    const unsigned G = gridDim.x * gridDim.y * gridDim.z;
    unsigned sum, cnt, mine, sp = 0u;
    for (;;) {
        sum = 0u; cnt = 0u; mine = 0u;
#pragma unroll
        for (unsigned j = 0; j < 16; ++j) { const unsigned c = xb_ld(&bar[XB_XCNT(j)]); sum += c; cnt += (c > 0u) ? 1u : 0u; mine = (j == x) ? c : mine; }
        if (sum == G) break;
        __builtin_amdgcn_s_sleep(1);
        if ((++sp & 255u) == 0u) { if (xb_ld(&bar[XB_TMO])) break; if (sp > XB_SPIN_CAP) { atomicAdd(&bar[XB_TMO], 1u); break; } }
    }
    nloc = mine > 0u ? mine : 1u; nx = cnt > 0u ? cnt : 1u;
}

__device__ __forceinline__ void xcd_barrier(const XcdBarrier& b) {
    asm volatile("s_waitcnt vmcnt(0)" ::: "memory");
    __syncthreads();
    if (threadIdx.x == 0) {
        unsigned* bar = b.bar;
        __builtin_amdgcn_s_waitcnt(0);
        unsigned nloc = b.st[0], nx = b.st[1];
        if (nloc == 0u) { xcd_barrier_complete(bar, b.x, nloc, nx); b.st[0] = nloc; b.st[1] = nx; }
        const unsigned old = xb_add(&bar[XB_XSUB(b.x)], 1u);
        const unsigned gen = old / nloc;
        if (old + 1u == (gen + 1u) * nloc) {
            __builtin_amdgcn_fence(__ATOMIC_RELEASE, "agent");
            asm volatile("s_waitcnt vmcnt(0)" ::: "memory");
            const unsigned og = xb_add(&bar[XB_TOP], 1u);
            const unsigned tg = og / nx;
            if (og + 1u == (tg + 1u) * nx) xb_add(&bar[XB_TOPGEN], 1u);
            else XB_SPIN(xb_ld(&bar[XB_TOPGEN]) == tg, bar);
            __builtin_amdgcn_fence(__ATOMIC_ACQUIRE, "agent");
            xb_add(&bar[XB_XGEN(b.x)], 1u);
            asm volatile("s_waitcnt vmcnt(0)" ::: "memory");
        } else {
            XB_SPIN(xb_ld(&bar[XB_XGEN(b.x)]) == gen, bar);
            __builtin_amdgcn_fence(__ATOMIC_ACQUIRE, "agent");
            asm volatile("s_waitcnt vmcnt(0)" ::: "memory");
        }
    }
    __syncthreads();
}


namespace att {
typedef short bf16x8 __attribute__((ext_vector_type(8)));
typedef short s16x4 __attribute__((ext_vector_type(4)));
typedef float f32x16 __attribute__((ext_vector_type(16)));
typedef float f32x4 __attribute__((ext_vector_type(4)));
constexpr int SHM_V = 16384, SHM_K = 16384;
constexpr int L_V = 0, L_K = 65536, L_WS = 114688, L_TBL = 116736;
constexpr float SCALE = 0.08838834764831845f, THR = 8.f;
constexpr float C2 = 1.4426950408889634f * SCALE;
constexpr float LOG2E = 1.4426950408889634f, LN2 = 0.6931471805599453f, THR2 = THR * LOG2E;
constexpr int L_FLAG = 163840 - 56;
#define ATT_KSWZ(row, colB) ((row) * 256 + ((colB) ^ (((row) & 7) << 4)))
#define ATT_SBAR() __builtin_amdgcn_sched_barrier(0)
__device__ __forceinline__ int v_st(int k, int c) { const int kk = (k & ~0xC) | ((k & 4) << 1) | ((k & 8) >> 1); return ((kk >> 3) * 4 + (c >> 5)) * 512 + ((kk & 7) * 32 + (c & 31)) * 2; }
__device__ __forceinline__ int v_rd_base(int lane) { return ((lane & 3) << 3) | (((lane >> 2) & 3) << 6) | (((lane >> 4) & 1) << 5) | (((lane >> 5) & 1) << 8); }
constexpr int v_rd_off(int d0, int ks, int half) { return d0 * 512 + ks * 4096 + half * 2048; }
__device__ __forceinline__ int crow(int r, int hi) { return (r & 3) + 8 * (r >> 2) + 4 * hi; }
__device__ __forceinline__ unsigned cvtpk(float lo, float hi) { unsigned r; asm volatile("v_cvt_pk_bf16_f32 %0, %1, %2" : "=v"(r) : "v"(lo), "v"(hi)); return r; }

__device__ __forceinline__ void partialSM(f32x16& p0, f32x16& p1, float& m_reg, float& alpha) {
    float pmax = p0[0];
#pragma unroll
    for (int r = 1; r < 16; ++r) pmax = fmaxf(pmax, p0[r]);
#pragma unroll
    for (int r = 0; r < 16; ++r) pmax = fmaxf(pmax, p1[r]);
    { auto rr = __builtin_amdgcn_permlane32_swap(__float_as_uint(pmax), __float_as_uint(pmax), false, false);
      pmax = fmaxf(__uint_as_float(rr[0]), __uint_as_float(rr[1])); }
    float mn;
    if (__builtin_expect(__all((pmax - m_reg) * SCALE <= THR), 1)) { mn = m_reg; alpha = 1.f; }
    else { mn = fmaxf(m_reg, pmax); alpha = __builtin_amdgcn_exp2f((m_reg - mn) * C2); m_reg = mn; }
    const float mnL = -mn * C2;
#pragma unroll
    for (int r = 0; r < 16; ++r) p0[r] = fmaf(p0[r], C2, mnL);
#pragma unroll
    for (int r = 0; r < 16; ++r) p1[r] = fmaf(p1[r], C2, mnL);
#pragma unroll
    for (int r = 0; r < 16; ++r) p0[r] = __builtin_amdgcn_exp2f(p0[r]);
}
#define ATT_PK4(P, B_, OUT) do { unsigned a0 = att::cvtpk(P[B_+0], P[B_+1]), a1 = att::cvtpk(P[B_+2], P[B_+3]);                          \
        unsigned b0 = att::cvtpk(P[B_+4], P[B_+5]), b1 = att::cvtpk(P[B_+6], P[B_+7]);                                             \
        auto r0 = __builtin_amdgcn_permlane32_swap(a0, b0, false, false); auto r1 = __builtin_amdgcn_permlane32_swap(a1, b1, false, false); \
        u32x4 w = {r0[0], r1[0], r0[1], r1[1]}; OUT = __builtin_bit_cast(att::bf16x8, w); } while (0)
__device__ __forceinline__ void finishSM(f32x16& p0, f32x16& p1, float alpha, float& l_reg, bf16x8& pa0, bf16x8& pa1, bf16x8& pa2, bf16x8& pa3) {
#pragma unroll
    for (int r = 0; r < 16; ++r) p1[r] = __builtin_amdgcn_exp2f(p1[r]);
    float ps = 0;
#pragma unroll
    for (int r = 0; r < 16; ++r) ps += p0[r];
#pragma unroll
    for (int r = 0; r < 16; ++r) ps += p1[r];
    { auto rr = __builtin_amdgcn_permlane32_swap(__float_as_uint(ps), __float_as_uint(ps), false, false);
      ps = __uint_as_float(rr[0]) + __uint_as_float(rr[1]); }
    l_reg = l_reg * alpha + ps;
    ATT_PK4(p0, 0, pa0); ATT_PK4(p0, 8, pa1); ATT_PK4(p1, 0, pa2); ATT_PK4(p1, 8, pa3);
}
__device__ __forceinline__ void qkt(f32x16& p0, f32x16& p1, const LAS unsigned char* Kt, int r32, int hi, const bf16x8 (&qr)[8], const LAS float* tb) {
#pragma unroll
    for (int r = 0; r < 16; ++r) { p0[r] = tb[59 - ((r & 3) + 8 * (r >> 2))]; p1[r] = tb[27 - ((r & 3) + 8 * (r >> 2))]; }
    const LAS unsigned char* kb[4];
#pragma unroll
    for (int dd = 0; dd < 4; ++dd) kb[dd] = Kt + ATT_KSWZ(r32, (dd * 16 + hi * 8) * 2);
#pragma unroll
    for (int d0 = 0; d0 < 8; ++d0) { const LAS unsigned char* a = kb[d0 & 3] + (d0 >> 2) * 128;
        const bf16x8 b0 = *(const LAS bf16x8*)a;
        const bf16x8 b1 = *(const LAS bf16x8*)(a + 32 * 256);
        p0 = __builtin_amdgcn_mfma_f32_32x32x16_bf16(b0, qr[d0], p0, 0, 0, 0);
        p1 = __builtin_amdgcn_mfma_f32_32x32x16_bf16(b1, qr[d0], p1, 0, 0, 0); }
}
__device__ __forceinline__ void pv_tile(f32x16 (&o)[4], int vb, bf16x8 pa0, bf16x8 pa1, bf16x8 pa2, bf16x8 pa3) {
#define ATT_TRRD(dst, off) asm volatile("ds_read_b64_tr_b16 %0, %1 offset:%2" : "=&v"(dst) : "v"(vb), "i"(off) : "memory")
#define ATT_VLD(L, H, d0) do { constexpr int b_ = v_rd_off(d0, 0, 0); \
        ATT_TRRD(L[0], b_); ATT_TRRD(H[0], b_ + 2048); ATT_TRRD(L[1], b_ + 4096); ATT_TRRD(H[1], b_ + 6144); ATT_TRRD(L[2], b_ + 8192); ATT_TRRD(H[2], b_ + 10240); ATT_TRRD(L[3], b_ + 12288); ATT_TRRD(H[3], b_ + 14336); } while (0)
#define ATT_VF(L, H, k) (bf16x8){L[k][0], L[k][1], L[k][2], L[k][3], H[k][0], H[k][1], H[k][2], H[k][3]}
#define ATT_PVM(L, H, d0) do { \
        o[d0] = __builtin_amdgcn_mfma_f32_32x32x16_bf16(pa0, ATT_VF(L, H, 0), o[d0], 0, 0, 0); o[d0] = __builtin_amdgcn_mfma_f32_32x32x16_bf16(pa1, ATT_VF(L, H, 1), o[d0], 0, 0, 0); \
        o[d0] = __builtin_amdgcn_mfma_f32_32x32x16_bf16(pa2, ATT_VF(L, H, 2), o[d0], 0, 0, 0); o[d0] = __builtin_amdgcn_mfma_f32_32x32x16_bf16(pa3, ATT_VF(L, H, 3), o[d0], 0, 0, 0); } while (0)
    s16x4 la[4], ha[4], lb[4], hb[4];
    ATT_VLD(la, ha, 0);
    ATT_VLD(lb, hb, 1);
    asm volatile("s_waitcnt lgkmcnt(8)" ::: "memory"); ATT_SBAR();
    ATT_PVM(la, ha, 0); ATT_SBAR();
    ATT_VLD(la, ha, 2);
    asm volatile("s_waitcnt lgkmcnt(8)" ::: "memory"); ATT_SBAR();
    ATT_PVM(lb, hb, 1); ATT_SBAR();
    ATT_VLD(lb, hb, 3);
    asm volatile("s_waitcnt lgkmcnt(8)" ::: "memory"); ATT_SBAR();
    ATT_PVM(la, ha, 2); ATT_SBAR();
    asm volatile("s_waitcnt lgkmcnt(0)" ::: "memory"); ATT_SBAR();
    ATT_PVM(lb, hb, 3);
#undef ATT_PVM
#undef ATT_VF
#undef ATT_VLD
#undef ATT_TRRD
}
typedef short v4i16_t __attribute__((ext_vector_type(4)));
__device__ __forceinline__ s16x4 vtr(const LAS unsigned char* p) { return __builtin_bit_cast(s16x4, __builtin_amdgcn_ds_read_tr16_b64_v4i16((LAS v4i16_t*)p)); }
__device__ __forceinline__ void qk_half(f32x16& p, const LAS unsigned char* Kt, int half, int r32, int hi, const bf16x8 (&qr)[8], const LAS float* tb) {
#pragma unroll
    for (int r = 0; r < 16; ++r) p[r] = tb[32 * half + ((r & 3) + 8 * (r >> 2))];
    const LAS unsigned char* kb[4];
#pragma unroll
    for (int dd = 0; dd < 4; ++dd) kb[dd] = Kt + half * 8192 + ATT_KSWZ(r32, (dd * 16 + hi * 8) * 2);
#pragma unroll
    for (int d0 = 0; d0 < 8; ++d0) p = __builtin_amdgcn_mfma_f32_32x32x16_bf16(*(const LAS bf16x8*)(kb[d0 & 3] + (d0 >> 2) * 128), qr[d0], p, 0, 0, 0);
}
__device__ __forceinline__ void exp_half(f32x16& p) {
#pragma unroll
    for (int r = 0; r < 16; ++r) p[r] = __builtin_amdgcn_exp2f(p[r]);
}
__device__ __forceinline__ bool partial_half(f32x16& p, float& m_reg, float& mthr, float& alpha) {
    float pmax = p[0];
#pragma unroll
    for (int r = 1; r < 16; ++r) pmax = fmaxf(pmax, p[r]);
    { auto rr = __builtin_amdgcn_permlane32_swap(__float_as_uint(pmax), __float_as_uint(pmax), false, false);
      pmax = fmaxf(__uint_as_float(rr[0]), __uint_as_float(rr[1])); }
    bool moved = false;
    if (__builtin_expect(!__all(pmax <= mthr), 0)) { const float mn = fmaxf(m_reg, pmax); alpha = __builtin_amdgcn_exp2f(m_reg - mn); m_reg = mn; mthr = mn + THR2; moved = true; }
#pragma unroll
    for (int r = 0; r < 16; ++r) p[r] = __builtin_amdgcn_exp2f(p[r] - m_reg);
    return moved;
}
__device__ __forceinline__ void finish_half(const f32x16& p, float& l_reg, bf16x8& pa0, bf16x8& pa1) {
    float ps = p[0];
#pragma unroll
    for (int r = 1; r < 16; ++r) ps += p[r];
    { auto rr = __builtin_amdgcn_permlane32_swap(__float_as_uint(ps), __float_as_uint(ps), false, false);
      ps = __uint_as_float(rr[0]) + __uint_as_float(rr[1]); }
    l_reg += ps;
    ATT_PK4(p, 0, pa0); ATT_PK4(p, 8, pa1);
}
template <int HALF>
__device__ __forceinline__ void pv_half(f32x16 (&o)[4], int vb, bf16x8 pa0, bf16x8 pa1) {
#define ATT_TRRD(dst, off) asm volatile("ds_read_b64_tr_b16 %0, %1 offset:%2" : "=&v"(dst) : "v"(vb), "i"(off) : "memory")
#define ATT_VLD2(L0, H0, L1, H1, d0) do { constexpr int b_ = (d0) * 512 + HALF * 8192; ATT_TRRD(L0, b_); ATT_TRRD(H0, b_ + 2048); ATT_TRRD(L1, b_ + 4096); ATT_TRRD(H1, b_ + 6144); } while (0)
#define ATT_VF(L, H) (bf16x8){L[0], L[1], L[2], L[3], H[0], H[1], H[2], H[3]}
    s16x4 a0, a1, a2, a3, b0, b1, b2, b3, c0, c1, c2, c3, d0_, d1_, d2_, d3_;
    ATT_VLD2(a0, a1, a2, a3, 0); ATT_VLD2(b0, b1, b2, b3, 1); ATT_VLD2(c0, c1, c2, c3, 2); ATT_VLD2(d0_, d1_, d2_, d3_, 3);
    asm volatile("s_waitcnt lgkmcnt(8)" ::: "memory"); ATT_SBAR();
    o[0] = __builtin_amdgcn_mfma_f32_32x32x16_bf16(pa0, ATT_VF(a0, a1), o[0], 0, 0, 0); o[0] = __builtin_amdgcn_mfma_f32_32x32x16_bf16(pa1, ATT_VF(a2, a3), o[0], 0, 0, 0);
    o[1] = __builtin_amdgcn_mfma_f32_32x32x16_bf16(pa0, ATT_VF(b0, b1), o[1], 0, 0, 0); o[1] = __builtin_amdgcn_mfma_f32_32x32x16_bf16(pa1, ATT_VF(b2, b3), o[1], 0, 0, 0);
    ATT_SBAR(); asm volatile("s_waitcnt lgkmcnt(0)" ::: "memory"); ATT_SBAR();
    o[2] = __builtin_amdgcn_mfma_f32_32x32x16_bf16(pa0, ATT_VF(c0, c1), o[2], 0, 0, 0); o[2] = __builtin_amdgcn_mfma_f32_32x32x16_bf16(pa1, ATT_VF(c2, c3), o[2], 0, 0, 0);
    o[3] = __builtin_amdgcn_mfma_f32_32x32x16_bf16(pa0, ATT_VF(d0_, d1_), o[3], 0, 0, 0); o[3] = __builtin_amdgcn_mfma_f32_32x32x16_bf16(pa1, ATT_VF(d2_, d3_), o[3], 0, 0, 0);
#undef ATT_VF
#undef ATT_VLD2
#undef ATT_TRRD
}
__device__ __forceinline__ void dma16(const void* g, LAS unsigned char* l) { __builtin_amdgcn_global_load_lds((const unsigned*)g, (LAS unsigned*)l, 16, 0, 0); }
template <class U>
__device__ __forceinline__ void dma_tile(LAS unsigned char* lds, const U& u, int t, int kb, int vs, int lane, int wid) {
    int l_ = lane; asm volatile("" : "+v"(l_));
    const int kkey0 = 8 * wid + (l_ >> 4), kkey1 = kkey0 + 4;
    const int kc0 = ((l_ & 15) ^ (kkey0 & 7)) * 8, kc1 = ((l_ & 15) ^ (kkey1 & 7)) * 8;
    const int vkk = 8 * wid + ((l_ & 31) >> 2), vkey = (vkk & ~0xC) | ((vkk & 4) << 1) | ((vkk & 8) >> 1);
    const int vc0 = 32 * (l_ >> 5) + 8 * (l_ & 3), vc1 = vc0 + 64;
    const int ro0 = u.rowoff(t, kkey0), ro1 = u.rowoff(t, kkey1), rov = u.rowoff(t, vkey);
    LAS unsigned char* kdst = lds + L_K + wid * 2048 + kb * SHM_K; LAS unsigned char* vdst = lds + L_V + wid * 2048 + vs * SHM_V;
    dma16(u.K + ro0 + kc0, kdst); dma16(u.K + ro1 + kc1, kdst + 1024);
    dma16(u.V + rov + vc0, vdst); dma16(u.V + rov + vc1, vdst + 1024);
}
template <class U>
__device__ __forceinline__ void dma_tile_u(LAS unsigned char* lds, const U& u, int t, int kb, int vs, unsigned kof0, unsigned kof1, unsigned vof, int wid) {
    const int tb = __builtin_amdgcn_readfirstlane(u.rowoff(t, 0));
    const char* kbase = (const char*)(u.K + tb); const char* vbase = (const char*)(u.V + tb);
    LAS unsigned char* kdst = lds + L_K + wid * 2048 + kb * SHM_K; LAS unsigned char* vdst = lds + L_V + wid * 2048 + vs * SHM_V;
    dma16(kbase + kof0, kdst); dma16(kbase + kof1, kdst + 1024);
    dma16(vbase + vof, vdst); dma16(vbase + vof + 128, vdst + 1024);
}
template <bool FAST, class U>
__device__ __forceinline__ void flash_impl(LAS unsigned char* lds, const U& u, const bf16x8 (&qr)[8], f32x16 (&o)[4], float& m_reg, float& l_reg, int tid, int lane, int wid, bool tile0_issued) {
    const int r32 = lane & 31, hi = lane >> 5;
    u.reset();
    const int vp0 = L_V + v_rd_base(lane);
    LAS float* al_l = (LAS float*)(lds + L_WS) + wid * 64 + 32;
    const int NT = u.nt();
    unsigned kof0, kof1, vof;
    { const int rs = u.rs(), kkey0 = 8 * wid + (lane >> 4), kc0 = ((lane & 15) ^ (kkey0 & 7)) * 8;
      const int vkk = 8 * wid + ((lane & 31) >> 2), vkey = (vkk & ~0xC) | ((vkk & 4) << 1) | ((vkk & 8) >> 1), vc0 = 32 * (lane >> 5) + 8 * (lane & 3);
      kof0 = (unsigned)(kkey0 * rs + kc0) * 2u; kof1 = (unsigned)((kkey0 + 4) * rs + (kc0 ^ 32)) * 2u; vof = (unsigned)(vkey * rs + vc0) * 2u; }
#define ATT_DMA(t_, kb_, vs_) dma_tile_u(lds, u, t_, kb_, vs_, kof0, kof1, vof, wid)
#define ATT_RESC(a) do { l_reg *= (a); if (hi == 0) al_l[r32] = (a); asm volatile("s_waitcnt lgkmcnt(0)" ::: "memory"); \
        _Pragma("unroll") for (int d_ = 0; d_ < 4; ++d_) _Pragma("unroll") for (int r = 0; r < 16; ++r) o[d_][r] *= al_l[crow(r, hi)]; } while (0)
    f32x16 pA, pB; float alp = 1.f; bf16x8 pa0, pa1;
    float mthr = m_reg + THR2;
    bool actP = false;
    int ks_cur = 0, ks_n1 = 1, ks_n2 = 2;
    int vs_prev = 3, vs_cur = 0, vs_n1 = 1, vs_n2 = 2;
    if (!tile0_issued) ATT_DMA(0, 0, 0);
    if (NT > 1) ATT_DMA(1, 1, 1);
    for (int t = 0; t < NT; ++t) {
        if (t + 1 < NT) asm volatile("s_waitcnt vmcnt(4) lgkmcnt(0)" ::: "memory"); else asm volatile("s_waitcnt vmcnt(0) lgkmcnt(0)" ::: "memory");
        __builtin_amdgcn_s_barrier(); asm volatile("" ::: "memory");
        if (t + 2 < NT) ATT_DMA(t + 2, ks_n2, vs_n2);
        const bool actC = u.act(t);
        const LAS unsigned char* Kt = lds + L_K + ks_cur * SHM_K; const LAS float* tb = u.tbl(t); asm volatile("" : "+v"(tb));
        ATT_SBAR();
        if (actC) qk_half(pA, Kt, 0, r32, hi, qr, tb);
        if (actP) finish_half(pB, l_reg, pa0, pa1);
        if (actP) pv_half<1>(o, vp0 + vs_prev * SHM_V, pa0, pa1);
        if (actC) { if constexpr (FAST) exp_half(pA); else { if (partial_half(pA, m_reg, mthr, alp)) ATT_RESC(alp); } }
        ATT_SBAR();
        if (actC) { qk_half(pB, Kt, 1, r32, hi, qr, tb);
            finish_half(pA, l_reg, pa0, pa1);
            pv_half<0>(o, vp0 + vs_cur * SHM_V, pa0, pa1);
            if constexpr (FAST) exp_half(pB); else { if (partial_half(pB, m_reg, mthr, alp)) ATT_RESC(alp); } }
        actP = actC;
        { const int tk_ = ks_cur; ks_cur = ks_n1; ks_n1 = ks_n2; ks_n2 = tk_; }
        { const int tv_ = vs_prev; vs_prev = vs_cur; vs_cur = vs_n1; vs_n1 = vs_n2; vs_n2 = tv_; }
    }
    if (actP) { finish_half(pB, l_reg, pa0, pa1); pv_half<1>(o, vp0 + vs_prev * SHM_V, pa0, pa1); }
    if constexpr (FAST) {
#ifdef ATT_FORCE_FALLBACK
        const bool bad = true;
#else
        const bool bad = !(l_reg > 0.f && l_reg < 1.2676506e30f);
#endif
        if (__any(bad) && lane == 0) *(volatile LAS unsigned*)(lds + L_FLAG) = 1u;
    }
    asm volatile("s_waitcnt vmcnt(0) lgkmcnt(0)" ::: "memory");
    __syncthreads();
#undef ATT_RESC
#undef ATT_DMA
}
template <class U>
__device__ __forceinline__ void flash_tiles(LAS unsigned char* lds, const U& u, const bf16x8 (&qr)[8], f32x16 (&o)[4], float& m_reg, float& l_reg, int tid, int lane, int wid, bool tile0_issued = false) {
    if (tid == 0) *(volatile LAS unsigned*)(lds + L_FLAG) = 0u;
    m_reg = 0.f;
    flash_impl<true>(lds, u, qr, o, m_reg, l_reg, tid, lane, wid, tile0_issued);
    if (__builtin_expect(*(volatile LAS unsigned*)(lds + L_FLAG) != 0u, 0)) {
#pragma unroll
        for (int d_ = 0; d_ < 4; ++d_)
#pragma unroll
            for (int r = 0; r < 16; ++r) o[d_][r] = 0.f;
        m_reg = -1e30f; l_reg = 0.f;
        flash_impl<false>(lds, u, qr, o, m_reg, l_reg, tid, lane, wid, false);
    }
}
template <class F>
__device__ __forceinline__ void emit(LAS unsigned char* lds, const f32x16 (&o)[4], float l_reg, int lane_in, int wid, const F& f, int stg_off = 0) {
    int lane = lane_in; asm volatile("" : "+v"(lane));
    const int r32 = lane & 31, hi = lane >> 5;
    LAS float* li_l = (LAS float*)(lds + L_WS) + wid * 64;
    if (hi == 0) li_l[r32] = (l_reg > 0.f ? frcp(l_reg) : 0.f) * f.rowscale(r32);
    asm volatile("s_waitcnt lgkmcnt(0)" ::: "memory");
    float rli[16];
#pragma unroll
    for (int r = 0; r < 16; ++r) rli[r] = li_l[crow(r, hi)];
    LAS float* stg = (LAS float*)(lds + stg_off + wid * 8192);
#pragma unroll
    for (int hf = 0; hf < 2; ++hf) {
#pragma unroll
        for (int r = 0; r < 16; ++r) { const int row = crow(r, hi);
            stg[row * 64 + r32] = o[2 * hf][r] * rli[r]; stg[row * 64 + 32 + r32] = o[2 * hf + 1][r] * rli[r]; }
        asm volatile("s_waitcnt lgkmcnt(0)" ::: "memory");
        {
            typename F::Ld ld[4];
#pragma unroll
            for (int i = 0; i < 4; ++i) { const int idx = i * 64 + lane; ld[i] = f.load(idx >> 3, hf * 64 + (idx & 7) * 8); }
#pragma unroll
            for (int i = 0; i < 4; ++i) { const int idx = i * 64 + lane, row = idx >> 3, c8 = (idx & 7) * 8;
                const f32x4 v0 = *(const LAS f32x4*)(stg + row * 64 + c8), v1 = *(const LAS f32x4*)(stg + row * 64 + c8 + 4); f.store(row, hf * 64 + c8, v0, v1, ld[i]); }
        }
        asm volatile("s_waitcnt lgkmcnt(0)" ::: "memory");
    }
    __syncthreads();
}
}

struct DilU {
    const bf16_t* K; const bf16_t* V;
    int d, m16, lbase, res, jlo, ntl, lw0, wsel, lane_off;
    const LAS float* T;
    __device__ __forceinline__ int nt() const { return ntl; }
    __device__ __forceinline__ int rs() const { return d * HD; }
    __device__ __forceinline__ void reset() const {}
    __device__ __forceinline__ void tile(int t, int& lk0, int& rt, int& jj) const { const int j = jlo + t; jj = j; if (!m16) { lk0 = lbase + 64 * j; rt = res; } else { lk0 = 64 * (j & 1); rt = res + (j >> 1); } }
    __device__ __forceinline__ int rowoff(int t, int key) const { int lk0, rt, jj; tile(t, lk0, rt, jj); return ((lk0 + key) * d + rt) * HD; }
    __device__ __forceinline__ bool act(int t) const { int lk0, rt, jj; tile(t, lk0, rt, jj);
        return m16 ? ((jj >> 1) == wsel && lk0 <= lw0 + 31) : (lk0 <= lw0 + 31 && lk0 + 63 >= lw0 - 128); }
    __device__ __forceinline__ const LAS float* tbl(int t) const { int lk0, rt, jj; tile(t, lk0, rt, jj); return T + (260 - (lw0 - lk0 + lane_off)); }
};

struct DilStoreF {
    static constexpr int BATCH = 8;
    bf16_t* base; int rstride;
    struct Ld { };
    __device__ __forceinline__ float rowscale(int) const { return 1.f; }
    __device__ __forceinline__ Ld load(int, int) const { return Ld{}; }
    __device__ __forceinline__ void store(int row, int col, att::f32x4 v, att::f32x4 w, const Ld&) const {
        *(uint4*)(base + (size_t)row * rstride + col) = make_uint4(pg8::cvt_pk_bf16(v[0], v[1]), pg8::cvt_pk_bf16(v[2], v[3]), pg8::cvt_pk_bf16(w[0], w[1]), pg8::cvt_pk_bf16(w[2], w[3])); }
};

struct DilMergeF {
    const bf16_t* o2; const bf16_t* o3; const bf16_t* z; bf16_t* a0;
    const float* lse2; const float* lse3;
    const LAS float* lse1;
    LAS float* w23;
    static constexpr int BATCH = 4;
    struct Ld { uint4 o2, o3, z; };
    __device__ __forceinline__ float rowscale(int row) const {
        const float l1 = lse1[row], l2 = lse2[(size_t)row * NH], l3 = lse3[(size_t)row * NH]; const float mx = fmaxf(l1, fmaxf(l2, l3));
        float w1 = __expf(l1 - mx), w2 = __expf(l2 - mx), w3 = __expf(l3 - mx); const float inv = frcp(w1 + w2 + w3);
        w23[row] = w2 * inv; w23[32 + row] = w3 * inv; return w1 * inv; }
    __device__ __forceinline__ Ld load(int row, int col) const { Ld l; const size_t e = (size_t)row * DM + col;
        l.o2 = ldnt4u((const uint4*)(o2 + e)); l.o3 = ldnt4u((const uint4*)(o3 + e)); l.z = ldnt4u((const uint4*)(z + e)); return l; }
    __device__ __forceinline__ unsigned mix2(float va, float vb, float w2, float w3, unsigned p2, unsigned p3, unsigned pz) const {
        return pg8::cvt_pk_bf16((va + w2 * bflo(p2) + w3 * bflo(p3)) * silu(bflo(pz)), (vb + w2 * bfhi(p2) + w3 * bfhi(p3)) * silu(bfhi(pz))); }
    __device__ __forceinline__ void store(int row, int col, att::f32x4 v, att::f32x4 u, const Ld& l) const {
        const float w2 = w23[row], w3 = w23[32 + row];
        *(uint4*)(a0 + (size_t)row * DM + col) = make_uint4(mix2(v[0], v[1], w2, w3, l.o2.x, l.o3.x, l.z.x), mix2(v[2], v[3], w2, w3, l.o2.y, l.o3.y, l.z.y),
                                                            mix2(u[0], u[1], w2, w3, l.o2.z, l.o3.z, l.z.z), mix2(u[2], u[3], w2, w3, l.o2.w, l.o3.w, l.z.w));
    }
};

struct DilCtx { DilU U; int pat, h, d, grow_l, rbase; };
template <int PASS>
__device__ __forceinline__ void dil_setup(int ui, DilCtx& c, LAS float* T, const bf16_t* qkvA, const float* table, int tid, int lane, int wave) {
    const int r32 = lane & 31, hi = lane >> 5;
    int bh, kk;
    if (PASS == 0) { bh = ui >> 4; const int w = ui & 15; kk = (w & 1) * 8 + (w >> 1); } else { bh = ui >> 3; kk = ui & 7; }
    const int pat = PASS ? 0 : 1 + (kk >> 3), idx = kk & 7, b = bh >> 4, h = bh & 15;
    const int d = pat == 0 ? 1 : (pat == 1 ? 4 : 16);
    DilU& U = c.U; U.d = d; U.m16 = (pat == 2); U.T = T; U.lane_off = r32 - 4 * hi + 37;
    int rw;
    if (pat == 2) { U.res = 2 * idx; U.lbase = 0; U.jlo = 0; U.ntl = 4; U.lw0 = 32 * (wave & 3); U.wsel = wave >> 2; rw = 2 * idx + (wave >> 2); }
    else { const int mm = (pat == 0) ? idx : (idx & 1); U.res = (pat == 0) ? 0 : (idx >> 1); U.lbase = 256 * mm - 128; U.jlo = (mm == 0) ? 2 : 0; U.ntl = 6 - U.jlo; U.lw0 = 256 * mm + 32 * wave; U.wsel = 0; rw = U.res; }
    U.K = qkvA + ((size_t)(16 + h) * MTOK + b * SEQ) * HD; U.V = qkvA + ((size_t)(32 + h) * MTOK + b * SEQ) * HD;
    if (tid < 320) { const int delta = tid - 96; T[319 - tid] = (delta >= 0 && delta <= 128) ? table[rel_bucket(delta * d) * NH + h] * att::LOG2E : -__builtin_inff(); }
    c.pat = pat; c.h = h; c.d = d; c.grow_l = b * SEQ + (U.lw0 + r32) * d + rw; c.rbase = b * SEQ + U.lw0 * d + rw;
}
template <int PASS>
__device__ __forceinline__ void dil_phase(LAS unsigned char* lds, int G, unsigned char* dob, unsigned char* ws, const bf16_t* qkvA, const bf16_t* zA, bf16_t* a0, const float* table) {
    int tid = threadIdx.x; asm volatile("" : "+v"(tid)); const int lane = tid & 63, wave = __builtin_amdgcn_readfirstlane(tid >> 6);
    bf16_t* op1 = (bf16_t*)(dob); bf16_t* op2 = (bf16_t*)(dob + 32 * MiB);
    float* lseb = (float*)(ws + WS_SSQ0);
    const int r32 = lane & 31, hi = lane >> 5;
    const int vcu = (G % 8 == 0) ? ((int)blockIdx.x % 8) * (G / 8) + (int)blockIdx.x / 8 : (int)blockIdx.x;
    constexpr int upb = PASS ? 8 : 16, NU = 64 * upb; const int per = (NU + G - 1) / G;
    const int ui0 = vcu * per, ui1 = (ui0 + per < NU) ? ui0 + per : NU;
    if (ui0 >= ui1) return;
    DilCtx cur; att::bf16x8 qn[8];
    dil_setup<PASS>(ui0, cur, (LAS float*)(lds + att::L_TBL), qkvA, table, tid, lane, wave);
    { const bf16_t* qp = qkvA + ((size_t)cur.h * MTOK + cur.grow_l) * HD + hi * 8;
#pragma unroll
      for (int d0 = 0; d0 < 8; ++d0) qn[d0] = *(const att::bf16x8*)(qp + d0 * 16); }
    att::dma_tile(lds, cur.U, 0, 0, 0, lane, wave);
    for (int ui = ui0; ui < ui1; ++ui) {
        att::bf16x8 qr[8];
#pragma unroll
        for (int d0 = 0; d0 < 8; ++d0) qr[d0] = qn[d0];
        att::f32x16 o[4];
#pragma unroll
        for (int d_ = 0; d_ < 4; ++d_)
#pragma unroll
            for (int r = 0; r < 16; ++r) o[d_][r] = 0.f;
        float m_reg = -1e30f, l_reg = 0.f;
        att::flash_tiles(lds, cur.U, qr, o, m_reg, l_reg, tid, lane, wave, true);
        const float lse = m_reg * att::LN2 + __logf(l_reg);
        if constexpr (PASS == 0) {
            if (hi == 0) lseb[((size_t)cur.pat * MTOK + cur.grow_l) * NH + cur.h] = lse;
            bf16_t* opp = (cur.pat == 1 ? op1 : op2) + cur.h * HD;
            att::emit(lds, o, l_reg, lane, wave, DilStoreF{opp + (size_t)cur.rbase * DM, cur.d * DM});
        } else {
            LAS float* l1s = (LAS float*)(lds + att::L_WS) + wave * 64 + 32;
            if (hi == 0) l1s[r32] = lse;
            const size_t e0 = (size_t)cur.rbase * DM + cur.h * HD;
            att::emit(lds, o, l_reg, lane, wave, DilMergeF{op1 + e0, op2 + e0, zA + e0, a0 + e0, lseb + ((size_t)1 * MTOK + cur.rbase) * NH + cur.h, lseb + ((size_t)2 * MTOK + cur.rbase) * NH + cur.h, l1s, (LAS float*)(lds + att::L_TBL + 4096) + wave * 64});
        }
        DilCtx nxt = cur; const bool has = ui + 1 < ui1;
        if (has) {
            dil_setup<PASS>(ui + 1, nxt, (LAS float*)(lds + att::L_TBL + (((ui + 1 - ui0) & 1) ? 2048 : 0)), qkvA, table, tid, lane, wave);
            const bf16_t* qp = qkvA + ((size_t)nxt.h * MTOK + nxt.grow_l) * HD + hi * 8;
#pragma unroll
            for (int d0 = 0; d0 < 8; ++d0) qn[d0] = *(const att::bf16x8*)(qp + d0 * 16);
            att::dma_tile(lds, nxt.U, 0, 0, 0, lane, wave);
        }
        cur = nxt;
    }
}

constexpr int L_TSEL = att::L_TBL, L_TWIN = L_TSEL + 4 * 2112 * 4, L_SELM = L_TWIN + 4 * 640 * 4, L_TL = L_SELM + 256;
constexpr int L_TAB4 = L_TL + 256;
constexpr int L_IMPH = att::L_V + 2 * att::SHM_V;
static_assert(L_TAB4 + 512 <= 163840 - 64, "LDS map");
struct SelU {
    const bf16_t* K; const bf16_t* V;
    unsigned un; mutable unsigned rd, ra, rt; int ntl; unsigned mymask; int tq_off;
    __device__ __forceinline__ void reset() const { rd = un; ra = un; rt = un; }
    const LAS float* T;
    __device__ __forceinline__ int nt() const { return ntl; }
    __device__ __forceinline__ int rs() const { return HD; }
    __device__ __forceinline__ int rowoff(int, int key) const { const int n = __builtin_ctz(rd); rd &= rd - 1u; return (64 * n + key) * HD; }
    __device__ __forceinline__ bool act(int) const { const int n = __builtin_ctz(ra); ra &= ra - 1u; return __any((mymask >> n) & 1u); }
    __device__ __forceinline__ const LAS float* tbl(int) const { const int n = __builtin_ctz(rt); rt &= rt - 1u; int idx = ((mymask >> n) & 1u) ? 2052 - tq_off + 64 * n : 2052; asm volatile("" : "+v"(idx)); return T + idx; }
};
struct WinU {
    const bf16_t* K; const bf16_t* V;
    int tk_base, ntl, tq_off;
    __device__ __forceinline__ void reset() const {}
    const LAS float* T;
    __device__ __forceinline__ int nt() const { return ntl; }
    __device__ __forceinline__ int rs() const { return HD; }
    __device__ __forceinline__ int rowoff(int t, int key) const { return (tk_base + 64 * t + key) * HD; }
    __device__ __forceinline__ bool act(int) const { return true; }
    __device__ __forceinline__ const LAS float* tbl(int t) const { return T + (580 - tq_off + tk_base + 64 * t); }
};
struct GateF {
    const bf16_t* zrow; const bf16_t* grow; bf16_t* arow;
    int first;
    static constexpr int BATCH = 8;
    struct Ld { uint4 z, a; };
    __device__ __forceinline__ float rowscale(int row) const { return frcp(1.f + __expf(-bf2f(grow[(size_t)row * 256]))); }
    __device__ __forceinline__ Ld load(int row, int col) const { Ld l; l.z = ldnt4u((const uint4*)(zrow + (size_t)row * 6144 + col));
        l.a = first ? make_uint4(0u, 0u, 0u, 0u) : *(const uint4*)(arow + (size_t)row * DM + col); return l; }
    __device__ __forceinline__ unsigned gate2(float va, float vb, unsigned pz, unsigned pa) const { return pg8::cvt_pk_bf16(va * silu(bflo(pz)) + bflo(pa), vb * silu(bfhi(pz)) + bfhi(pa)); }
    __device__ __forceinline__ void store(int row, int col, att::f32x4 v, att::f32x4 u, const Ld& l) const {
        *(uint4*)(arow + (size_t)row * DM + col) = make_uint4(gate2(v[0], v[1], l.z.x, l.a.x), gate2(v[2], v[3], l.z.y, l.a.y), gate2(u[0], u[1], l.z.z, l.a.z), gate2(u[2], u[3], l.z.w, l.a.w));
    }
};

constexpr int NWAVES = 8, NTHREADS = 512;
#ifndef REP_P2
#define REP_P2 1
#endif
#ifndef REP_P7
#define REP_P7 1
#endif
#ifndef REP_P1
#define REP_P1 1
#endif
#ifndef REP_EW
#define REP_EW 1
#endif
#ifndef REP_G2
#define REP_G2 1
#endif
#ifndef REP_FD
#define REP_FD 1
#endif
#ifndef REP_F7
#define REP_F7 1
#endif
#ifndef REP_P5
#define REP_P5 1
#endif
#ifndef REP_P0
#define REP_P0 1
#endif
constexpr int LDS_BYTES = 163840;

__global__ void __launch_bounds__(NTHREADS, 2) yoco_fwd(Params p) {
    extern __shared__ __attribute__((aligned(16))) unsigned char lds_raw[];
    LAS unsigned char* lds = (LAS unsigned char*)lds_raw;
    cg::grid_group grid = cg::this_grid();
    const int G = gridDim.x, NGW = G * NWAVES;
    { volatile LAS unsigned* st = (volatile LAS unsigned*)(lds + LDS_BYTES - 64); if (threadIdx.x == 0) { st[0] = 0u; st[1] = 0u; st[3] = 0u; } __syncthreads(); }
    XcdBarrier bar = xcd_barrier_post((unsigned*)(p.ws + WS_BAR), (volatile LAS unsigned*)(lds + LDS_BYTES - 64));
#define PHASE_VARS int tid = threadIdx.x; asm volatile("" : "+v"(tid)); const int lane = tid & 63, wave = __builtin_amdgcn_readfirstlane(tid >> 6), gw = blockIdx.x * NWAVES + wave; (void)lane; (void)gw;
    unsigned char* ws = p.ws; unsigned char* dob = (unsigned char*)p.out;
    const float* x = p.in[0]; const float* norm_pre = p.in[1]; const float* norm_post = p.in[2]; const float* table = p.in[3];
    const float* w_in_a = p.in[4]; const float* w_out_a = p.in[5]; const float* kv_norm = p.in[6]; const float* w_kv = p.in[7];
    const float* pos_k = p.in[8]; const float* pos_v = p.in[9]; const float* w1k = p.in[10]; const float* w2k = p.in[11];
    const float* w1v = p.in[12]; const float* w2v = p.in[13]; const float* w_in_b = p.in[14]; const float* w_out_b = p.in[15];
    bf16_t* WA_t = (bf16_t*)(ws + WS_B); bf16_t* WoA_t = (bf16_t*)(ws + WS_WOA); bf16_t* WB_t = (bf16_t*)(ws + WS_WB); bf16_t* WoB_t = (bf16_t*)(ws + WS_WOB);
    bf16_t* xhat0 = (bf16_t*)(dob + DO_XHAT0);
    bf16_t* qkvA = (bf16_t*)(ws + WS_QKVA); bf16_t* zA = (bf16_t*)(ws + WS_ZA); bf16_t* a0 = (bf16_t*)(ws + WS_B);
    bf16_t* y0b = (bf16_t*)(ws + WS_Y0); float* ssq0 = (float*)(ws + WS_SSQ0); float* ssq1 = (float*)(ws + WS_SSQ1); float* rstd0 = (float*)(ws + WS_RSTD0);
    bf16_t* xhat1 = (bf16_t*)(ws + WS_B); bf16_t* qB = (bf16_t*)(ws + WS_QB); bf16_t* zB = (bf16_t*)(ws + WS_ZB);
    bf16_t* kvb = (bf16_t*)(dob + DO_KVB); bf16_t* gB = (bf16_t*)(dob + DO_GB); bf16_t* kcmp = (bf16_t*)(dob + DO_KCMP); bf16_t* vcmp = (bf16_t*)(dob + DO_VCMP);
    bf16_t* a1 = (bf16_t*)(ws + WS_B); bf16_t* y1b = (bf16_t*)(ws + WS_Y1);
    float* posvec = (float*)(ws + WS_RSTD0 + 65536); bf16_t* W1t = (bf16_t*)(dob + 54 * MiB); bf16_t* cpart = (bf16_t*)(ws + WS_WOA);
    unsigned* kvcnt = (unsigned*)(ws + WS_BAR) + 3584;

    for (int rep = 0; rep < REP_P0; ++rep) {
        PHASE_VARS
        LAS float* scr = (LAS float*)(lds + wave * 16384);
        constexpr int I_A = 32 * 128, I_OA = 32 * 32, I_B = 32 * (NWB / 64), I_OB = 32 * 32;
        constexpr int NIT = I_A + I_OA + I_B;
        auto decode = [&](int it) -> TItem {
            int r = it;
            if (r < I_A) { const int kb = r / 128, nb = r % 128; return TItem{w_in_a, norm_pre, WA_t, 8192, nb * 64, 8192, kb * 64, DM, nb * 64, nb < 32 ? QSC : 1.f}; } r -= I_A;
            if (r < I_OA) { const int kb = r / 32, nb = r % 32; return TItem{w_out_a, nullptr, WoA_t, 2048, nb * 64, 2048, kb * 64, DM, nb * 64, 1.f}; } r -= I_OA;
            if (r < I_B) { const int kb = r / (NWB / 64), nb = r % (NWB / 64); const int n0 = nb * 64;
                if (n0 < 8192) return TItem{w_in_b, norm_pre + DM, WB_t, 8240, n0, 8240, kb * 64, DM, n0, n0 < 2048 ? QSC : 1.f};
                if (n0 < 11264) return TItem{w_kv, kv_norm, WB_t, 3072, n0 - 8192, 3072, kb * 64, DM, n0, 1.f};
                return TItem{w_in_b, norm_pre + DM, WB_t, 8240, 8192 + (n0 - 11264), 8240, kb * 64, DM, n0, 1.f}; }
            r -= I_B;
            { const int kb = r / 32, nb = r % 32; return TItem{w_out_b, nullptr, WoB_t, 2048, nb * 64, 2048, kb * 64, DM, nb * 64, 1.f}; }
        };
        LAS float* scr64 = (LAS float*)(lds + wave * 20480);
        for (int it = gw; it < NIT; it += 2 * NGW) {
            const TItem ta = decode(it); const bool hasb = it + NGW < NIT; const TItem tb = decode(hasb ? it + NGW : it);
            float va[64], vb[64];
            titem_load64(ta, va, lane); if (hasb) titem_load64(tb, vb, lane);
            titem_store64(ta, va, scr64, lane); if (hasb) titem_store64(tb, vb, scr64, lane);
        }
        for (int m = gw; m < MTOK; m += NGW) rms_row_bf16(x + (size_t)m * DM, xhat0 + (size_t)m * DM, lane);
        for (int it = gw; it < 2048; it += NGW) {
            const int q = it >> 9, sec = (it >> 8) & 1, n = it & 255; const float* pos = (sec ? pos_v : pos_k) + q * 1024 + lane; const float* w1 = (sec ? w1v : w1k) + (size_t)(q * 1024 + lane) * 256 + n;
            float pv[16], wv[16];
#pragma unroll
            for (int j = 0; j < 16; ++j) { pv[j] = pos[64 * j]; wv[j] = w1[(size_t)64 * j * 256]; }
            float a = 0.f;
#pragma unroll
            for (int j = 0; j < 16; ++j) a += pv[j] * wv[j];
            a = wave_sum(a); if (lane == 0) posvec[it] = a;
        }
    }
    if (__builtin_expect(G > 65535, 0)) grid.sync();
    xcd_barrier(bar);
    for (int rep = 0; rep < REP_P1; ++rep) {
        pg8::Gemm g{xhat0, WA_t, MTOK, 8192, DM, DM, DM}; pg8::StaticOrder S; S.init(MTOK, 8192, G, (int)blockIdx.x);
        pg8::EpiK<1> E{qkvA, zA};
        pg8::gemm_phase<pg8::EpiK<1>, pg8::StaticOrder, true, true>(lds, g, S, E);
    }
    xcd_barrier(bar);
    dil_phase<0>(lds, G, dob, ws, qkvA, zA, a0, table);
    xcd_barrier(bar);
    dil_phase<1>(lds, G, dob, ws, qkvA, zA, a0, table);
    xcd_barrier(bar);
    for (int rep = 0; rep < REP_G2; ++rep) {
        pg8::Gemm g{a0, WoA_t, MTOK, DM, DM, DM, DM}; pg8::StaticOrder S; S.init(MTOK, DM, G, (int)blockIdx.x);
        pg8::EpiK<2> E{y0b, (bf16_t*)ssq0};
        pg8::gemm_phase<pg8::EpiK<2>, pg8::StaticOrder, true, true>(lds, g, S, E);
    }
    xcd_barrier(bar);
    for (int rep = 0; rep < REP_EW; ++rep) { PHASE_VARS
    {   LAS float* scr = (LAS float*)(lds + wave * 16384);
        for (int it = gw; it < 1024; it += NGW) { const int sec = it >> 9, r = it & 511, kb = r >> 3, nb = r & 7;
            transpose_item(sec ? w1v : w1k, 256, nb * 32, 256, kb * 64, nullptr, W1t + (size_t)sec * 256 * 4096, 4096, nb * 32, scr, lane); } }
    for (int m = gw; m < MTOK; m += NGW) {
        float sp = (lane < 32) ? ssq0[(size_t)m * 32 + lane] : 0.f;
        const float r0 = rsqrtf(wave_sum(sp) * (1.f / DM) + 1e-6f);
        if (lane == 0) rstd0[m] = r0;
        const float4* xr = (const float4*)(x + (size_t)m * DM) + lane; const uint2* yr = (const uint2*)(y0b + (size_t)m * DM) + lane; const float4* gr = (const float4*)norm_post + lane;
        float4 hv[8]; float ss = 0.f;
#pragma unroll
        for (int j = 0; j < 8; ++j) {
            const float4 xv = ldnt4(xr + 64 * j); const uint2 yv = yr[64 * j]; const float4 gv = gr[64 * j];
            hv[j].x = xv.x + bflo(yv.x) * r0 * gv.x; hv[j].y = xv.y + bfhi(yv.x) * r0 * gv.y; hv[j].z = xv.z + bflo(yv.y) * r0 * gv.z; hv[j].w = xv.w + bfhi(yv.y) * r0 * gv.w;
            ss += (hv[j].x * hv[j].x + hv[j].y * hv[j].y) + (hv[j].z * hv[j].z + hv[j].w * hv[j].w);
        }
        const float rh = rsqrtf(wave_sum(ss) * (1.f / DM) + 1e-6f);
        uint2* o8 = (uint2*)(xhat1 + (size_t)m * DM) + lane; uint2* h8 = (uint2*)(y0b + (size_t)m * DM) + lane;
#pragma unroll
        for (int j = 0; j < 8; ++j) { o8[64 * j] = make_uint2(pk2(hv[j].x * rh, hv[j].y * rh), pk2(hv[j].z * rh, hv[j].w * rh));
            h8[64 * j] = make_uint2(pk2(hv[j].x, hv[j].y), pk2(hv[j].z, hv[j].w)); }
    } }
    xcd_barrier(bar);
    for (int rep = 0; rep < REP_P5; ++rep) {
        pg8::Gemm g{xhat1, WB_t, MTOK, NWB, DM, DM, DM}; pg8::P5Order S; S.init(MTOK, NWB, G, (int)blockIdx.x); S.cnt = kvcnt; S.ui = 0; S.lastkv = 0; S.elect = (LAS unsigned*)(lds + LDS_BYTES - 64 + 12);
        { pg8::Unit u5; for (int i = 0; S.next(i, u5); ++i) if (u5.pn >= 32 && u5.pn < 44) S.lastkv = i; }
        pg8::EpiK<3> E{qB, kvb};
        pg8::gemm_phase<pg8::EpiK<3>, pg8::P5Order, true, true>(lds, g, S, E);
    }
    for (int rep = 0; rep < REP_EW; ++rep) {
        const int ntl5 = (MTOK / 256) * (NWB / 256);
        pg8::Gemm g{kvb, W1t, 4096, 256, 1024, 2048, 4096}; pg8::CmpOrder S{(int)blockIdx.x, G, ntl5 % G, kvcnt, (unsigned)G, (unsigned*)(ws + WS_BAR) + XB_TMO};
        pg8::EpiPart E{cpart};
        pg8::gemm_phase<pg8::EpiPart, pg8::CmpOrder, false, true>(lds, g, S, E);
        { PHASE_VARS
          const int first5 = ntl5 % G, ci = ((int)blockIdx.x - first5 + G) % G, nidle = first5 ? G - first5 : G, ntr = nidle > 64 ? nidle - 64 : nidle, ct = nidle > 64 ? ci - 64 : ci;
          if (ci < nidle && ct >= 0 && ct < ntr) {
              LAS float* scr64 = (LAS float*)(lds + wave * 20480);
              for (int it = ct * NWAVES + wave; it < 1024; it += 2 * ntr * NWAVES) {
                  const int itb = it + ntr * NWAVES; const bool hasb = itb < 1024;
                  const TItem ta{w_out_b, nullptr, WoB_t, 2048, (it & 31) * 64, 2048, (it >> 5) * 64, DM, (it & 31) * 64, 1.f};
                  const int ib = hasb ? itb : it; const TItem tb{w_out_b, nullptr, WoB_t, 2048, (ib & 31) * 64, 2048, (ib >> 5) * 64, DM, (ib & 31) * 64, 1.f};
                  float va[64], vb[64];
                  titem_load64(ta, va, lane); if (hasb) titem_load64(tb, vb, lane);
                  titem_store64(ta, va, scr64, lane); if (hasb) titem_store64(tb, vb, scr64, lane);
              }
          } }
    }
    xcd_barrier(bar);
    for (int rep = 0; rep < REP_EW; ++rep) {
        PHASE_VARS
        const int sec = ((int)blockIdx.x * 2 >= G) ? 1 : 0, bl = (int)blockIdx.x - sec * (G / 2), nbl = G / 2;
        LAS float* W2s = (LAS float*)lds;
        auto load_a = [&](int rr) -> float4 {
            const int cbl = rr >> 9, row = (sec * 4 + cbl) * 512 + (rr & 511);
            float4 a = *(const float4*)(posvec + sec * 256 + 4 * lane);
#pragma unroll
            for (int q = 1; q < 4; ++q) { const float4 pq = *(const float4*)(posvec + q * 512 + sec * 256 + 4 * lane); a.x += pq.x; a.y += pq.y; a.z += pq.z; a.w += pq.w; }
#pragma unroll
            for (int ks = 0; ks < 4; ++ks) { const uint2 pv = *(const uint2*)(cpart + ((size_t)ks * 4096 + row) * 256 + 4 * lane); a.x += bflo(pv.x); a.y += bfhi(pv.x); a.z += bflo(pv.y); a.w += bfhi(pv.y); }
            return a; };
        const int rr0 = bl * NWAVES + wave, rrs = nbl * NWAVES;
        float4 apre0 = make_float4(0.f, 0.f, 0.f, 0.f), apre1 = apre0;
        if (rr0 < 2048) apre0 = load_a(rr0);
        if (rr0 + rrs < 2048) apre1 = load_a(rr0 + rrs);
        { const float* w2 = sec ? w2v : w2k; att::f32x4 tw[16];
#pragma unroll
          for (int i = 0; i < 16; ++i) tw[i] = *(const att::f32x4*)(w2 + 4 * (tid + i * NTHREADS));
#pragma unroll
          for (int i = 0; i < 16; ++i) *(LAS att::f32x4*)(W2s + 4 * (tid + i * NTHREADS)) = tw[i]; }
        __syncthreads();
        LAS float* hid = (LAS float*)(lds + 131072 + wave * 1024);
        for (int rr = bl * NWAVES + wave; rr < 2048; rr += nbl * NWAVES) {
            const int cbl = rr >> 9, b = (rr >> 7) & 3, c = rr & 127;
            bf16_t* dst = (sec ? vcmp : kcmp) + ((size_t)(b * 4 + cbl) * 128 + c) * HD;
            if (c == 127) { ((unsigned*)dst)[lane] = 0u; continue; }
            const float4 a = (rr == rr0) ? apre0 : ((rr == rr0 + rrs) ? apre1 : load_a(rr));
            float hv[4] = {a.x, a.y, a.z, a.w};
#pragma unroll
            for (int j = 0; j < 4; ++j) { const float v = hv[j]; const float u = 0.7978845608028654f * (v + 0.044715f * v * v * v); hv[j] = 0.5f * v * (1.f + tanhf(u)); }
            *(LAS att::f32x4*)(hid + 4 * lane) = (att::f32x4){hv[0], hv[1], hv[2], hv[3]};
            asm volatile("s_waitcnt lgkmcnt(0)" ::: "memory");
            float o0 = 0.f, o1 = 0.f;
#pragma unroll 8
            for (int kq = 0; kq < 256; ++kq) { const float hq = hid[kq]; const pg8::f32x2 w = *(const LAS pg8::f32x2*)(W2s + kq * 128 + 2 * lane); o0 += hq * w[0]; o1 += hq * w[1]; }
            ((unsigned*)dst)[lane] = pk2(o0, o1);
            asm volatile("s_waitcnt lgkmcnt(0)" ::: "memory");
        }
    }
    xcd_barrier(bar);
    for (int rep = 0; rep < REP_P7; ++rep) {
        const int tid_ph = threadIdx.x; const int wave = __builtin_amdgcn_readfirstlane(tid_ph >> 6);
        const int jh = wave >> 1, sub = wave & 1;
        const int vcu = (G % 8 == 0) ? ((int)blockIdx.x % 8) * (G / 8) + (int)blockIdx.x / 8 : (int)blockIdx.x;
        LAS float* Tsel = (LAS float*)(lds + L_TSEL); LAS float* Twin = (LAS float*)(lds + L_TWIN);
        LAS float* impH = (LAS float*)(lds + L_IMPH);
        LAS unsigned* selm = (LAS unsigned*)(lds + L_SELM); LAS int* tl = (LAS int*)(lds + L_TL);
        const float NINF = -__builtin_inff();
        for (int pi = vcu; pi < 256; pi += G) {
        {
            const int gq = (pi >> 4) & 3; const int tid = tid_ph;
            LAS float* tab4 = (LAS float*)(lds + L_TAB4);
            if (tid < 128) tab4[tid] = table[(tid >> 2) * NH + gq * 4 + (tid & 3)] * att::LOG2E;
            __syncthreads();
            for (int i0 = tid; i0 < 4 * 2112; i0 += 4 * NTHREADS) { float v[4];
#pragma unroll
                for (int j = 0; j < 4; ++j) { const int i = i0 + j * NTHREADS, hh = i / 2112, xx = i - hh * 2112, dist = xx - 64; v[j] = (i < 4 * 2112 && dist >= 0) ? tab4[rel_bucket(dist) * 4 + hh] : NINF; }
#pragma unroll
                for (int j = 0; j < 4; ++j) { const int i = i0 + j * NTHREADS, hh = i / 2112, xx = i - hh * 2112; if (i < 4 * 2112) Tsel[hh * 2112 + 2111 - xx] = v[j]; } }
            for (int i0 = tid; i0 < 4 * 640; i0 += 4 * NTHREADS) { float v[4];
#pragma unroll
                for (int j = 0; j < 4; ++j) { const int i = i0 + j * NTHREADS, hh = i / 640, xx = i - hh * 640, delta = xx - 64; v[j] = (i < 4 * 640 && delta >= 0 && delta < 512) ? tab4[rel_bucket(delta) * 4 + hh] : NINF; }
#pragma unroll
                for (int j = 0; j < 4; ++j) { const int i = i0 + j * NTHREADS, hh = i / 640, xx = i - hh * 640; if (i < 4 * 640) Twin[hh * 640 + 639 - xx] = v[j]; } }
        }
        for (int pass = 0; pass < 2; ++pass) {
            int tid = tid_ph; asm volatile("" : "+v"(tid));
            const int lane = tid & 63, r32 = lane & 31, hi = lane >> 5;
            const int bg = pi >> 4, qb = pass ? 31 - (pi & 15) : (pi & 15), b = bg >> 2, gq = bg & 3, h = gq * 4 + jh;
            const int tq = 64 * qb + 32 * sub + r32;
            const int grow0 = b * SEQ + 64 * qb + 32 * sub;
            const LAS float* Tsh = Tsel + jh * 2112; const LAS float* Twh = Twin + jh * 640;
            att::bf16x8 qr[8];
            { const bf16_t* qp = qB + ((size_t)h * MTOK + grow0 + r32) * HD + hi * 8;
#pragma unroll
              for (int d0 = 0; d0 < 8; ++d0) qr[d0] = *(const att::bf16x8*)(qp + d0 * 16); }
            att::f32x16 o[4];
            {
                const int sr = tid >> 4, sc = (tid & 15) * 8, vst0 = att::v_st(sr, sc), vst1 = att::v_st(32 + sr, sc), kws = ATT_KSWZ(sr, sc * 2);
                const bf16_t* Kc = kcmp + (size_t)bg * 128 * HD; const bf16_t* Vc = vcmp + (size_t)bg * 128 * HD;
#pragma unroll
                for (int tt = 0; tt < 2; ++tt) {
                    const size_t e0 = (size_t)(64 * tt + sr) * HD + sc, e1 = e0 + 32 * HD;
                    *(LAS att::bf16x8*)(lds + att::L_K + tt * att::SHM_K + kws) = *(const att::bf16x8*)(Kc + e0); *(LAS att::bf16x8*)(lds + att::L_K + tt * att::SHM_K + kws + 32 * 256) = *(const att::bf16x8*)(Kc + e1);
                    *(LAS att::bf16x8*)(lds + att::L_V + tt * att::SHM_V + vst0) = *(const att::bf16x8*)(Vc + e0); *(LAS att::bf16x8*)(lds + att::L_V + tt * att::SHM_V + vst1) = *(const att::bf16x8*)(Vc + e1);
                }
                __syncthreads();
                att::f32x16 pA0, pA1, pB0, pB1;
                const int xb = tq + 33 - 64 * hi;
#pragma unroll
                for (int r = 0; r < 16; ++r) { const int cr = 16 * ((r & 3) + 8 * (r >> 2));
                    pA0[r] = Tsh[2111 - max(xb - cr, 0)]; pA1[r] = Tsh[2111 - max(xb - cr - 512, 0)]; pB0[r] = Tsh[2111 - max(xb - cr - 1024, 0)]; pB1[r] = Tsh[2111 - max(xb - cr - 1536, 0)]; }
                {
                    const LAS unsigned char* kb[4];
#pragma unroll
                    for (int dd = 0; dd < 4; ++dd) kb[dd] = lds + att::L_K + ATT_KSWZ(r32, (dd * 16 + hi * 8) * 2);
#pragma unroll
                    for (int d0 = 0; d0 < 8; ++d0) { const LAS unsigned char* a = kb[d0 & 3] + (d0 >> 2) * 128;
                        pA0 = __builtin_amdgcn_mfma_f32_32x32x16_bf16(*(const LAS att::bf16x8*)a, qr[d0], pA0, 0, 0, 0);
                        pA1 = __builtin_amdgcn_mfma_f32_32x32x16_bf16(*(const LAS att::bf16x8*)(a + 32 * 256), qr[d0], pA1, 0, 0, 0);
                        pB0 = __builtin_amdgcn_mfma_f32_32x32x16_bf16(*(const LAS att::bf16x8*)(a + att::SHM_K), qr[d0], pB0, 0, 0, 0);
                        pB1 = __builtin_amdgcn_mfma_f32_32x32x16_bf16(*(const LAS att::bf16x8*)(a + att::SHM_K + 32 * 256), qr[d0], pB1, 0, 0, 0); }
                }
                float mx = NINF;
#pragma unroll
                for (int r = 0; r < 16; ++r) mx = fmaxf(fmaxf(mx, pA0[r]), fmaxf(fmaxf(pA1[r], pB0[r]), pB1[r]));
                { auto rr = __builtin_amdgcn_permlane32_swap(__float_as_uint(mx), __float_as_uint(mx), false, false); mx = fmaxf(__uint_as_float(rr[0]), __uint_as_float(rr[1])); }
                if (mx == NINF) mx = 0.f;
                float ps = 0.f;
#pragma unroll
                for (int r = 0; r < 16; ++r) { pA0[r] = __builtin_amdgcn_exp2f(pA0[r] - mx); pA1[r] = __builtin_amdgcn_exp2f(pA1[r] - mx);
                    pB0[r] = __builtin_amdgcn_exp2f(pB0[r] - mx); pB1[r] = __builtin_amdgcn_exp2f(pB1[r] - mx); ps += (pA0[r] + pA1[r]) + (pB0[r] + pB1[r]); }
                { auto rr = __builtin_amdgcn_permlane32_swap(__float_as_uint(ps), __float_as_uint(ps), false, false); ps = __uint_as_float(rr[0]) + __uint_as_float(rr[1]); }
                const float l_c = ps, inv = ps > 0.f ? frcp(ps) : 0.f;
                {
                    const int qrow = 32 * sub + r32; LAS float* ip = impH + (jh * 64 + qrow) * 32 + hi;
                    float eprev = 0.f;
#define IMP_GRP(P, U0) do { _Pragma("unroll") for (int q4 = 0; q4 < 4; ++q4) { \
                        const float gsum = ((P[4 * q4] + P[4 * q4 + 1]) + (P[4 * q4 + 2] + P[4 * q4 + 3])) * inv, e3 = P[4 * q4 + 3] * inv; \
                        const float eo = __uint_as_float(__builtin_amdgcn_permlane32_swap(__float_as_uint(e3), __float_as_uint(e3), false, false)[hi ? 0 : 1]);     \
                        const float ein = hi ? eo : eprev; eprev = eo; ip[2 * ((U0) + q4)] = gsum + ein; } } while (0)
                    IMP_GRP(pA0, 0); IMP_GRP(pA1, 4); IMP_GRP(pB0, 8); IMP_GRP(pB1, 12);
#undef IMP_GRP
                }
                att::bf16x8 pa0, pa1, pa2, pa3, pb0, pb1, pb2, pb3;
                ATT_PK4(pA0, 0, pa0); ATT_PK4(pA0, 8, pa1); ATT_PK4(pA1, 0, pa2); ATT_PK4(pA1, 8, pa3);
                ATT_PK4(pB0, 0, pb0); ATT_PK4(pB0, 8, pb1); ATT_PK4(pB1, 0, pb2); ATT_PK4(pB1, 8, pb3);
#pragma unroll
                for (int d_ = 0; d_ < 4; ++d_)
#pragma unroll
                    for (int r = 0; r < 16; ++r) o[d_][r] = 0.f;
                const int vb0 = att::L_V + att::v_rd_base(lane);
                att::pv_tile(o, vb0, pa0, pa1, pa2, pa3);
                att::pv_tile(o, vb0 + att::SHM_V, pb0, pb1, pb2, pb3);
                __syncthreads();
                {
                    const int q = tid >> 3, n4 = (tid & 7) * 4, cur = qb;
                    float vals[32];
#pragma unroll
                    for (int i = 0; i < 8; ++i) {
                        att::f32x4 gv = *(const LAS att::f32x4*)(impH + (0 * 64 + q) * 32 + 4 * i);
                        gv += *(const LAS att::f32x4*)(impH + (1 * 64 + q) * 32 + 4 * i); gv += *(const LAS att::f32x4*)(impH + (2 * 64 + q) * 32 + 4 * i); gv += *(const LAS att::f32x4*)(impH + (3 * 64 + q) * 32 + 4 * i);
#pragma unroll
                        for (int e = 0; e < 4; ++e) { const int n = 4 * i + e; const bool forced = (n == 0) || (n == cur) || (n == cur - 1);
                            vals[n] = forced ? 1e9f : (n > cur ? -1e9f : gv[e]); } }
                    att::f32x4 mine = *(const LAS att::f32x4*)(impH + (0 * 64 + q) * 32 + n4);
                    mine += *(const LAS att::f32x4*)(impH + (1 * 64 + q) * 32 + n4); mine += *(const LAS att::f32x4*)(impH + (2 * 64 + q) * 32 + n4); mine += *(const LAS att::f32x4*)(impH + (3 * 64 + q) * 32 + n4);
                    unsigned bits = 0u;
#pragma unroll
                    for (int e = 0; e < 4; ++e) {
                        const int n = n4 + e; const bool forced = (n == 0) || (n == cur) || (n == cur - 1);
                        const float myv = forced ? 1e9f : (n > cur ? -1e9f : mine[e]);
                        int rank = 0;
#pragma unroll
                        for (int m2 = 0; m2 < 32; ++m2) rank += (vals[m2] > myv || (vals[m2] == myv && m2 < n)) ? 1 : 0;
                        if (rank < 16 && n <= cur) bits |= 1u << n;
                    }
                    bits |= __shfl_xor(bits, 1); bits |= __shfl_xor(bits, 2); bits |= __shfl_xor(bits, 4);
                    if ((tid & 7) == 0) selm[q] = bits;
                }
                __syncthreads();
                if (tid < 64) {
                    unsigned un = selm[lane];
#pragma unroll
                    for (int off = 1; off < 64; off <<= 1) un |= __shfl_xor(un, off);
                    if (lane < 32 && ((un >> lane) & 1u)) tl[__popc(un & ((1u << lane) - 1u))] = lane;
                    if (lane == 0) { tl[32] = __popc(un); tl[33] = (int)un; }
                }
                __syncthreads();
                GateF F{zB + (size_t)grow0 * 6144 + 0 * 2048 + h * HD, gB + (size_t)grow0 * 256 + 0 * 16 + h, a1 + (size_t)grow0 * DM + h * HD, 1};
                att::emit(lds, o, l_c, lane, wave, F);
            }
            {
                SelU U; U.K = kvb + ((size_t)(2 * 4 + gq) * MTOK + b * SEQ) * HD; U.V = kvb + ((size_t)(3 * 4 + gq) * MTOK + b * SEQ) * HD;
                U.un = (unsigned)__builtin_amdgcn_readfirstlane(tl[33]); U.ntl = __builtin_amdgcn_readfirstlane(tl[32]); U.mymask = selm[32 * sub + r32]; U.tq_off = tq - 4 * hi + 5; U.T = Tsh;
#pragma unroll
                for (int d_ = 0; d_ < 4; ++d_)
#pragma unroll
                    for (int r = 0; r < 16; ++r) o[d_][r] = 0.f;
                float m_reg = -1e30f, l_reg = 0.f;
                for (int rf = 0; rf < REP_F7; ++rf) {
                    if (rf) { asm volatile("" :: "v"(o[0]), "v"(o[1]), "v"(o[2]), "v"(o[3]), "v"(m_reg), "v"(l_reg));
#pragma unroll
                        for (int d_ = 0; d_ < 4; ++d_)
#pragma unroll
                            for (int r = 0; r < 16; ++r) o[d_][r] = 0.f;
                        m_reg = -1e30f; l_reg = 0.f; }
                    att::flash_tiles(lds, U, qr, o, m_reg, l_reg, tid, lane, wave);
                }
                GateF F{zB + (size_t)grow0 * 6144 + 1 * 2048 + h * HD, gB + (size_t)grow0 * 256 + 1 * 16 + h, a1 + (size_t)grow0 * DM + h * HD, 0};
                att::emit(lds, o, l_reg, lane, wave, F);
            }
            {
                WinU U; U.K = kvb + ((size_t)(4 * 4 + gq) * MTOK + b * SEQ) * HD; U.V = kvb + ((size_t)(5 * 4 + gq) * MTOK + b * SEQ) * HD;
                const int jlo = qb < 8 ? 8 - qb : 0; U.tk_base = 64 * qb - 512 + 64 * jlo; U.ntl = 9 - jlo; U.tq_off = tq - 4 * hi + 5; U.T = Twh;
#pragma unroll
                for (int d_ = 0; d_ < 4; ++d_)
#pragma unroll
                    for (int r = 0; r < 16; ++r) o[d_][r] = 0.f;
                float m_reg = -1e30f, l_reg = 0.f;
                for (int rf = 0; rf < REP_F7; ++rf) {
                    if (rf) { asm volatile("" :: "v"(o[0]), "v"(o[1]), "v"(o[2]), "v"(o[3]), "v"(m_reg), "v"(l_reg));
#pragma unroll
                        for (int d_ = 0; d_ < 4; ++d_)
#pragma unroll
                            for (int r = 0; r < 16; ++r) o[d_][r] = 0.f;
                        m_reg = -1e30f; l_reg = 0.f; }
                    att::flash_tiles(lds, U, qr, o, m_reg, l_reg, tid, lane, wave);
                }
                GateF F{zB + (size_t)grow0 * 6144 + 2 * 2048 + h * HD, gB + (size_t)grow0 * 256 + 2 * 16 + h, a1 + (size_t)grow0 * DM + h * HD, 0};
                att::emit(lds, o, l_reg, lane, wave, F);
            }
        }
        __syncthreads();
        }
    }
    xcd_barrier(bar);
    for (int rep = 0; rep < REP_G2; ++rep) {
        pg8::Gemm g{a1, WoB_t, MTOK, DM, DM, DM, DM}; pg8::StaticOrder S; S.init(MTOK, DM, G, (int)blockIdx.x);
        pg8::EpiK<2> E{y1b, (bf16_t*)ssq1};
        pg8::gemm_phase<pg8::EpiK<2>, pg8::StaticOrder, true, true>(lds, g, S, E);
    }
    xcd_barrier(bar);
    for (int rep = 0; rep < REP_EW; ++rep) { PHASE_VARS
    for (int m = gw; m < MTOK; m += NGW) {
        float sp = (lane < 32) ? ssq1[(size_t)m * 32 + lane] : 0.f;
        const float r1 = rsqrtf(wave_sum(sp) * (1.f / DM) + 1e-6f);
        const uint2* y0r = (const uint2*)(y0b + (size_t)m * DM) + lane; const uint2* y1r = (const uint2*)(y1b + (size_t)m * DM) + lane;
        const float4* g1r = (const float4*)(norm_post + DM) + lane;
        float4* orow = (float4*)(p.out + (size_t)m * DM) + lane;
#pragma unroll
        for (int j = 0; j < 8; ++j) {
            const uint2 a = ldnt2(y0r + 64 * j), bb = ldnt2(y1r + 64 * j); const float4 g1 = g1r[64 * j];
            float4 o;
            o.x = bflo(a.x) + bflo(bb.x) * r1 * g1.x; o.y = bfhi(a.x) + bfhi(bb.x) * r1 * g1.y;
            o.z = bflo(a.y) + bflo(bb.y) * r1 * g1.z; o.w = bfhi(a.y) + bfhi(bb.y) * r1 * g1.w;
            { att::f32x4 ov = {o.x, o.y, o.z, o.w}; __builtin_nontemporal_store(ov, (att::f32x4*)(orow + 64 * j)); }
        }
    } }
}

extern "C" void kernel_launch(void* const* d_in, const int* in_sizes, int n_in, void* d_out, int out_size, void* d_ws, size_t ws_size, hipStream_t stream) {
    static int grid = 0;
    if (grid == 0) {
        if (n_in != 16 || ws_size < WS_END) { fprintf(stderr, "kernel_launch: unexpected n_in %d / ws_size %zu\n", n_in, ws_size); grid = -1; return; }
        int dev = 0, cus = 0, per_cu = 0;
        (void)hipGetDevice(&dev); (void)hipDeviceGetAttribute(&cus, hipDeviceAttributeMultiprocessorCount, dev);
        if (hipFuncSetAttribute((const void*)yoco_fwd, hipFuncAttributeMaxDynamicSharedMemorySize, LDS_BYTES) != hipSuccess) { fprintf(stderr, "kernel_launch: hipFuncSetAttribute failed\n"); grid = -1; return; }
        if (hipOccupancyMaxActiveBlocksPerMultiprocessor(&per_cu, (const void*)yoco_fwd, NTHREADS, LDS_BYTES) != hipSuccess || per_cu < 1) { fprintf(stderr, "kernel_launch: occupancy query says %d\n", per_cu); per_cu = 1; }
        (void)hipGetLastError();
        grid = cus;
        if (grid != 256) fprintf(stderr, "kernel_launch: note: %d CUs\n", grid);
    }
    if (grid < 0) return;
    if (hipMemsetAsync((char*)d_ws + WS_BAR, 0, 16384, stream) != hipSuccess) { fprintf(stderr, "kernel_launch: memset failed\n"); return; }
    Params prm{};
    for (int i = 0; i < 16; ++i) prm.in[i] = (const float*)d_in[i];
    prm.out = (float*)d_out; prm.ws = (unsigned char*)d_ws;
    void* args[] = {&prm};
    hipError_t e = hipLaunchCooperativeKernel((const void*)yoco_fwd, dim3(grid), dim3(NTHREADS), args, LDS_BYTES, stream);
    if (e != hipSuccess) fprintf(stderr, "kernel_launch: cooperative launch failed: %s (grid %d)\n", hipGetErrorString(e), grid);
}
```

```cpp
#include <hip/hip_runtime.h>
#include <hip/hip_cooperative_groups.h>
#include <cstdio>
#include <cstdint>
namespace cg = cooperative_groups;

namespace pg8 {
#define PG8_LAS __attribute__((address_space(3)))
typedef unsigned short bf16_t;
typedef short bf16x8 __attribute__((ext_vector_type(8)));
typedef float f32x4 __attribute__((ext_vector_type(4)));
typedef unsigned u32x4 __attribute__((ext_vector_type(4)));
constexpr int BM = 256, BK = 64, HALF = 128, HTB = HALF * BK * 2  , STAGE_BYTES = 8 * HTB, NXCD = 8, WGM = 8;

__host__ __device__ __forceinline__ int lds_byte(int r, int c) { const int st = (r >> 4) * 2 + (c >> 5), rr = r & 15, cc = c & 31, ob = rr * 64 + cc * 2; return st * 1024 + (ob ^ (((ob >> 9) & 1) << 5)); }
__host__ __device__ __forceinline__ void stage_rc(int b, int& R, int& C) { const int st = b / 1024, sb = b % 1024, swz = sb ^ (((sb >> 9) & 1) << 5); R = (st >> 1) * 16 + swz / 64; C = (st & 1) * 32 + (swz % 64) / 2; }
__host__ __device__ __forceinline__ int perm32(int rho) { const int n = rho >> 4, i = rho & 15; return 8 * (i >> 2) + 4 * n + (i & 3); }

struct Unit { int pm, pn; };
struct Gemm { const bf16_t* A; const bf16_t* Bt; int M, N, K, lda, ldb; };

struct StaticOrder {
    int nM, nN, nwg, G, c;
    __host__ __device__ void init(int M, int N, int G_, int c_) { nM = M / BM; nN = N / BM; nwg = nM * nN; G = G_; c = c_; }
    __host__ __device__ bool next(int i, Unit& u) const {
        const long L = (long)i * G + c; if (L >= nwg) return false;
        int wgid = (int)L; { const int q = nwg / NXCD, r = nwg % NXCD, xcd = wgid % NXCD, off = wgid / NXCD; wgid = (xcd < r ? xcd * (q + 1) : r * (q + 1) + (xcd - r) * q) + off; }
        const int nig = WGM * nN, gid = wgid / nig, fm = gid * WGM, gsz = (nM - fm) < WGM ? (nM - fm) : WGM;
        u.pm = fm + ((wgid % nig) % gsz); u.pn = (wgid % nig) / gsz; return true;
    }
    __device__ __forceinline__ void a_ready(const Unit&) const {}
    __device__ __forceinline__ void done(const Unit&) const {}
    __device__ __forceinline__ const char* abase(const Gemm& g, const Unit& u) const { return (const char*)g.A + (size_t)u.pm * BM * g.lda * 2; }
    __device__ __forceinline__ const char* bbase(const Gemm& g, const Unit& u) const { return (const char*)g.Bt + (size_t)u.pn * BM * g.ldb * 2; }
};

__device__ __forceinline__ unsigned cvt_pk_bf16(float lo, float hi) { unsigned r; asm volatile("v_cvt_pk_bf16_f32 %0, %1, %2" : "=v"(r) : "v"(lo), "v"(hi)); return r; }
typedef float f32x2 __attribute__((ext_vector_type(2)));

template <int KIND> struct EpiK {
    static constexpr bool PERM = true, AFTER_DRAIN = false;
    bf16_t* b0; bf16_t* b1;
    __device__ __forceinline__ void operator()(const f32x4 (&acc)[2][2][4][2], const Unit& u, int wr, int wc, int fr, int fq) const {
        bf16_t* base; bool hm; int ld = 2048, pr = u.pn;
        if (KIND == 1) { if (u.pn < 24) { base = b0; hm = true; } else { base = b1; hm = false; pr = u.pn - 24; } }
        else if (KIND == 2) { base = b0; hm = false; }
        else { if (u.pn < 8) { base = b0; hm = true; } else if (u.pn < 32) { base = b0 + (size_t)16 * 1024 * 1024; hm = false; ld = 6144; pr = u.pn - 8; }
               else if (u.pn < 44) { base = b1; hm = true; pr = u.pn - 32; } else { base = b1 + (size_t)24 * 1024 * 1024; hm = false; ld = 256; pr = 0; } }
        const int row0 = u.pm * BM + wr * 64 + fr;
        const int cin = wc * 32 + 8 * fq;
#pragma unroll
        for (int ai = 0; ai < 2; ++ai)
#pragma unroll
            for (int m = 0; m < 4; ++m) {
                const int row = row0 + ai * HALF + m * 16;
                float s = 0.f;
#pragma unroll
                for (int bj = 0; bj < 2; ++bj) {
                    const f32x4 v0 = acc[ai][bj][m][0], v1 = acc[ai][bj][m][1];
                    if (KIND == 2) s += (v0[0] * v0[0] + v0[1] * v0[1]) + (v0[2] * v0[2] + v0[3] * v0[3]) + (v1[0] * v1[0] + v1[1] * v1[1]) + (v1[2] * v1[2] + v1[3] * v1[3]);
                    u32x4 w; w.x = cvt_pk_bf16(v0[0], v0[1]); w.y = cvt_pk_bf16(v0[2], v0[3]); w.z = cvt_pk_bf16(v1[0], v1[1]); w.w = cvt_pk_bf16(v1[2], v1[3]);
                    bf16_t* dst = hm ? base + ((size_t)(pr * 2 + bj) * 8192 + row) * 128 + cin
                                     : base + (size_t)row * ld + pr * 256 + bj * HALF + cin;
                    *(u32x4*)dst = w;
                }
                if (KIND == 2) { s += __shfl_xor(s, 16); s += __shfl_xor(s, 32); if (fq == 0) ((float*)b1)[(size_t)row * 32 + u.pn * 4 + wc] = s; }
            }
    }
};

struct EpiPart {
    static constexpr bool PERM = true, AFTER_DRAIN = false;
    bf16_t* part;
    __device__ __forceinline__ void operator()(const f32x4 (&acc)[2][2][4][2], const Unit& u, int wr, int wc, int fr, int fq) const {
        bf16_t* base = part + ((size_t)u.pn * 4096 + (size_t)u.pm * BM + wr * 64 + fr) * 256 + wc * 32 + 8 * fq;
#pragma unroll
        for (int ai = 0; ai < 2; ++ai)
#pragma unroll
            for (int m = 0; m < 4; ++m)
#pragma unroll
                for (int bj = 0; bj < 2; ++bj) {
                    const f32x4 v0 = acc[ai][bj][m][0], v1 = acc[ai][bj][m][1];
                    u32x4 w; w.x = cvt_pk_bf16(v0[0], v0[1]); w.y = cvt_pk_bf16(v0[2], v0[3]); w.z = cvt_pk_bf16(v1[0], v1[1]); w.w = cvt_pk_bf16(v1[2], v1[3]);
                    *(u32x4*)(base + (size_t)(ai * HALF + m * 16) * 256 + bj * HALF) = w; }
    }
};
struct P5Order : StaticOrder {
    unsigned* cnt; int lastkv; mutable int ui; PG8_LAS unsigned* elect;
    __device__ __forceinline__ bool next(int i, Unit& u) const { if (!StaticOrder::next(i, u)) return false; u.pn = u.pn + 32 >= nN ? u.pn + 32 - nN : u.pn + 32; return true; }
    __device__ __forceinline__ void done(const Unit&) const {
        if (ui++ == lastkv) { asm volatile("s_waitcnt vmcnt(0)" ::: "memory");
            unsigned prev = 0u; if ((threadIdx.x & 63) == 0) prev = __hip_atomic_fetch_add(elect, 1u, __ATOMIC_RELAXED, __HIP_MEMORY_SCOPE_WORKGROUP);
            if ((unsigned)__builtin_amdgcn_readfirstlane((int)prev) == 7u) {
                __builtin_amdgcn_fence(__ATOMIC_RELEASE, "agent"); asm volatile("s_waitcnt vmcnt(0)" ::: "memory");
                if ((threadIdx.x & 63) == 0) { (void)__hip_atomic_fetch_add(cnt, 1u, __ATOMIC_RELAXED, __HIP_MEMORY_SCOPE_AGENT); __hip_atomic_store(elect, 0u, __ATOMIC_RELAXED, __HIP_MEMORY_SCOPE_WORKGROUP); } } }
    }
};
struct CmpOrder {
    int c, G, first; const unsigned* cnt; unsigned need; unsigned* tmo;
    __device__ __forceinline__ bool next(int i, Unit& u) const { const int j = (c - first + G) % G + i * G; if (j >= 64) return false; u.pm = j >> 2; u.pn = j & 3; return true; }
    __device__ __forceinline__ void a_ready(const Unit&) const {
        if (threadIdx.x < 64) {
            unsigned sp = 0u;
            while ((unsigned)__builtin_amdgcn_readfirstlane(__hip_atomic_load(cnt, __ATOMIC_RELAXED, __HIP_MEMORY_SCOPE_AGENT)) < need) {
                __builtin_amdgcn_s_sleep(2);
                if ((++sp & 255u) == 0u) { if (__hip_atomic_load(tmo, __ATOMIC_RELAXED, __HIP_MEMORY_SCOPE_AGENT)) break; if (sp > (1u << 18)) { atomicAdd(tmo, 1u); break; } } }
            __builtin_amdgcn_fence(__ATOMIC_ACQUIRE, "agent");
            asm volatile("s_waitcnt vmcnt(0)" ::: "memory");
        }
        asm volatile("" ::: "memory"); __builtin_amdgcn_s_barrier(); asm volatile("" ::: "memory");
    }
    __device__ __forceinline__ void done(const Unit&) const {}
    __device__ __forceinline__ const char* abase(const Gemm& g, const Unit& u) const { const int cb = u.pm >> 1, mt = u.pm & 1; return (const char*)g.A + ((size_t)cb * 8192 * 128 + (size_t)mt * 256 * 2048 + (size_t)u.pn * 1024) * 2; }
    __device__ __forceinline__ const char* bbase(const Gemm& g, const Unit& u) const { const int sec = u.pm >> 3; return (const char*)g.Bt + ((size_t)sec * 256 * 4096 + (size_t)u.pn * 1024) * 2; }
};
template <class Epi, class Sched, bool ALIGN_EPI = false, bool SP2 = false>
__device__ __forceinline__ void gemm_phase(PG8_LAS unsigned char* lds, const Gemm g, const Sched& S, const Epi& E) {
    int tid_raw = threadIdx.x; asm volatile("" : "+v"(tid_raw));
    const int tid = tid_raw, wid = __builtin_amdgcn_readfirstlane(tid >> 6), lane = tid & 63, wr = wid >> 2, wc = wid & 3, fr = lane & 15, fq = lane >> 4;
    const int K = g.K, nt = K / BK;
    unsigned voffA[2], voffB[2];
#pragma unroll
    for (int i = 0; i < 2; ++i) { int R, C; stage_rc(tid * 16 + i * 8192, R, C); const int Rb = Epi::PERM ? ((R & ~31) + perm32(R & 31)) : R;
        voffA[i] = (unsigned)(R * g.lda + C) * 2u; voffB[i] = (unsigned)(Rb * g.ldb + C) * 2u; }
    const size_t kstep = (size_t)(BK * 2);
    const size_t hstepA = (size_t)HALF * g.lda * 2, hstepB = (size_t)HALF * g.ldb * 2;
    const unsigned ldsw = (unsigned)wid * 1024u;
    const int aoff = lds_byte(wr * 64 + fr, fq * 8), boff = lds_byte(wc * 32 + fr, fq * 8);
#define PG8_SA(b, h) (((b) * 2 + (h)) * HTB)
#define PG8_SB(b, h) ((4 + (b) * 2 + (h)) * HTB)
#define PG8_STAGE(bufoff, gbase, voff) do { _Pragma("unroll") for (int _i = 0; _i < 2; ++_i) \
        __builtin_amdgcn_global_load_lds((const unsigned*)((const char*)(gbase) + (voff)[_i]), (PG8_LAS unsigned*)(lds + (bufoff) + ldsw + _i * 8192), 16, 0, 0); } while (0)
#define PG8_LDA(dst, b, h) do { _Pragma("unroll") for (int m = 0; m < 4; ++m) _Pragma("unroll") for (int k = 0; k < 2; ++k) dst[m][k] = *(const PG8_LAS bf16x8*)(lds + PG8_SA(b, h) + aoff + m * 2048 + k * 1024); } while (0)
#define PG8_LDB(dst, b, h) do { _Pragma("unroll") for (int n = 0; n < 2; ++n) _Pragma("unroll") for (int k = 0; k < 2; ++k) dst[n][k] = *(const PG8_LAS bf16x8*)(lds + PG8_SB(b, h) + boff + n * 2048 + k * 1024); } while (0)
#define PG8_MMA(ai, bj, At, Bt) do { __builtin_amdgcn_s_setprio(1); _Pragma("unroll") for (int m = 0; m < 4; ++m) _Pragma("unroll") for (int n = 0; n < 2; ++n) _Pragma("unroll") for (int k = 0; k < 2; ++k) \
        acc[ai][bj][m][n] = __builtin_amdgcn_mfma_f32_16x16x32_bf16(Bt[n][k], At[m][k], acc[ai][bj][m][n], 0, 0, 0); __builtin_amdgcn_s_setprio(0); } while (0)
#define PG8_WAIT_V(n) asm volatile("s_waitcnt vmcnt(" #n ")" ::: "memory")
#define PG8_WAIT_L(n) asm volatile("s_waitcnt lgkmcnt(" #n ")" ::: "memory")
#define PG8_BAR __builtin_amdgcn_s_barrier()
#define PG8_SCHED __builtin_amdgcn_sched_barrier(0)
    Unit cur, nxt; int ui = 0;
    if (!S.next(0, cur)) return;
    f32x4 acc[2][2][4][2];
#pragma unroll
    for (int a = 0; a < 2; ++a)
#pragma unroll
        for (int b = 0; b < 2; ++b)
#pragma unroll
            for (int m = 0; m < 4; ++m)
#pragma unroll
                for (int n = 0; n < 2; ++n) acc[a][b][m][n] = (f32x4){0.f, 0.f, 0.f, 0.f};
    bf16x8 At[4][2], B0[2][2], B1[2][2];
    const char* cA = S.abase(g, cur); const char* cB = S.bbase(g, cur);
    S.a_ready(cur);
    if constexpr (SP2) {
        PG8_STAGE(PG8_SB(0, 0), cB, voffB); PG8_STAGE(PG8_SB(0, 1), cB + hstepB, voffB); PG8_STAGE(PG8_SA(0, 0), cA, voffA); PG8_STAGE(PG8_SA(0, 1), cA + hstepA, voffA);
        if (wr == 1) PG8_BAR;
        PG8_WAIT_V(2); PG8_BAR;
        PG8_STAGE(PG8_SB(1, 0), cB + kstep, voffB); PG8_STAGE(PG8_SA(1, 0), cA + kstep, voffA); PG8_STAGE(PG8_SB(1, 1), cB + hstepB + kstep, voffB);
        PG8_WAIT_V(6); PG8_BAR;
    } else {
        PG8_STAGE(PG8_SB(0, 0), cB, voffB); PG8_STAGE(PG8_SA(0, 0), cA, voffA); PG8_STAGE(PG8_SB(0, 1), cB + hstepB, voffB); PG8_STAGE(PG8_SA(0, 1), cA + hstepA, voffA);
        if (wr == 1) PG8_BAR;
        PG8_WAIT_V(4); PG8_BAR;
        PG8_STAGE(PG8_SB(1, 0), cB + kstep, voffB); PG8_STAGE(PG8_SA(1, 0), cA + kstep, voffA); PG8_STAGE(PG8_SB(1, 1), cB + hstepB + kstep, voffB);
        PG8_WAIT_V(6); PG8_BAR;
    }
    for (;;) {
        const bool has_next = S.next(ui + 1, nxt);
        const char* nA = has_next ? S.abase(g, nxt) : cA; const char* nB = has_next ? S.bbase(g, nxt) : cB;
        for (int t = 0; t < nt; t += 2) {
            const bool last = (t == nt - 2);
            const char* a1 = cA + (size_t)(t + 1) * kstep;
            const char* a2 = last ? nA : cA + (size_t)(t + 2) * kstep; const char* b2 = last ? nB : cB + (size_t)(t + 2) * kstep;
            const char* a3 = a2 + kstep; const char* b3 = b2 + kstep;
            if (last && has_next) S.a_ready(nxt);
            if constexpr (SP2) {
            PG8_LDB(B0, 0, 0); PG8_LDB(B1, 0, 1); PG8_SCHED; PG8_LDA(At, 0, 0); PG8_STAGE(PG8_SA(1, 1), a1 + hstepA, voffA);
            PG8_WAIT_V(8); PG8_WAIT_L(0); PG8_BAR; PG8_MMA(0, 0, At, B0); PG8_MMA(0, 1, At, B1); PG8_BAR; PG8_SCHED;
            PG8_LDA(At, 0, 1); PG8_STAGE(PG8_SB(0, 0), b2, voffB); PG8_STAGE(PG8_SB(0, 1), b2 + hstepB, voffB); PG8_STAGE(PG8_SA(0, 0), a2, voffA);
            PG8_WAIT_V(8); PG8_WAIT_L(0); PG8_BAR; PG8_MMA(1, 0, At, B0); PG8_MMA(1, 1, At, B1); PG8_BAR; PG8_SCHED;
            PG8_LDB(B0, 1, 0); PG8_LDB(B1, 1, 1); PG8_SCHED; PG8_LDA(At, 1, 0); PG8_STAGE(PG8_SA(0, 1), a2 + hstepA, voffA);
            PG8_WAIT_V(8); PG8_WAIT_L(0); PG8_BAR; PG8_MMA(0, 0, At, B0); PG8_MMA(0, 1, At, B1); PG8_BAR; PG8_SCHED;
            PG8_LDA(At, 1, 1); PG8_STAGE(PG8_SB(1, 0), b3, voffB); PG8_STAGE(PG8_SB(1, 1), b3 + hstepB, voffB); PG8_STAGE(PG8_SA(1, 0), a3, voffA);
            PG8_WAIT_V(8); PG8_WAIT_L(0); PG8_BAR; PG8_MMA(1, 0, At, B0); PG8_MMA(1, 1, At, B1); PG8_BAR; PG8_SCHED;
            } else {
            PG8_LDB(B0, 0, 0); PG8_SCHED; PG8_LDA(At, 0, 0); PG8_STAGE(PG8_SA(1, 1), a1 + hstepA, voffA);
            PG8_WAIT_L(8); PG8_BAR; PG8_WAIT_L(0); PG8_MMA(0, 0, At, B0); PG8_BAR; PG8_SCHED;
            PG8_LDB(B1, 0, 1); PG8_STAGE(PG8_SB(0, 0), b2, voffB);
            PG8_BAR; PG8_WAIT_L(0); PG8_MMA(0, 1, At, B1); PG8_BAR;
            PG8_LDA(At, 0, 1); PG8_STAGE(PG8_SA(0, 0), a2, voffA);
            PG8_BAR; PG8_WAIT_L(0); PG8_MMA(1, 0, At, B0); PG8_BAR; PG8_SCHED;
            PG8_STAGE(PG8_SB(0, 1), b2 + hstepB, voffB);
            PG8_WAIT_V(6); PG8_BAR; PG8_MMA(1, 1, At, B1); PG8_BAR;
            PG8_LDB(B0, 1, 0); PG8_SCHED; PG8_LDA(At, 1, 0); PG8_STAGE(PG8_SA(0, 1), a2 + hstepA, voffA);
            PG8_WAIT_L(8); PG8_BAR; PG8_WAIT_L(0); PG8_MMA(0, 0, At, B0); PG8_BAR; PG8_SCHED;
            PG8_LDB(B1, 1, 1); PG8_STAGE(PG8_SB(1, 0), b3, voffB);
            PG8_BAR; PG8_WAIT_L(0); PG8_MMA(0, 1, At, B1); PG8_BAR;
            PG8_LDA(At, 1, 1); PG8_STAGE(PG8_SA(1, 0), a3, voffA);
            PG8_BAR; PG8_WAIT_L(0); PG8_MMA(1, 0, At, B0); PG8_BAR; PG8_SCHED;
            PG8_STAGE(PG8_SB(1, 1), b3 + hstepB, voffB);
            PG8_WAIT_V(6); PG8_BAR; PG8_MMA(1, 1, At, B1); PG8_BAR;
            }
        }
        if constexpr (ALIGN_EPI) { if (wr == 0) PG8_BAR; }
        if constexpr (!Epi::AFTER_DRAIN) { E(acc, cur, wr, wc, fr, fq); S.done(cur); }
        if (!has_next) break;
#pragma unroll
        for (int a = 0; a < 2; ++a)
#pragma unroll
            for (int b = 0; b < 2; ++b)
#pragma unroll
                for (int m = 0; m < 4; ++m)
#pragma unroll
                    for (int n = 0; n < 2; ++n) acc[a][b][m][n] = (f32x4){0.f, 0.f, 0.f, 0.f};
        cur = nxt; cA = nA; cB = nB; ++ui;
        if constexpr (ALIGN_EPI) { if (wr == 1) PG8_BAR; }
    }
    PG8_WAIT_V(0);
    if constexpr (!ALIGN_EPI) { if (wr == 0) PG8_BAR; }
    PG8_BAR;
    if constexpr (Epi::AFTER_DRAIN) { E.fused(acc, cur, wr, wc, fr, fq, lds, wid, lane); S.done(cur); }
#undef PG8_SA
#undef PG8_SB
#undef PG8_STAGE
#undef PG8_LDA
#undef PG8_LDB
#undef PG8_MMA
#undef PG8_WAIT_V
#undef PG8_WAIT_L
#undef PG8_BAR
#undef PG8_SCHED
}
}

#define LAS __attribute__((address_space(3)))
typedef unsigned short bf16_t;
typedef unsigned u32x4 __attribute__((ext_vector_type(4)));
constexpr int DM = 2048, NB = 4, SEQ = 2048, NH = 16, HD = 128, MTOK = NB * SEQ;
constexpr int NCMP = 127;
constexpr float ATT_SCALE = 0.08838834764831845f;
constexpr float QSC = ATT_SCALE * 1.4426950408889634f;
constexpr float NEGF = -1e30f;
constexpr size_t MiB = 1u << 20;
constexpr size_t WS_QKVA = 0, WS_ZA = 96 * MiB;
constexpr size_t WS_QB = 0, WS_ZB = 32 * MiB;
constexpr size_t WS_Y1 = 0;
constexpr size_t WS_B = 128 * MiB;
constexpr size_t WS_WB = 160 * MiB;
constexpr size_t WS_WOA = 205 * MiB, WS_WOB = 213 * MiB;
constexpr size_t WS_Y0 = 221 * MiB;
constexpr size_t WS_SSQ0 = 253 * MiB, WS_SSQ1 = 254 * MiB, WS_RSTD0 = 255 * MiB;
constexpr size_t WS_BAR = 255 * MiB + 131072;
constexpr size_t WS_END = 256 * MiB;
constexpr size_t DO_XHAT0 = 0;
constexpr size_t DO_KVB = 0;
constexpr size_t DO_GB = 48 * MiB;
constexpr size_t DO_KCMP = 52 * MiB, DO_VCMP = 53 * MiB;
constexpr int NWB = 11520;

struct Params { const float* in[16]; float* out; unsigned char* ws; };

__device__ __forceinline__ float4 ldnt4(const float4* p) { typedef float f4v __attribute__((ext_vector_type(4))); const f4v v = __builtin_nontemporal_load((const f4v*)p); return make_float4(v[0], v[1], v[2], v[3]); }
__device__ __forceinline__ uint2 ldnt2(const uint2* p) { typedef unsigned u2v __attribute__((ext_vector_type(2))); const u2v v = __builtin_nontemporal_load((const u2v*)p); return make_uint2(v[0], v[1]); }
__device__ __forceinline__ uint4 ldnt4u(const uint4* p) { typedef unsigned u4v __attribute__((ext_vector_type(4))); const u4v v = __builtin_nontemporal_load((const u4v*)p); return make_uint4(v[0], v[1], v[2], v[3]); }
__device__ __forceinline__ float bf2f(unsigned u16) { return __uint_as_float(u16 << 16); }
__device__ __forceinline__ float bflo(unsigned w) { return __uint_as_float(w << 16); }
__device__ __forceinline__ float bfhi(unsigned w) { return __uint_as_float(w & 0xffff0000u); }
__device__ __forceinline__ unsigned f2bf(float f) { unsigned u = __float_as_uint(f); return (u + 0x7fffu + ((u >> 16) & 1u)) >> 16; }
__device__ __forceinline__ unsigned pk2(float lo, float hi) { return f2bf(lo) | (f2bf(hi) << 16); }
__device__ __forceinline__ float wave_sum(float v) {
#pragma unroll
    for (int o = 32; o >= 1; o >>= 1) v += __shfl_xor(v, o);
    return v;
}
__device__ __forceinline__ float wave_max(float v) {
#pragma unroll
    for (int o = 32; o >= 1; o >>= 1) v = fmaxf(v, __shfl_xor(v, o));
    return v;
}
__device__ __forceinline__ int rel_bucket(int dist) {
    int n = dist > 0 ? dist : 0;
    if (n < 16) return n;
    int b = 16;
    b += (n >= 22); b += (n >= 30); b += (n >= 40); b += (n >= 54); b += (n >= 73); b += (n >= 99); b += (n >= 134); b += (n >= 182);
    b += (n >= 246); b += (n >= 332); b += (n >= 450); b += (n >= 609); b += (n >= 825); b += (n >= 1117); b += (n >= 1513);
    return b;
}
__device__ __forceinline__ float frcp(float x) { return __builtin_amdgcn_rcpf(x); }
__device__ __forceinline__ float silu(float z) { return z * frcp(1.f + __expf(-z)); }

struct TItem { const float* W; const float* g; bf16_t* WT; int ldw, c0, ncv, k0, K, r0; float sc; };
__device__ __forceinline__ void titem_load64(const TItem& t, float (&v)[64], int lane) {
    const int c = t.c0 + lane; const float* p = t.W + (size_t)t.k0 * t.ldw + c; const bool ok = c < t.ncv;
#pragma unroll
    for (int i = 0; i < 64; ++i) v[i] = ok ? __builtin_nontemporal_load(p + (size_t)i * t.ldw) : 0.f;
}
__device__ __forceinline__ void titem_store64(const TItem& t, const float (&v)[64], LAS float* scr, int lane) {
#pragma unroll
    for (int i = 0; i < 64; ++i) scr[i * 65 + lane] = v[i];
    const int c = lane & 7;
    float gk[8];
#pragma unroll
    for (int j = 0; j < 8; ++j) gk[j] = (t.g ? t.g[t.k0 + 8 * c + j] : 1.f) * t.sc;
    asm volatile("s_waitcnt lgkmcnt(0)" ::: "memory");
#pragma unroll
    for (int j = 0; j < 8; ++j) {
        const int n = (lane >> 3) + 8 * j; const LAS float* s = scr + (8 * c) * 65 + n;
        u32x4 o; o.x = pk2(s[0 * 65] * gk[0], s[1 * 65] * gk[1]); o.y = pk2(s[2 * 65] * gk[2], s[3 * 65] * gk[3]); o.z = pk2(s[4 * 65] * gk[4], s[5 * 65] * gk[5]); o.w = pk2(s[6 * 65] * gk[6], s[7 * 65] * gk[7]);
        *(u32x4*)(t.WT + (size_t)(t.r0 + n) * t.K + t.k0 + 8 * c) = o;
    }
    asm volatile("s_waitcnt lgkmcnt(0)" ::: "memory");
}
__device__ __forceinline__ void titem_load(const TItem& t, float (&v)[32], int lane) {
    const int c = t.c0 + (lane & 31); const float* p = t.W + (size_t)(t.k0 + (lane >> 5)) * t.ldw + c; const bool ok = c < t.ncv;
#pragma unroll
    for (int i = 0; i < 32; ++i) v[i] = ok ? p[(size_t)(2 * i) * t.ldw] : 0.f;
}
__device__ __forceinline__ void titem_store(const TItem& t, const float (&v)[32], LAS float* scr, int lane) {
#pragma unroll
    for (int i = 0; i < 32; ++i) scr[(2 * i + (lane >> 5)) * 33 + (lane & 31)] = v[i];
    const int c = lane & 7;
    float gk[8];
#pragma unroll
    for (int j = 0; j < 8; ++j) gk[j] = (t.g ? t.g[t.k0 + 8 * c + j] : 1.f) * t.sc;
    asm volatile("s_waitcnt lgkmcnt(0)" ::: "memory");
#pragma unroll
    for (int j = 0; j < 4; ++j) {
        const int n = (lane >> 3) + 8 * j; const LAS float* s = scr + (8 * c) * 33 + n;
        u32x4 o; o.x = pk2(s[0 * 33] * gk[0], s[1 * 33] * gk[1]); o.y = pk2(s[2 * 33] * gk[2], s[3 * 33] * gk[3]); o.z = pk2(s[4 * 33] * gk[4], s[5 * 33] * gk[5]); o.w = pk2(s[6 * 33] * gk[6], s[7 * 33] * gk[7]);
        *(u32x4*)(t.WT + (size_t)(t.r0 + n) * t.K + t.k0 + 8 * c) = o;
    }
    asm volatile("s_waitcnt lgkmcnt(0)" ::: "memory");
}
__device__ __forceinline__ void transpose_item(const float* W, int ldw, int c0, int ncv, int k0, const float* g, bf16_t* WT, int K, int r0, LAS float* scr, int lane) {
    TItem t{W, g, WT, ldw, c0, ncv, k0, K, r0, 1.f}; float v[32]; titem_load(t, v, lane); titem_store(t, v, scr, lane);
}
__device__ __forceinline__ void rms_row_bf16(const float* xrow, bf16_t* orow, int lane) {
    const float4* xr = (const float4*)xrow + lane;
    float4 v[8]; float ss = 0.f;
#pragma unroll
    for (int j = 0; j < 8; ++j) { v[j] = ldnt4(xr + 64 * j); ss += (v[j].x * v[j].x + v[j].y * v[j].y) + (v[j].z * v[j].z + v[j].w * v[j].w); }
    const float r = rsqrtf(wave_sum(ss) * (1.f / DM) + 1e-6f);
    uint2* o8 = (uint2*)orow + lane;
#pragma unroll
    for (int j = 0; j < 8; ++j) o8[64 * j] = make_uint2(pk2(v[j].x * r, v[j].y * r), pk2(v[j].z * r, v[j].w * r));
}

__device__ __forceinline__ float dot_row(const LAS float* qs, const bf16_t* krow) {
    const uint4* kp = (const uint4*)krow; float acc = 0.f;
#pragma unroll 4
    for (int i = 0; i < 16; ++i) {
        const uint4 w = kp[i]; const LAS float* q = qs + 8 * i;
        acc += q[0] * bflo(w.x) + q[1] * bfhi(w.x) + q[2] * bflo(w.y) + q[3] * bfhi(w.y) + q[4] * bflo(w.z) + q[5] * bfhi(w.z) + q[6] * bflo(w.w) + q[7] * bfhi(w.w);
    }
    return acc;
}
__device__ __forceinline__ void wave_chunk(const LAS float* qs, const bf16_t* Kb, const bf16_t* Vb, bool valid, int row, float bias,
                                           float& m, float& l, float& o0, float& o1, int lane) {
    float s = NEGF;
    if (valid) s = dot_row(qs, Kb + (size_t)row * HD) * ATT_SCALE + bias;
    const float cm = wave_max(s);
    const float mn = fmaxf(m, cm);
    const float p = valid ? __expf(s - mn) : 0.f;
    const float alpha = __expf(m - mn);
    l = l * alpha + wave_sum(p);
    o0 *= alpha; o1 *= alpha; m = mn;
    const float pb = bf2f(f2bf(p));
    const unsigned long long act = __ballot(pb != 0.f);
    for (int j = 0; j < 64; ++j) {
        if (!((act >> j) & 1ull)) continue;
        const float pj = __shfl(pb, j); const int rj = __shfl(row, j);
        const unsigned w = ((const unsigned*)(Vb + (size_t)rj * HD))[lane];
        o0 += pj * bflo(w); o1 += pj * bfhi(w);
    }
}
__device__ __forceinline__ void load_q(LAS float* qs, const bf16_t* qrow, int lane) {
    const unsigned w = ((const unsigned*)qrow)[lane];
    qs[2 * lane] = bflo(w); qs[2 * lane + 1] = bfhi(w);
    asm volatile("s_waitcnt lgkmcnt(0)" ::: "memory");
}

__device__ __forceinline__ unsigned long long rt() { return __builtin_amdgcn_s_memrealtime(); }
#define XB_TMO      128
#define XB_XCNT(j)  (256  + 64 * (j))
#define XB_XSUB(j)  (1280 + 64 * (j))
#define XB_XGEN(j)  (2304 + 64 * (j))
#define XB_TOP      3328
#define XB_TOPGEN   3392
#define XCD_BAR_WORDS 3456
#define XB_SPIN_CAP (1u << 18)

__device__ __forceinline__ unsigned xb_ld(unsigned* p)              { return __hip_atomic_load(p, __ATOMIC_RELAXED, __HIP_MEMORY_SCOPE_AGENT); }
__device__ __forceinline__ unsigned xb_add(unsigned* p, unsigned v) { return __hip_atomic_fetch_add(p, v, __ATOMIC_RELAXED, __HIP_MEMORY_SCOPE_AGENT); }
__device__ __forceinline__ unsigned xb_xcc_id() { return (unsigned)__builtin_amdgcn_s_getreg((3 << 11) | 20) & 0xFu; }
#define XB_SPIN(cond, bar) do { unsigned _sp = 0; while (cond) { __builtin_amdgcn_s_sleep(1); \
    if ((++_sp & 255u) == 0u) { if (xb_ld(&(bar)[XB_TMO])) break; if (_sp > XB_SPIN_CAP) { atomicAdd(&(bar)[XB_TMO], 1u); break; } } } } while (0)

struct XcdBarrier {
    unsigned* bar; unsigned x;
    volatile LAS unsigned* st;
};

__device__ __forceinline__ XcdBarrier xcd_barrier_post(unsigned* bar, volatile LAS unsigned* st) {
    XcdBarrier b; b.bar = bar; b.x = xb_xcc_id(); b.st = st;
    if (threadIdx.x == 0) (void)xb_add(&bar[XB_XCNT(b.x)], 1u);
    return b;
}
__device__ __forceinline__ void xcd_barrier_complete(unsigned* bar, unsigned x, unsigned& nloc, unsigned& nx) {
    const unsigned G = gridDim.x * gridDim.y * gridDim.z;
    unsigned sum, cnt, mine, sp = 0u;
    for (;;) {
        sum = 0u; cnt = 0u; mine = 0u;
#pragma unroll
        for (unsigned j = 0; j < 16; ++j) { const unsigned c = xb_ld(&bar[XB_XCNT(j)]); sum += c; cnt += (c > 0u) ? 1u : 0u; mine = (j == x) ? c : mine; }
        if (sum == G) break;
        __builtin_amdgcn_s_sleep(1);
        if ((++sp & 255u) == 0u) { if (xb_ld(&bar[XB_TMO])) break; if (sp > XB_SPIN_CAP) { atomicAdd(&bar[XB_TMO], 1u); break; } }
    }
    nloc = mine > 0u ? mine : 1u; nx = cnt > 0u ? cnt : 1u;
}

__device__ __forceinline__ void xcd_barrier(const XcdBarrier& b) {
    asm volatile("s_waitcnt vmcnt(0)" ::: "memory");
    __syncthreads();
    if (threadIdx.x == 0) {
        unsigned* bar = b.bar;
        __builtin_amdgcn_s_waitcnt(0);
        unsigned nloc = b.st[0], nx = b.st[1];
        if (nloc == 0u) { xcd_barrier_complete(bar, b.x, nloc, nx); b.st[0] = nloc; b.st[1] = nx; }
        const unsigned old = xb_add(&bar[XB_XSUB(b.x)], 1u);
        const unsigned gen = old / nloc;
        if (old + 1u == (gen + 1u) * nloc) {
            __builtin_amdgcn_fence(__ATOMIC_RELEASE, "agent");
            asm volatile("s_waitcnt vmcnt(0)" ::: "memory");
            const unsigned og = xb_add(&bar[XB_TOP], 1u);
            const unsigned tg = og / nx;
            if (og + 1u == (tg + 1u) * nx) xb_add(&bar[XB_TOPGEN], 1u);
            else XB_SPIN(xb_ld(&bar[XB_TOPGEN]) == tg, bar);
            __builtin_amdgcn_fence(__ATOMIC_ACQUIRE, "agent");
            xb_add(&bar[XB_XGEN(b.x)], 1u);
            asm volatile("s_waitcnt vmcnt(0)" ::: "memory");
        } else {
            XB_SPIN(xb_ld(&bar[XB_XGEN(b.x)]) == gen, bar);
            __builtin_amdgcn_fence(__ATOMIC_ACQUIRE, "agent");
            asm volatile("s_waitcnt vmcnt(0)" ::: "memory");
        }
    }
    __syncthreads();
}


namespace att {
typedef short bf16x8 __attribute__((ext_vector_type(8)));
typedef short s16x4 __attribute__((ext_vector_type(4)));
typedef float f32x16 __attribute__((ext_vector_type(16)));
typedef float f32x4 __attribute__((ext_vector_type(4)));
constexpr int SHM_V = 16384, SHM_K = 16384;
constexpr int L_V = 0, L_K = 65536, L_WS = 114688, L_TBL = 116736;
constexpr float SCALE = 0.08838834764831845f, THR = 8.f;
constexpr float C2 = 1.4426950408889634f * SCALE;
constexpr float LOG2E = 1.4426950408889634f, LN2 = 0.6931471805599453f, THR2 = THR * LOG2E;
constexpr int L_FLAG = 163840 - 56;
#define ATT_KSWZ(row, colB) ((row) * 256 + ((colB) ^ (((row) & 7) << 4)))
#define ATT_SBAR() __builtin_amdgcn_sched_barrier(0)
__device__ __forceinline__ int v_st(int k, int c) { const int kk = (k & ~0xC) | ((k & 4) << 1) | ((k & 8) >> 1); return ((kk >> 3) * 4 + (c >> 5)) * 512 + ((kk & 7) * 32 + (c & 31)) * 2; }
__device__ __forceinline__ int v_rd_base(int lane) { return ((lane & 3) << 3) | (((lane >> 2) & 3) << 6) | (((lane >> 4) & 1) << 5) | (((lane >> 5) & 1) << 8); }
constexpr int v_rd_off(int d0, int ks, int half) { return d0 * 512 + ks * 4096 + half * 2048; }
__device__ __forceinline__ int crow(int r, int hi) { return (r & 3) + 8 * (r >> 2) + 4 * hi; }
__device__ __forceinline__ unsigned cvtpk(float lo, float hi) { unsigned r; asm volatile("v_cvt_pk_bf16_f32 %0, %1, %2" : "=v"(r) : "v"(lo), "v"(hi)); return r; }

__device__ __forceinline__ void partialSM(f32x16& p0, f32x16& p1, float& m_reg, float& alpha) {
    float pmax = p0[0];
#pragma unroll
    for (int r = 1; r < 16; ++r) pmax = fmaxf(pmax, p0[r]);
#pragma unroll
    for (int r = 0; r < 16; ++r) pmax = fmaxf(pmax, p1[r]);
    { auto rr = __builtin_amdgcn_permlane32_swap(__float_as_uint(pmax), __float_as_uint(pmax), false, false);
      pmax = fmaxf(__uint_as_float(rr[0]), __uint_as_float(rr[1])); }
    float mn;
    if (__builtin_expect(__all((pmax - m_reg) * SCALE <= THR), 1)) { mn = m_reg; alpha = 1.f; }
    else { mn = fmaxf(m_reg, pmax); alpha = __builtin_amdgcn_exp2f((m_reg - mn) * C2); m_reg = mn; }
    const float mnL = -mn * C2;
#pragma unroll
    for (int r = 0; r < 16; ++r) p0[r] = fmaf(p0[r], C2, mnL);
#pragma unroll
    for (int r = 0; r < 16; ++r) p1[r] = fmaf(p1[r], C2, mnL);
#pragma unroll
    for (int r = 0; r < 16; ++r) p0[r] = __builtin_amdgcn_exp2f(p0[r]);
}
#define ATT_PK4(P, B_, OUT) do { unsigned a0 = att::cvtpk(P[B_+0], P[B_+1]), a1 = att::cvtpk(P[B_+2], P[B_+3]);                          \
        unsigned b0 = att::cvtpk(P[B_+4], P[B_+5]), b1 = att::cvtpk(P[B_+6], P[B_+7]);                                             \
        auto r0 = __builtin_amdgcn_permlane32_swap(a0, b0, false, false); auto r1 = __builtin_amdgcn_permlane32_swap(a1, b1, false, false); \
        u32x4 w = {r0[0], r1[0], r0[1], r1[1]}; OUT = __builtin_bit_cast(att::bf16x8, w); } while (0)
__device__ __forceinline__ void finishSM(f32x16& p0, f32x16& p1, float alpha, float& l_reg, bf16x8& pa0, bf16x8& pa1, bf16x8& pa2, bf16x8& pa3) {
#pragma unroll
    for (int r = 0; r < 16; ++r) p1[r] = __builtin_amdgcn_exp2f(p1[r]);
    float ps = 0;
#pragma unroll
    for (int r = 0; r < 16; ++r) ps += p0[r];
#pragma unroll
    for (int r = 0; r < 16; ++r) ps += p1[r];
    { auto rr = __builtin_amdgcn_permlane32_swap(__float_as_uint(ps), __float_as_uint(ps), false, false);
      ps = __uint_as_float(rr[0]) + __uint_as_float(rr[1]); }
    l_reg = l_reg * alpha + ps;
    ATT_PK4(p0, 0, pa0); ATT_PK4(p0, 8, pa1); ATT_PK4(p1, 0, pa2); ATT_PK4(p1, 8, pa3);
}
__device__ __forceinline__ void qkt(f32x16& p0, f32x16& p1, const LAS unsigned char* Kt, int r32, int hi, const bf16x8 (&qr)[8], const LAS float* tb) {
#pragma unroll
    for (int r = 0; r < 16; ++r) { p0[r] = tb[59 - ((r & 3) + 8 * (r >> 2))]; p1[r] = tb[27 - ((r & 3) + 8 * (r >> 2))]; }
    const LAS unsigned char* kb[4];
#pragma unroll
    for (int dd = 0; dd < 4; ++dd) kb[dd] = Kt + ATT_KSWZ(r32, (dd * 16 + hi * 8) * 2);
#pragma unroll
    for (int d0 = 0; d0 < 8; ++d0) { const LAS unsigned char* a = kb[d0 & 3] + (d0 >> 2) * 128;
        const bf16x8 b0 = *(const LAS bf16x8*)a;
        const bf16x8 b1 = *(const LAS bf16x8*)(a + 32 * 256);
        p0 = __builtin_amdgcn_mfma_f32_32x32x16_bf16(b0, qr[d0], p0, 0, 0, 0);
        p1 = __builtin_amdgcn_mfma_f32_32x32x16_bf16(b1, qr[d0], p1, 0, 0, 0); }
}
__device__ __forceinline__ void pv_tile(f32x16 (&o)[4], int vb, bf16x8 pa0, bf16x8 pa1, bf16x8 pa2, bf16x8 pa3) {
#define ATT_TRRD(dst, off) asm volatile("ds_read_b64_tr_b16 %0, %1 offset:%2" : "=&v"(dst) : "v"(vb), "i"(off) : "memory")
#define ATT_VLD(L, H, d0) do { constexpr int b_ = v_rd_off(d0, 0, 0); \
        ATT_TRRD(L[0], b_); ATT_TRRD(H[0], b_ + 2048); ATT_TRRD(L[1], b_ + 4096); ATT_TRRD(H[1], b_ + 6144); ATT_TRRD(L[2], b_ + 8192); ATT_TRRD(H[2], b_ + 10240); ATT_TRRD(L[3], b_ + 12288); ATT_TRRD(H[3], b_ + 14336); } while (0)
#define ATT_VF(L, H, k) (bf16x8){L[k][0], L[k][1], L[k][2], L[k][3], H[k][0], H[k][1], H[k][2], H[k][3]}
#define ATT_PVM(L, H, d0) do { \
        o[d0] = __builtin_amdgcn_mfma_f32_32x32x16_bf16(pa0, ATT_VF(L, H, 0), o[d0], 0, 0, 0); o[d0] = __builtin_amdgcn_mfma_f32_32x32x16_bf16(pa1, ATT_VF(L, H, 1), o[d0], 0, 0, 0); \
        o[d0] = __builtin_amdgcn_mfma_f32_32x32x16_bf16(pa2, ATT_VF(L, H, 2), o[d0], 0, 0, 0); o[d0] = __builtin_amdgcn_mfma_f32_32x32x16_bf16(pa3, ATT_VF(L, H, 3), o[d0], 0, 0, 0); } while (0)
    s16x4 la[4], ha[4], lb[4], hb[4];
    ATT_VLD(la, ha, 0);
    ATT_VLD(lb, hb, 1);
    asm volatile("s_waitcnt lgkmcnt(8)" ::: "memory"); ATT_SBAR();
    ATT_PVM(la, ha, 0); ATT_SBAR();
    ATT_VLD(la, ha, 2);
    asm volatile("s_waitcnt lgkmcnt(8)" ::: "memory"); ATT_SBAR();
    ATT_PVM(lb, hb, 1); ATT_SBAR();
    ATT_VLD(lb, hb, 3);
    asm volatile("s_waitcnt lgkmcnt(8)" ::: "memory"); ATT_SBAR();
    ATT_PVM(la, ha, 2); ATT_SBAR();
    asm volatile("s_waitcnt lgkmcnt(0)" ::: "memory"); ATT_SBAR();
    ATT_PVM(lb, hb, 3);
#undef ATT_PVM
#undef ATT_VF
#undef ATT_VLD
#undef ATT_TRRD
}
typedef short v4i16_t __attribute__((ext_vector_type(4)));
__device__ __forceinline__ s16x4 vtr(const LAS unsigned char* p) { return __builtin_bit_cast(s16x4, __builtin_amdgcn_ds_read_tr16_b64_v4i16((LAS v4i16_t*)p)); }
__device__ __forceinline__ void gather_half(f32x16& p, const LAS float* tb, int half) {
#pragma unroll
    for (int r = 0; r < 16; ++r) p[r] = tb[32 * half + ((r & 3) + 8 * (r >> 2))];
}
__device__ __forceinline__ void qk_mma(f32x16& p, const LAS unsigned char* Kt, int half, int r32, int hi, const bf16x8 (&qr)[8]) {
    const LAS unsigned char* kb[4];
#pragma unroll
    for (int dd = 0; dd < 4; ++dd) kb[dd] = Kt + half * 8192 + ATT_KSWZ(r32, (dd * 16 + hi * 8) * 2);
#pragma unroll
    for (int d0 = 0; d0 < 8; ++d0) p = __builtin_amdgcn_mfma_f32_32x32x16_bf16(*(const LAS bf16x8*)(kb[d0 & 3] + (d0 >> 2) * 128), qr[d0], p, 0, 0, 0);
}
__device__ __forceinline__ void qk_half(f32x16& p, const LAS unsigned char* Kt, int half, int r32, int hi, const bf16x8 (&qr)[8], const LAS float* tb) {
#pragma unroll
    for (int r = 0; r < 16; ++r) p[r] = tb[32 * half + ((r & 3) + 8 * (r >> 2))];
    const LAS unsigned char* kb[4];
#pragma unroll
    for (int dd = 0; dd < 4; ++dd) kb[dd] = Kt + half * 8192 + ATT_KSWZ(r32, (dd * 16 + hi * 8) * 2);
#pragma unroll
    for (int d0 = 0; d0 < 8; ++d0) p = __builtin_amdgcn_mfma_f32_32x32x16_bf16(*(const LAS bf16x8*)(kb[d0 & 3] + (d0 >> 2) * 128), qr[d0], p, 0, 0, 0);
}
__device__ __forceinline__ void exp_half(f32x16& p) {
#pragma unroll
    for (int r = 0; r < 16; ++r) p[r] = __builtin_amdgcn_exp2f(p[r]);
}
__device__ __forceinline__ bool partial_half(f32x16& p, float& m_reg, float& mthr, float& alpha) {
    float pmax = p[0];
#pragma unroll
    for (int r = 1; r < 16; ++r) pmax = fmaxf(pmax, p[r]);
    { auto rr = __builtin_amdgcn_permlane32_swap(__float_as_uint(pmax), __float_as_uint(pmax), false, false);
      pmax = fmaxf(__uint_as_float(rr[0]), __uint_as_float(rr[1])); }
    bool moved = false;
    if (__builtin_expect(!__all(pmax <= mthr), 0)) { const float mn = fmaxf(m_reg, pmax); alpha = __builtin_amdgcn_exp2f(m_reg - mn); m_reg = mn; mthr = mn + THR2; moved = true; }
#pragma unroll
    for (int r = 0; r < 16; ++r) p[r] = __builtin_amdgcn_exp2f(p[r] - m_reg);
    return moved;
}
__device__ __forceinline__ void finish_half(const f32x16& p, float& l_reg, bf16x8& pa0, bf16x8& pa1) {
    float ps = p[0];
#pragma unroll
    for (int r = 1; r < 16; ++r) ps += p[r];
    { auto rr = __builtin_amdgcn_permlane32_swap(__float_as_uint(ps), __float_as_uint(ps), false, false);
      ps = __uint_as_float(rr[0]) + __uint_as_float(rr[1]); }
    l_reg += ps;
    ATT_PK4(p, 0, pa0); ATT_PK4(p, 8, pa1);
}
template <int HALF>
__device__ __forceinline__ void pv_half(f32x16 (&o)[4], int vb, bf16x8 pa0, bf16x8 pa1) {
#define ATT_TRRD(dst, off) asm volatile("ds_read_b64_tr_b16 %0, %1 offset:%2" : "=&v"(dst) : "v"(vb), "i"(off) : "memory")
#define ATT_VLD2(L0, H0, L1, H1, d0) do { constexpr int b_ = (d0) * 512 + HALF * 8192; ATT_TRRD(L0, b_); ATT_TRRD(H0, b_ + 2048); ATT_TRRD(L1, b_ + 4096); ATT_TRRD(H1, b_ + 6144); } while (0)
#define ATT_VF(L, H) (bf16x8){L[0], L[1], L[2], L[3], H[0], H[1], H[2], H[3]}
    s16x4 a0, a1, a2, a3, b0, b1, b2, b3, c0, c1, c2, c3, d0_, d1_, d2_, d3_;
    ATT_VLD2(a0, a1, a2, a3, 0); ATT_VLD2(b0, b1, b2, b3, 1); ATT_VLD2(c0, c1, c2, c3, 2); ATT_VLD2(d0_, d1_, d2_, d3_, 3);
    asm volatile("s_waitcnt lgkmcnt(8)" ::: "memory"); ATT_SBAR();
    o[0] = __builtin_amdgcn_mfma_f32_32x32x16_bf16(pa0, ATT_VF(a0, a1), o[0], 0, 0, 0); o[0] = __builtin_amdgcn_mfma_f32_32x32x16_bf16(pa1, ATT_VF(a2, a3), o[0], 0, 0, 0);
    o[1] = __builtin_amdgcn_mfma_f32_32x32x16_bf16(pa0, ATT_VF(b0, b1), o[1], 0, 0, 0); o[1] = __builtin_amdgcn_mfma_f32_32x32x16_bf16(pa1, ATT_VF(b2, b3), o[1], 0, 0, 0);
    ATT_SBAR(); asm volatile("s_waitcnt lgkmcnt(0)" ::: "memory"); ATT_SBAR();
    o[2] = __builtin_amdgcn_mfma_f32_32x32x16_bf16(pa0, ATT_VF(c0, c1), o[2], 0, 0, 0); o[2] = __builtin_amdgcn_mfma_f32_32x32x16_bf16(pa1, ATT_VF(c2, c3), o[2], 0, 0, 0);
    o[3] = __builtin_amdgcn_mfma_f32_32x32x16_bf16(pa0, ATT_VF(d0_, d1_), o[3], 0, 0, 0); o[3] = __builtin_amdgcn_mfma_f32_32x32x16_bf16(pa1, ATT_VF(d2_, d3_), o[3], 0, 0, 0);
#undef ATT_VF
#undef ATT_VLD2
#undef ATT_TRRD
}
__device__ __forceinline__ void dma16(const void* g, LAS unsigned char* l) { __builtin_amdgcn_global_load_lds((const unsigned*)g, (LAS unsigned*)l, 16, 0, 0); }
template <class U>
__device__ __forceinline__ void dma_tile(LAS unsigned char* lds, const U& u, int t, int kb, int vs, int lane, int wid) {
    int l_ = lane; asm volatile("" : "+v"(l_));
    const int kkey0 = 8 * wid + (l_ >> 4), kkey1 = kkey0 + 4;
    const int kc0 = ((l_ & 15) ^ (kkey0 & 7)) * 8, kc1 = ((l_ & 15) ^ (kkey1 & 7)) * 8;
    const int vkk = 8 * wid + ((l_ & 31) >> 2), vkey = (vkk & ~0xC) | ((vkk & 4) << 1) | ((vkk & 8) >> 1);
    const int vc0 = 32 * (l_ >> 5) + 8 * (l_ & 3), vc1 = vc0 + 64;
    const int ro0 = u.rowoff(t, kkey0), ro1 = u.rowoff(t, kkey1), rov = u.rowoff(t, vkey);
    LAS unsigned char* kdst = lds + L_K + wid * 2048 + kb * SHM_K; LAS unsigned char* vdst = lds + L_V + wid * 2048 + vs * SHM_V;
    dma16(u.K + ro0 + kc0, kdst); dma16(u.K + ro1 + kc1, kdst + 1024);
    dma16(u.V + rov + vc0, vdst); dma16(u.V + rov + vc1, vdst + 1024);
}
template <class U>
__device__ __forceinline__ void dma_tile_u(LAS unsigned char* lds, const U& u, int t, int kb, int vs, unsigned kof0, unsigned kof1, unsigned vof, int wid) {
    const int tb = __builtin_amdgcn_readfirstlane(u.rowoff(t, 0));
    const char* kbase = (const char*)(u.K + tb); const char* vbase = (const char*)(u.V + tb);
    LAS unsigned char* kdst = lds + L_K + wid * 2048 + kb * SHM_K; LAS unsigned char* vdst = lds + L_V + wid * 2048 + vs * SHM_V;
    dma16(kbase + kof0, kdst); dma16(kbase + kof1, kdst + 1024);
    dma16(vbase + vof, vdst); dma16(vbase + vof + 128, vdst + 1024);
}
template <bool FAST, class U>
__device__ __forceinline__ void flash_impl(LAS unsigned char* lds, const U& u, const bf16x8 (&qr)[8], f32x16 (&o)[4], float& m_reg, float& l_reg, int tid, int lane, int wid, bool tile0_issued) {
    const int r32 = lane & 31, hi = lane >> 5;
    u.reset();
    const int vp0 = L_V + v_rd_base(lane);
    LAS float* al_l = (LAS float*)(lds + L_WS) + wid * 64 + 32;
    const int NT = u.nt();
    unsigned kof0, kof1, vof;
    { const int rs = u.rs(), kkey0 = 8 * wid + (lane >> 4), kc0 = ((lane & 15) ^ (kkey0 & 7)) * 8;
      const int vkk = 8 * wid + ((lane & 31) >> 2), vkey = (vkk & ~0xC) | ((vkk & 4) << 1) | ((vkk & 8) >> 1), vc0 = 32 * (lane >> 5) + 8 * (lane & 3);
      kof0 = (unsigned)(kkey0 * rs + kc0) * 2u; kof1 = (unsigned)((kkey0 + 4) * rs + (kc0 ^ 32)) * 2u; vof = (unsigned)(vkey * rs + vc0) * 2u; }
#define ATT_DMA(t_, kb_, vs_) dma_tile_u(lds, u, t_, kb_, vs_, kof0, kof1, vof, wid)
#define ATT_RESC(a) do { l_reg *= (a); if (hi == 0) al_l[r32] = (a); asm volatile("s_waitcnt lgkmcnt(0)" ::: "memory"); \
        _Pragma("unroll") for (int d_ = 0; d_ < 4; ++d_) _Pragma("unroll") for (int r = 0; r < 16; ++r) o[d_][r] *= al_l[crow(r, hi)]; } while (0)
    f32x16 pA, pB; float alp = 1.f; bf16x8 pa0, pa1;
    float mthr = m_reg + THR2;
    bool actP = false;
    int ks_cur = 0, ks_n1 = 1, ks_n2 = 2;
    int vs_prev = 3, vs_cur = 0, vs_n1 = 1, vs_n2 = 2;
    if (!tile0_issued) ATT_DMA(0, 0, 0);
    if (NT > 1) ATT_DMA(1, 1, 1);
    for (int t = 0; t < NT; ++t) {
        if (t + 1 < NT) asm volatile("s_waitcnt vmcnt(4) lgkmcnt(0)" ::: "memory"); else asm volatile("s_waitcnt vmcnt(0) lgkmcnt(0)" ::: "memory");
        __builtin_amdgcn_s_barrier(); asm volatile("" ::: "memory");
        const bool actC = u.act(t);
        const LAS unsigned char* Kt = lds + L_K + ks_cur * SHM_K; const LAS float* tb = u.tbl(t); asm volatile("" : "+v"(tb));
        if (actC) gather_half(pA, tb, 0);
        if (t + 2 < NT) ATT_DMA(t + 2, ks_n2, vs_n2);
        ATT_SBAR();
        if (actC) qk_mma(pA, Kt, 0, r32, hi, qr);
        if (actP) finish_half(pB, l_reg, pa0, pa1);
        if (actP) pv_half<1>(o, vp0 + vs_prev * SHM_V, pa0, pa1);
        if (actC) { if constexpr (FAST) exp_half(pA); else { if (partial_half(pA, m_reg, mthr, alp)) ATT_RESC(alp); } }
        ATT_SBAR();
        if (actC) { qk_half(pB, Kt, 1, r32, hi, qr, tb);
            finish_half(pA, l_reg, pa0, pa1);
            pv_half<0>(o, vp0 + vs_cur * SHM_V, pa0, pa1);
            if constexpr (FAST) exp_half(pB); else { if (partial_half(pB, m_reg, mthr, alp)) ATT_RESC(alp); } }
        actP = actC;
        { const int tk_ = ks_cur; ks_cur = ks_n1; ks_n1 = ks_n2; ks_n2 = tk_; }
        { const int tv_ = vs_prev; vs_prev = vs_cur; vs_cur = vs_n1; vs_n1 = vs_n2; vs_n2 = tv_; }
    }
    if (actP) { finish_half(pB, l_reg, pa0, pa1); pv_half<1>(o, vp0 + vs_prev * SHM_V, pa0, pa1); }
    if constexpr (FAST) {
#ifdef ATT_FORCE_FALLBACK
        const bool bad = true;
#else
        const bool bad = !(l_reg > 0.f && l_reg < 1.2676506e30f);
#endif
        if (__any(bad) && lane == 0) *(volatile LAS unsigned*)(lds + L_FLAG) = 1u;
    }
    asm volatile("s_waitcnt vmcnt(0) lgkmcnt(0)" ::: "memory");
    __syncthreads();
#undef ATT_RESC
#undef ATT_DMA
}
template <class U>
__device__ __forceinline__ void flash_tiles(LAS unsigned char* lds, const U& u, const bf16x8 (&qr)[8], f32x16 (&o)[4], float& m_reg, float& l_reg, int tid, int lane, int wid, bool tile0_issued = false) {
    if (tid == 0) *(volatile LAS unsigned*)(lds + L_FLAG) = 0u;
    m_reg = 0.f;
    flash_impl<true>(lds, u, qr, o, m_reg, l_reg, tid, lane, wid, tile0_issued);
    if (__builtin_expect(*(volatile LAS unsigned*)(lds + L_FLAG) != 0u, 0)) {
#pragma unroll
        for (int d_ = 0; d_ < 4; ++d_)
#pragma unroll
            for (int r = 0; r < 16; ++r) o[d_][r] = 0.f;
        m_reg = -1e30f; l_reg = 0.f;
        flash_impl<false>(lds, u, qr, o, m_reg, l_reg, tid, lane, wid, false);
    }
}
template <class F>
__device__ __forceinline__ void emit(LAS unsigned char* lds, const f32x16 (&o)[4], float l_reg, int lane_in, int wid, const F& f, int stg_off = 0) {
    int lane = lane_in; asm volatile("" : "+v"(lane));
    const int r32 = lane & 31, hi = lane >> 5;
    LAS float* li_l = (LAS float*)(lds + L_WS) + wid * 64;
    if (hi == 0) li_l[r32] = (l_reg > 0.f ? frcp(l_reg) : 0.f) * f.rowscale(r32);
    asm volatile("s_waitcnt lgkmcnt(0)" ::: "memory");
    float rli[16];
#pragma unroll
    for (int r = 0; r < 16; ++r) rli[r] = li_l[crow(r, hi)];
    LAS float* stg = (LAS float*)(lds + stg_off + wid * 8192);
#pragma unroll
    for (int hf = 0; hf < 2; ++hf) {
#pragma unroll
        for (int r = 0; r < 16; ++r) { const int row = crow(r, hi);
            stg[row * 64 + r32] = o[2 * hf][r] * rli[r]; stg[row * 64 + 32 + r32] = o[2 * hf + 1][r] * rli[r]; }
        asm volatile("s_waitcnt lgkmcnt(0)" ::: "memory");
        {
            typename F::Ld ld[4];
#pragma unroll
            for (int i = 0; i < 4; ++i) { const int idx = i * 64 + lane; ld[i] = f.load(idx >> 3, hf * 64 + (idx & 7) * 8); }
#pragma unroll
            for (int i = 0; i < 4; ++i) { const int idx = i * 64 + lane, row = idx >> 3, c8 = (idx & 7) * 8;
                const f32x4 v0 = *(const LAS f32x4*)(stg + row * 64 + c8), v1 = *(const LAS f32x4*)(stg + row * 64 + c8 + 4); f.store(row, hf * 64 + c8, v0, v1, ld[i]); }
        }
        asm volatile("s_waitcnt lgkmcnt(0)" ::: "memory");
    }
    __syncthreads();
}
}

struct DilU {
    const bf16_t* K; const bf16_t* V;
    int d, m16, lbase, res, jlo, ntl, lw0, wsel, lane_off;
    const LAS float* T;
    __device__ __forceinline__ int nt() const { return ntl; }
    __device__ __forceinline__ int rs() const { return d * HD; }
    __device__ __forceinline__ void reset() const {}
    __device__ __forceinline__ void tile(int t, int& lk0, int& rt, int& jj) const { const int j = jlo + t; jj = j; if (!m16) { lk0 = lbase + 64 * j; rt = res; } else { lk0 = 64 * (j & 1); rt = res + (j >> 1); } }
    __device__ __forceinline__ int rowoff(int t, int key) const { int lk0, rt, jj; tile(t, lk0, rt, jj); return ((lk0 + key) * d + rt) * HD; }
    __device__ __forceinline__ bool act(int t) const { int lk0, rt, jj; tile(t, lk0, rt, jj);
        return m16 ? ((jj >> 1) == wsel && lk0 <= lw0 + 31) : (lk0 <= lw0 + 31 && lk0 + 63 >= lw0 - 128); }
    __device__ __forceinline__ const LAS float* tbl(int t) const { int lk0, rt, jj; tile(t, lk0, rt, jj); return T + (260 - (lw0 - lk0 + lane_off)); }
};

struct DilStoreF {
    static constexpr int BATCH = 8;
    bf16_t* base; int rstride;
    struct Ld { };
    __device__ __forceinline__ float rowscale(int) const { return 1.f; }
    __device__ __forceinline__ Ld load(int, int) const { return Ld{}; }
    __device__ __forceinline__ void store(int row, int col, att::f32x4 v, att::f32x4 w, const Ld&) const {
        *(uint4*)(base + (size_t)row * rstride + col) = make_uint4(pg8::cvt_pk_bf16(v[0], v[1]), pg8::cvt_pk_bf16(v[2], v[3]), pg8::cvt_pk_bf16(w[0], w[1]), pg8::cvt_pk_bf16(w[2], w[3])); }
};

struct DilMergeF {
    const bf16_t* o2; const bf16_t* o3; const bf16_t* z; bf16_t* a0;
    const float* lse2; const float* lse3;
    const LAS float* lse1;
    LAS float* w23;
    static constexpr int BATCH = 4;
    struct Ld { uint4 o2, o3, z; };
    __device__ __forceinline__ float rowscale(int row) const {
        const float l1 = lse1[row], l2 = lse2[(size_t)row * NH], l3 = lse3[(size_t)row * NH]; const float mx = fmaxf(l1, fmaxf(l2, l3));
        float w1 = __expf(l1 - mx), w2 = __expf(l2 - mx), w3 = __expf(l3 - mx); const float inv = frcp(w1 + w2 + w3);
        w23[row] = w2 * inv; w23[32 + row] = w3 * inv; return w1 * inv; }
    __device__ __forceinline__ Ld load(int row, int col) const { Ld l; const size_t e = (size_t)row * DM + col;
        l.o2 = ldnt4u((const uint4*)(o2 + e)); l.o3 = ldnt4u((const uint4*)(o3 + e)); l.z = ldnt4u((const uint4*)(z + e)); return l; }
    __device__ __forceinline__ unsigned mix2(float va, float vb, float w2, float w3, unsigned p2, unsigned p3, unsigned pz) const {
        return pg8::cvt_pk_bf16((va + w2 * bflo(p2) + w3 * bflo(p3)) * silu(bflo(pz)), (vb + w2 * bfhi(p2) + w3 * bfhi(p3)) * silu(bfhi(pz))); }
    __device__ __forceinline__ void store(int row, int col, att::f32x4 v, att::f32x4 u, const Ld& l) const {
        const float w2 = w23[row], w3 = w23[32 + row];
        *(uint4*)(a0 + (size_t)row * DM + col) = make_uint4(mix2(v[0], v[1], w2, w3, l.o2.x, l.o3.x, l.z.x), mix2(v[2], v[3], w2, w3, l.o2.y, l.o3.y, l.z.y),
                                                            mix2(u[0], u[1], w2, w3, l.o2.z, l.o3.z, l.z.z), mix2(u[2], u[3], w2, w3, l.o2.w, l.o3.w, l.z.w));
    }
};

struct DilCtx { DilU U; int pat, h, d, grow_l, rbase; };
template <int PASS>
__device__ __forceinline__ void dil_setup(int ui, DilCtx& c, LAS float* T, const bf16_t* qkvA, const float* table, int tid, int lane, int wave) {
    const int r32 = lane & 31, hi = lane >> 5;
    int bh, kk;
    if (PASS == 0) { bh = ui >> 4; const int w = ui & 15; kk = (w & 1) * 8 + (w >> 1); } else { bh = ui >> 3; kk = ui & 7; }
    const int pat = PASS ? 0 : 1 + (kk >> 3), idx = kk & 7, b = bh >> 4, h = bh & 15;
    const int d = pat == 0 ? 1 : (pat == 1 ? 4 : 16);
    DilU& U = c.U; U.d = d; U.m16 = (pat == 2); U.T = T; U.lane_off = r32 - 4 * hi + 37;
    int rw;
    if (pat == 2) { U.res = 2 * idx; U.lbase = 0; U.jlo = 0; U.ntl = 4; U.lw0 = 32 * (wave & 3); U.wsel = wave >> 2; rw = 2 * idx + (wave >> 2); }
    else { const int mm = (pat == 0) ? idx : (idx & 1); U.res = (pat == 0) ? 0 : (idx >> 1); U.lbase = 256 * mm - 128; U.jlo = (mm == 0) ? 2 : 0; U.ntl = 6 - U.jlo; U.lw0 = 256 * mm + 32 * wave; U.wsel = 0; rw = U.res; }
    U.K = qkvA + ((size_t)(16 + h) * MTOK + b * SEQ) * HD; U.V = qkvA + ((size_t)(32 + h) * MTOK + b * SEQ) * HD;
    if (tid < 320) { const int delta = tid - 96; T[319 - tid] = (delta >= 0 && delta <= 128) ? table[rel_bucket(delta * d) * NH + h] * att::LOG2E : -__builtin_inff(); }
    c.pat = pat; c.h = h; c.d = d; c.grow_l = b * SEQ + (U.lw0 + r32) * d + rw; c.rbase = b * SEQ + U.lw0 * d + rw;
}
template <int PASS>
__device__ __forceinline__ void dil_phase(LAS unsigned char* lds, int G, unsigned char* dob, unsigned char* ws, const bf16_t* qkvA, const bf16_t* zA, bf16_t* a0, const float* table) {
    int tid = threadIdx.x; asm volatile("" : "+v"(tid)); const int lane = tid & 63, wave = __builtin_amdgcn_readfirstlane(tid >> 6);
    bf16_t* op1 = (bf16_t*)(dob); bf16_t* op2 = (bf16_t*)(dob + 32 * MiB);
    float* lseb = (float*)(ws + WS_SSQ0);
    const int r32 = lane & 31, hi = lane >> 5;
    const int vcu = (G % 8 == 0) ? ((int)blockIdx.x % 8) * (G / 8) + (int)blockIdx.x / 8 : (int)blockIdx.x;
    constexpr int upb = PASS ? 8 : 16, NU = 64 * upb; const int per = (NU + G - 1) / G;
    const int ui0 = vcu * per, ui1 = (ui0 + per < NU) ? ui0 + per : NU;
    if (ui0 >= ui1) return;
    DilCtx cur; att::bf16x8 qn[8];
    dil_setup<PASS>(ui0, cur, (LAS float*)(lds + att::L_TBL), qkvA, table, tid, lane, wave);
    { const bf16_t* qp = qkvA + ((size_t)cur.h * MTOK + cur.grow_l) * HD + hi * 8;
#pragma unroll
      for (int d0 = 0; d0 < 8; ++d0) qn[d0] = *(const att::bf16x8*)(qp + d0 * 16); }
    att::dma_tile(lds, cur.U, 0, 0, 0, lane, wave);
    for (int ui = ui0; ui < ui1; ++ui) {
        att::bf16x8 qr[8];
#pragma unroll
        for (int d0 = 0; d0 < 8; ++d0) qr[d0] = qn[d0];
        att::f32x16 o[4];
#pragma unroll
        for (int d_ = 0; d_ < 4; ++d_)
#pragma unroll
            for (int r = 0; r < 16; ++r) o[d_][r] = 0.f;
        float m_reg = -1e30f, l_reg = 0.f;
        att::flash_tiles(lds, cur.U, qr, o, m_reg, l_reg, tid, lane, wave, true);
        const float lse = m_reg * att::LN2 + __logf(l_reg);
        if constexpr (PASS == 0) {
            if (hi == 0) lseb[((size_t)cur.pat * MTOK + cur.grow_l) * NH + cur.h] = lse;
            bf16_t* opp = (cur.pat == 1 ? op1 : op2) + cur.h * HD;
            att::emit(lds, o, l_reg, lane, wave, DilStoreF{opp + (size_t)cur.rbase * DM, cur.d * DM});
        } else {
            LAS float* l1s = (LAS float*)(lds + att::L_WS) + wave * 64 + 32;
            if (hi == 0) l1s[r32] = lse;
            const size_t e0 = (size_t)cur.rbase * DM + cur.h * HD;
            att::emit(lds, o, l_reg, lane, wave, DilMergeF{op1 + e0, op2 + e0, zA + e0, a0 + e0, lseb + ((size_t)1 * MTOK + cur.rbase) * NH + cur.h, lseb + ((size_t)2 * MTOK + cur.rbase) * NH + cur.h, l1s, (LAS float*)(lds + att::L_TBL + 4096) + wave * 64});
        }
        DilCtx nxt = cur; const bool has = ui + 1 < ui1;
        if (has) {
            dil_setup<PASS>(ui + 1, nxt, (LAS float*)(lds + att::L_TBL + (((ui + 1 - ui0) & 1) ? 2048 : 0)), qkvA, table, tid, lane, wave);
            const bf16_t* qp = qkvA + ((size_t)nxt.h * MTOK + nxt.grow_l) * HD + hi * 8;
#pragma unroll
            for (int d0 = 0; d0 < 8; ++d0) qn[d0] = *(const att::bf16x8*)(qp + d0 * 16);
            att::dma_tile(lds, nxt.U, 0, 0, 0, lane, wave);
        }
        cur = nxt;
    }
}

constexpr int L_TSEL = att::L_TBL, L_TWIN = L_TSEL + 4 * 2112 * 4, L_SELM = L_TWIN + 4 * 640 * 4, L_TL = L_SELM + 256;
constexpr int L_TAB4 = L_TL + 256;
constexpr int L_IMPH = att::L_V + 2 * att::SHM_V;
static_assert(L_TAB4 + 512 <= 163840 - 64, "LDS map");
struct SelU {
    const bf16_t* K; const bf16_t* V;
    unsigned un; mutable unsigned rd, ra, rt; int ntl; unsigned mymask; int tq_off;
    __device__ __forceinline__ void reset() const { rd = un; ra = un; rt = un; }
    const LAS float* T;
    __device__ __forceinline__ int nt() const { return ntl; }
    __device__ __forceinline__ int rs() const { return HD; }
    __device__ __forceinline__ int rowoff(int, int key) const { const int n = __builtin_ctz(rd); rd &= rd - 1u; return (64 * n + key) * HD; }
    __device__ __forceinline__ bool act(int) const { const int n = __builtin_ctz(ra); ra &= ra - 1u; return __any((mymask >> n) & 1u); }
    __device__ __forceinline__ const LAS float* tbl(int) const { const int n = __builtin_ctz(rt); rt &= rt - 1u; int idx = ((mymask >> n) & 1u) ? 2052 - tq_off + 64 * n : 2052; asm volatile("" : "+v"(idx)); return T + idx; }
};
struct WinU {
    const bf16_t* K; const bf16_t* V;
    int tk_base, ntl, tq_off;
    __device__ __forceinline__ void reset() const {}
    const LAS float* T;
    __device__ __forceinline__ int nt() const { return ntl; }
    __device__ __forceinline__ int rs() const { return HD; }
    __device__ __forceinline__ int rowoff(int t, int key) const { return (tk_base + 64 * t + key) * HD; }
    __device__ __forceinline__ bool act(int) const { return true; }
    __device__ __forceinline__ const LAS float* tbl(int t) const { return T + (580 - tq_off + tk_base + 64 * t); }
};
struct GateF {
    const bf16_t* zrow; const bf16_t* grow; bf16_t* arow;
    int first;
    static constexpr int BATCH = 8;
    struct Ld { uint4 z, a; };
    __device__ __forceinline__ float rowscale(int row) const { return frcp(1.f + __expf(-bf2f(grow[(size_t)row * 256]))); }
    __device__ __forceinline__ Ld load(int row, int col) const { Ld l; l.z = ldnt4u((const uint4*)(zrow + (size_t)row * 6144 + col));
        l.a = first ? make_uint4(0u, 0u, 0u, 0u) : *(const uint4*)(arow + (size_t)row * DM + col); return l; }
    __device__ __forceinline__ unsigned gate2(float va, float vb, unsigned pz, unsigned pa) const { return pg8::cvt_pk_bf16(va * silu(bflo(pz)) + bflo(pa), vb * silu(bfhi(pz)) + bfhi(pa)); }
    __device__ __forceinline__ void store(int row, int col, att::f32x4 v, att::f32x4 u, const Ld& l) const {
        *(uint4*)(arow + (size_t)row * DM + col) = make_uint4(gate2(v[0], v[1], l.z.x, l.a.x), gate2(v[2], v[3], l.z.y, l.a.y), gate2(u[0], u[1], l.z.z, l.a.z), gate2(u[2], u[3], l.z.w, l.a.w));
    }
};

constexpr int NWAVES = 8, NTHREADS = 512;
#ifndef REP_P2
#define REP_P2 1
#endif
#ifndef REP_P7
#define REP_P7 1
#endif
#ifndef REP_P1
#define REP_P1 1
#endif
#ifndef REP_EW
#define REP_EW 1
#endif
#ifndef REP_G2
#define REP_G2 1
#endif
#ifndef REP_FD
#define REP_FD 1
#endif
#ifndef REP_F7
#define REP_F7 1
#endif
#ifndef REP_P5
#define REP_P5 1
#endif
#ifndef REP_P0
#define REP_P0 1
#endif
constexpr int LDS_BYTES = 163840;

__global__ void __launch_bounds__(NTHREADS, 2) yoco_fwd(Params p) {
    extern __shared__ __attribute__((aligned(16))) unsigned char lds_raw[];
    LAS unsigned char* lds = (LAS unsigned char*)lds_raw;
    cg::grid_group grid = cg::this_grid();
    const int G = gridDim.x, NGW = G * NWAVES;
    { volatile LAS unsigned* st = (volatile LAS unsigned*)(lds + LDS_BYTES - 64); if (threadIdx.x == 0) { st[0] = 0u; st[1] = 0u; st[3] = 0u; } __syncthreads(); }
    XcdBarrier bar = xcd_barrier_post((unsigned*)(p.ws + WS_BAR), (volatile LAS unsigned*)(lds + LDS_BYTES - 64));
#define PHASE_VARS int tid = threadIdx.x; asm volatile("" : "+v"(tid)); const int lane = tid & 63, wave = __builtin_amdgcn_readfirstlane(tid >> 6), gw = blockIdx.x * NWAVES + wave; (void)lane; (void)gw;
    unsigned char* ws = p.ws; unsigned char* dob = (unsigned char*)p.out;
    const float* x = p.in[0]; const float* norm_pre = p.in[1]; const float* norm_post = p.in[2]; const float* table = p.in[3];
    const float* w_in_a = p.in[4]; const float* w_out_a = p.in[5]; const float* kv_norm = p.in[6]; const float* w_kv = p.in[7];
    const float* pos_k = p.in[8]; const float* pos_v = p.in[9]; const float* w1k = p.in[10]; const float* w2k = p.in[11];
    const float* w1v = p.in[12]; const float* w2v = p.in[13]; const float* w_in_b = p.in[14]; const float* w_out_b = p.in[15];
    bf16_t* WA_t = (bf16_t*)(ws + WS_B); bf16_t* WoA_t = (bf16_t*)(ws + WS_WOA); bf16_t* WB_t = (bf16_t*)(ws + WS_WB); bf16_t* WoB_t = (bf16_t*)(ws + WS_WOB);
    bf16_t* xhat0 = (bf16_t*)(dob + DO_XHAT0);
    bf16_t* qkvA = (bf16_t*)(ws + WS_QKVA); bf16_t* zA = (bf16_t*)(ws + WS_ZA); bf16_t* a0 = (bf16_t*)(ws + WS_B);
    bf16_t* y0b = (bf16_t*)(ws + WS_Y0); float* ssq0 = (float*)(ws + WS_SSQ0); float* ssq1 = (float*)(ws + WS_SSQ1); float* rstd0 = (float*)(ws + WS_RSTD0);
    bf16_t* xhat1 = (bf16_t*)(ws + WS_B); bf16_t* qB = (bf16_t*)(ws + WS_QB); bf16_t* zB = (bf16_t*)(ws + WS_ZB);
    bf16_t* kvb = (bf16_t*)(dob + DO_KVB); bf16_t* gB = (bf16_t*)(dob + DO_GB); bf16_t* kcmp = (bf16_t*)(dob + DO_KCMP); bf16_t* vcmp = (bf16_t*)(dob + DO_VCMP);
    bf16_t* a1 = (bf16_t*)(ws + WS_B); bf16_t* y1b = (bf16_t*)(ws + WS_Y1);
    float* posvec = (float*)(ws + WS_RSTD0 + 65536); bf16_t* W1t = (bf16_t*)(dob + 54 * MiB); bf16_t* cpart = (bf16_t*)(ws + WS_WOA);
    unsigned* kvcnt = (unsigned*)(ws + WS_BAR) + 3584;

    for (int rep = 0; rep < REP_P0; ++rep) {
        PHASE_VARS
        LAS float* scr = (LAS float*)(lds + wave * 16384);
        constexpr int I_A = 32 * 128, I_OA = 32 * 32, I_B = 32 * (NWB / 64), I_OB = 32 * 32;
        constexpr int NIT = I_A + I_OA + I_B;
        auto decode = [&](int it) -> TItem {
            int r = it;
            if (r < I_A) { const int kb = r / 128, nb = r % 128; return TItem{w_in_a, norm_pre, WA_t, 8192, nb * 64, 8192, kb * 64, DM, nb * 64, nb < 32 ? QSC : 1.f}; } r -= I_A;
            if (r < I_OA) { const int kb = r / 32, nb = r % 32; return TItem{w_out_a, nullptr, WoA_t, 2048, nb * 64, 2048, kb * 64, DM, nb * 64, 1.f}; } r -= I_OA;
            if (r < I_B) { const int kb = r / (NWB / 64), nb = r % (NWB / 64); const int n0 = nb * 64;
                if (n0 < 8192) return TItem{w_in_b, norm_pre + DM, WB_t, 8240, n0, 8240, kb * 64, DM, n0, n0 < 2048 ? QSC : 1.f};
                if (n0 < 11264) return TItem{w_kv, kv_norm, WB_t, 3072, n0 - 8192, 3072, kb * 64, DM, n0, 1.f};
                return TItem{w_in_b, norm_pre + DM, WB_t, 8240, 8192 + (n0 - 11264), 8240, kb * 64, DM, n0, 1.f}; }
            r -= I_B;
            { const int kb = r / 32, nb = r % 32; return TItem{w_out_b, nullptr, WoB_t, 2048, nb * 64, 2048, kb * 64, DM, nb * 64, 1.f}; }
        };
        LAS float* scr64 = (LAS float*)(lds + wave * 20480);
        for (int it = gw; it < NIT; it += 2 * NGW) {
            const TItem ta = decode(it); const bool hasb = it + NGW < NIT; const TItem tb = decode(hasb ? it + NGW : it);
            float va[64], vb[64];
            titem_load64(ta, va, lane); if (hasb) titem_load64(tb, vb, lane);
            titem_store64(ta, va, scr64, lane); if (hasb) titem_store64(tb, vb, scr64, lane);
        }
        for (int m = gw; m < MTOK; m += NGW) rms_row_bf16(x + (size_t)m * DM, xhat0 + (size_t)m * DM, lane);
        for (int it = gw; it < 2048; it += NGW) {
            const int q = it >> 9, sec = (it >> 8) & 1, n = it & 255; const float* pos = (sec ? pos_v : pos_k) + q * 1024 + lane; const float* w1 = (sec ? w1v : w1k) + (size_t)(q * 1024 + lane) * 256 + n;
            float pv[16], wv[16];
#pragma unroll
            for (int j = 0; j < 16; ++j) { pv[j] = pos[64 * j]; wv[j] = w1[(size_t)64 * j * 256]; }
            float a = 0.f;
#pragma unroll
            for (int j = 0; j < 16; ++j) a += pv[j] * wv[j];
            a = wave_sum(a); if (lane == 0) posvec[it] = a;
        }
    }
    if (__builtin_expect(G > 65535, 0)) grid.sync();
    xcd_barrier(bar);
    for (int rep = 0; rep < REP_P1; ++rep) {
        pg8::Gemm g{xhat0, WA_t, MTOK, 8192, DM, DM, DM}; pg8::StaticOrder S; S.init(MTOK, 8192, G, (int)blockIdx.x);
        pg8::EpiK<1> E{qkvA, zA};
        pg8::gemm_phase<pg8::EpiK<1>, pg8::StaticOrder, true, true>(lds, g, S, E);
    }
    xcd_barrier(bar);
    dil_phase<0>(lds, G, dob, ws, qkvA, zA, a0, table);
    xcd_barrier(bar);
    dil_phase<1>(lds, G, dob, ws, qkvA, zA, a0, table);
    xcd_barrier(bar);
    for (int rep = 0; rep < REP_G2; ++rep) {
        pg8::Gemm g{a0, WoA_t, MTOK, DM, DM, DM, DM}; pg8::StaticOrder S; S.init(MTOK, DM, G, (int)blockIdx.x);
        pg8::EpiK<2> E{y0b, (bf16_t*)ssq0};
        pg8::gemm_phase<pg8::EpiK<2>, pg8::StaticOrder, true, true>(lds, g, S, E);
    }
    xcd_barrier(bar);
    for (int rep = 0; rep < REP_EW; ++rep) { PHASE_VARS
    {   LAS float* scr = (LAS float*)(lds + wave * 16384);
        for (int it = gw; it < 1024; it += NGW) { const int sec = it >> 9, r = it & 511, kb = r >> 3, nb = r & 7;
            transpose_item(sec ? w1v : w1k, 256, nb * 32, 256, kb * 64, nullptr, W1t + (size_t)sec * 256 * 4096, 4096, nb * 32, scr, lane); } }
    for (int m = gw; m < MTOK; m += NGW) {
        float sp = (lane < 32) ? ssq0[(size_t)m * 32 + lane] : 0.f;
        const float r0 = rsqrtf(wave_sum(sp) * (1.f / DM) + 1e-6f);
        if (lane == 0) rstd0[m] = r0;
        const float4* xr = (const float4*)(x + (size_t)m * DM) + lane; const uint2* yr = (const uint2*)(y0b + (size_t)m * DM) + lane; const float4* gr = (const float4*)norm_post + lane;
        float4 hv[8]; float ss = 0.f;
#pragma unroll
        for (int j = 0; j < 8; ++j) {
            const float4 xv = ldnt4(xr + 64 * j); const uint2 yv = yr[64 * j]; const float4 gv = gr[64 * j];
            hv[j].x = xv.x + bflo(yv.x) * r0 * gv.x; hv[j].y = xv.y + bfhi(yv.x) * r0 * gv.y; hv[j].z = xv.z + bflo(yv.y) * r0 * gv.z; hv[j].w = xv.w + bfhi(yv.y) * r0 * gv.w;
            ss += (hv[j].x * hv[j].x + hv[j].y * hv[j].y) + (hv[j].z * hv[j].z + hv[j].w * hv[j].w);
        }
        const float rh = rsqrtf(wave_sum(ss) * (1.f / DM) + 1e-6f);
        uint2* o8 = (uint2*)(xhat1 + (size_t)m * DM) + lane;
#pragma unroll
        for (int j = 0; j < 8; ++j) o8[64 * j] = make_uint2(pk2(hv[j].x * rh, hv[j].y * rh), pk2(hv[j].z * rh, hv[j].w * rh));
    } }
    xcd_barrier(bar);
    for (int rep = 0; rep < REP_P5; ++rep) {
        pg8::Gemm g{xhat1, WB_t, MTOK, NWB, DM, DM, DM}; pg8::P5Order S; S.init(MTOK, NWB, G, (int)blockIdx.x); S.cnt = kvcnt; S.ui = 0; S.lastkv = 0; S.elect = (LAS unsigned*)(lds + LDS_BYTES - 64 + 12);
        { pg8::Unit u5; for (int i = 0; S.next(i, u5); ++i) if (u5.pn >= 32 && u5.pn < 44) S.lastkv = i; }
        pg8::EpiK<3> E{qB, kvb};
        pg8::gemm_phase<pg8::EpiK<3>, pg8::P5Order, true, true>(lds, g, S, E);
    }
    for (int rep = 0; rep < REP_EW; ++rep) {
        const int ntl5 = (MTOK / 256) * (NWB / 256);
        pg8::Gemm g{kvb, W1t, 4096, 256, 1024, 2048, 4096}; pg8::CmpOrder S{(int)blockIdx.x, G, ntl5 % G, kvcnt, (unsigned)G, (unsigned*)(ws + WS_BAR) + XB_TMO};
        pg8::EpiPart E{cpart};
        pg8::gemm_phase<pg8::EpiPart, pg8::CmpOrder, false, true>(lds, g, S, E);
        { PHASE_VARS
          const int first5 = ntl5 % G, ci = ((int)blockIdx.x - first5 + G) % G, nidle = first5 ? G - first5 : G, ntr = nidle > 64 ? nidle - 64 : nidle, ct = nidle > 64 ? ci - 64 : ci;
          if (ci < nidle && ct >= 0 && ct < ntr) {
              LAS float* scr64 = (LAS float*)(lds + wave * 20480);
              for (int it = ct * NWAVES + wave; it < 1024; it += 2 * ntr * NWAVES) {
                  const int itb = it + ntr * NWAVES; const bool hasb = itb < 1024;
                  const TItem ta{w_out_b, nullptr, WoB_t, 2048, (it & 31) * 64, 2048, (it >> 5) * 64, DM, (it & 31) * 64, 1.f};
                  const int ib = hasb ? itb : it; const TItem tb{w_out_b, nullptr, WoB_t, 2048, (ib & 31) * 64, 2048, (ib >> 5) * 64, DM, (ib & 31) * 64, 1.f};
                  float va[64], vb[64];
                  titem_load64(ta, va, lane); if (hasb) titem_load64(tb, vb, lane);
                  titem_store64(ta, va, scr64, lane); if (hasb) titem_store64(tb, vb, scr64, lane);
              }
          } }
    }
    xcd_barrier(bar);
    for (int rep = 0; rep < REP_EW; ++rep) {
        PHASE_VARS
        const int sec = ((int)blockIdx.x * 2 >= G) ? 1 : 0, bl = (int)blockIdx.x - sec * (G / 2), nbl = G / 2;
        LAS float* W2s = (LAS float*)lds;
        auto load_a = [&](int rr) -> float4 {
            const int cbl = rr >> 9, row = (sec * 4 + cbl) * 512 + (rr & 511);
            float4 a = *(const float4*)(posvec + sec * 256 + 4 * lane);
#pragma unroll
            for (int q = 1; q < 4; ++q) { const float4 pq = *(const float4*)(posvec + q * 512 + sec * 256 + 4 * lane); a.x += pq.x; a.y += pq.y; a.z += pq.z; a.w += pq.w; }
#pragma unroll
            for (int ks = 0; ks < 4; ++ks) { const uint2 pv = *(const uint2*)(cpart + ((size_t)ks * 4096 + row) * 256 + 4 * lane); a.x += bflo(pv.x); a.y += bfhi(pv.x); a.z += bflo(pv.y); a.w += bfhi(pv.y); }
            return a; };
        const int rr0 = bl * NWAVES + wave, rrs = nbl * NWAVES;
        float4 apre0 = make_float4(0.f, 0.f, 0.f, 0.f), apre1 = apre0;
        if (rr0 < 2048) apre0 = load_a(rr0);
        if (rr0 + rrs < 2048) apre1 = load_a(rr0 + rrs);
        { const float* w2 = sec ? w2v : w2k; att::f32x4 tw[16];
#pragma unroll
          for (int i = 0; i < 16; ++i) tw[i] = *(const att::f32x4*)(w2 + 4 * (tid + i * NTHREADS));
#pragma unroll
          for (int i = 0; i < 16; ++i) *(LAS att::f32x4*)(W2s + 4 * (tid + i * NTHREADS)) = tw[i]; }
        __syncthreads();
        LAS float* hid = (LAS float*)(lds + 131072 + wave * 1024);
        for (int rr = bl * NWAVES + wave; rr < 2048; rr += nbl * NWAVES) {
            const int cbl = rr >> 9, b = (rr >> 7) & 3, c = rr & 127;
            bf16_t* dst = (sec ? vcmp : kcmp) + ((size_t)(b * 4 + cbl) * 128 + c) * HD;
            if (c == 127) { ((unsigned*)dst)[lane] = 0u; continue; }
            const float4 a = (rr == rr0) ? apre0 : ((rr == rr0 + rrs) ? apre1 : load_a(rr));
            float hv[4] = {a.x, a.y, a.z, a.w};
#pragma unroll
            for (int j = 0; j < 4; ++j) { const float v = hv[j]; const float u = 0.7978845608028654f * (v + 0.044715f * v * v * v); hv[j] = 0.5f * v * (1.f + tanhf(u)); }
            *(LAS att::f32x4*)(hid + 4 * lane) = (att::f32x4){hv[0], hv[1], hv[2], hv[3]};
            asm volatile("s_waitcnt lgkmcnt(0)" ::: "memory");
            float o0 = 0.f, o1 = 0.f;
#pragma unroll 8
            for (int kq = 0; kq < 256; ++kq) { const float hq = hid[kq]; const pg8::f32x2 w = *(const LAS pg8::f32x2*)(W2s + kq * 128 + 2 * lane); o0 += hq * w[0]; o1 += hq * w[1]; }
            ((unsigned*)dst)[lane] = pk2(o0, o1);
            asm volatile("s_waitcnt lgkmcnt(0)" ::: "memory");
        }
    }
    xcd_barrier(bar);
    for (int rep = 0; rep < REP_P7; ++rep) {
        const int tid_ph = threadIdx.x; const int wave = __builtin_amdgcn_readfirstlane(tid_ph >> 6);
        const int jh = wave >> 1, sub = wave & 1;
        const int vcu = (G % 8 == 0) ? ((int)blockIdx.x % 8) * (G / 8) + (int)blockIdx.x / 8 : (int)blockIdx.x;
        LAS float* Tsel = (LAS float*)(lds + L_TSEL); LAS float* Twin = (LAS float*)(lds + L_TWIN);
        LAS float* impH = (LAS float*)(lds + L_IMPH);
        LAS unsigned* selm = (LAS unsigned*)(lds + L_SELM); LAS int* tl = (LAS int*)(lds + L_TL);
        const float NINF = -__builtin_inff();
        for (int pi = vcu; pi < 256; pi += G) {
        {
            const int gq = (pi >> 4) & 3; const int tid = tid_ph;
            LAS float* tab4 = (LAS float*)(lds + L_TAB4);
            if (tid < 128) tab4[tid] = table[(tid >> 2) * NH + gq * 4 + (tid & 3)] * att::LOG2E;
            __syncthreads();
            for (int i0 = tid; i0 < 4 * 2112; i0 += 4 * NTHREADS) { float v[4];
#pragma unroll
                for (int j = 0; j < 4; ++j) { const int i = i0 + j * NTHREADS, hh = i / 2112, xx = i - hh * 2112, dist = xx - 64; v[j] = (i < 4 * 2112 && dist >= 0) ? tab4[rel_bucket(dist) * 4 + hh] : NINF; }
#pragma unroll
                for (int j = 0; j < 4; ++j) { const int i = i0 + j * NTHREADS, hh = i / 2112, xx = i - hh * 2112; if (i < 4 * 2112) Tsel[hh * 2112 + 2111 - xx] = v[j]; } }
            for (int i0 = tid; i0 < 4 * 640; i0 += 4 * NTHREADS) { float v[4];
#pragma unroll
                for (int j = 0; j < 4; ++j) { const int i = i0 + j * NTHREADS, hh = i / 640, xx = i - hh * 640, delta = xx - 64; v[j] = (i < 4 * 640 && delta >= 0 && delta < 512) ? tab4[rel_bucket(delta) * 4 + hh] : NINF; }
#pragma unroll
                for (int j = 0; j < 4; ++j) { const int i = i0 + j * NTHREADS, hh = i / 640, xx = i - hh * 640; if (i < 4 * 640) Twin[hh * 640 + 639 - xx] = v[j]; } }
        }
        for (int pass = 0; pass < 2; ++pass) {
            int tid = tid_ph; asm volatile("" : "+v"(tid));
            const int lane = tid & 63, r32 = lane & 31, hi = lane >> 5;
            const int bg = pi >> 4, qb = pass ? 31 - (pi & 15) : (pi & 15), b = bg >> 2, gq = bg & 3, h = gq * 4 + jh;
            const int tq = 64 * qb + 32 * sub + r32;
            const int grow0 = b * SEQ + 64 * qb + 32 * sub;
            const LAS float* Tsh = Tsel + jh * 2112; const LAS float* Twh = Twin + jh * 640;
            att::bf16x8 qr[8];
            { const bf16_t* qp = qB + ((size_t)h * MTOK + grow0 + r32) * HD + hi * 8;
#pragma unroll
              for (int d0 = 0; d0 < 8; ++d0) qr[d0] = *(const att::bf16x8*)(qp + d0 * 16); }
            att::f32x16 o[4];
            {
                const int sr = tid >> 4, sc = (tid & 15) * 8, vst0 = att::v_st(sr, sc), vst1 = att::v_st(32 + sr, sc), kws = ATT_KSWZ(sr, sc * 2);
                const bf16_t* Kc = kcmp + (size_t)bg * 128 * HD; const bf16_t* Vc = vcmp + (size_t)bg * 128 * HD;
#pragma unroll
                for (int tt = 0; tt < 2; ++tt) {
                    const size_t e0 = (size_t)(64 * tt + sr) * HD + sc, e1 = e0 + 32 * HD;
                    *(LAS att::bf16x8*)(lds + att::L_K + tt * att::SHM_K + kws) = *(const att::bf16x8*)(Kc + e0); *(LAS att::bf16x8*)(lds + att::L_K + tt * att::SHM_K + kws + 32 * 256) = *(const att::bf16x8*)(Kc + e1);
                    *(LAS att::bf16x8*)(lds + att::L_V + tt * att::SHM_V + vst0) = *(const att::bf16x8*)(Vc + e0); *(LAS att::bf16x8*)(lds + att::L_V + tt * att::SHM_V + vst1) = *(const att::bf16x8*)(Vc + e1);
                }
                __syncthreads();
                att::f32x16 pA0, pA1, pB0, pB1;
                const int xb = tq + 33 - 64 * hi;
#pragma unroll
                for (int r = 0; r < 16; ++r) { const int cr = 16 * ((r & 3) + 8 * (r >> 2));
                    pA0[r] = Tsh[2111 - max(xb - cr, 0)]; pA1[r] = Tsh[2111 - max(xb - cr - 512, 0)]; pB0[r] = Tsh[2111 - max(xb - cr - 1024, 0)]; pB1[r] = Tsh[2111 - max(xb - cr - 1536, 0)]; }
                {
                    const LAS unsigned char* kb[4];
#pragma unroll
                    for (int dd = 0; dd < 4; ++dd) kb[dd] = lds + att::L_K + ATT_KSWZ(r32, (dd * 16 + hi * 8) * 2);
#pragma unroll
                    for (int d0 = 0; d0 < 8; ++d0) { const LAS unsigned char* a = kb[d0 & 3] + (d0 >> 2) * 128;
                        pA0 = __builtin_amdgcn_mfma_f32_32x32x16_bf16(*(const LAS att::bf16x8*)a, qr[d0], pA0, 0, 0, 0);
                        pA1 = __builtin_amdgcn_mfma_f32_32x32x16_bf16(*(const LAS att::bf16x8*)(a + 32 * 256), qr[d0], pA1, 0, 0, 0);
                        pB0 = __builtin_amdgcn_mfma_f32_32x32x16_bf16(*(const LAS att::bf16x8*)(a + att::SHM_K), qr[d0], pB0, 0, 0, 0);
                        pB1 = __builtin_amdgcn_mfma_f32_32x32x16_bf16(*(const LAS att::bf16x8*)(a + att::SHM_K + 32 * 256), qr[d0], pB1, 0, 0, 0); }
                }
                float mx = NINF;
#pragma unroll
                for (int r = 0; r < 16; ++r) mx = fmaxf(fmaxf(mx, pA0[r]), fmaxf(fmaxf(pA1[r], pB0[r]), pB1[r]));
                { auto rr = __builtin_amdgcn_permlane32_swap(__float_as_uint(mx), __float_as_uint(mx), false, false); mx = fmaxf(__uint_as_float(rr[0]), __uint_as_float(rr[1])); }
                if (mx == NINF) mx = 0.f;
                float ps = 0.f;
#pragma unroll
                for (int r = 0; r < 16; ++r) { pA0[r] = __builtin_amdgcn_exp2f(pA0[r] - mx); pA1[r] = __builtin_amdgcn_exp2f(pA1[r] - mx);
                    pB0[r] = __builtin_amdgcn_exp2f(pB0[r] - mx); pB1[r] = __builtin_amdgcn_exp2f(pB1[r] - mx); ps += (pA0[r] + pA1[r]) + (pB0[r] + pB1[r]); }
                { auto rr = __builtin_amdgcn_permlane32_swap(__float_as_uint(ps), __float_as_uint(ps), false, false); ps = __uint_as_float(rr[0]) + __uint_as_float(rr[1]); }
                const float l_c = ps, inv = ps > 0.f ? frcp(ps) : 0.f;
                {
                    const int qrow = 32 * sub + r32; LAS float* ip = impH + (jh * 64 + qrow) * 32 + hi;
                    float eprev = 0.f;
#define IMP_GRP(P, U0) do { _Pragma("unroll") for (int q4 = 0; q4 < 4; ++q4) { \
                        const float gsum = ((P[4 * q4] + P[4 * q4 + 1]) + (P[4 * q4 + 2] + P[4 * q4 + 3])) * inv, e3 = P[4 * q4 + 3] * inv; \
                        const float eo = __uint_as_float(__builtin_amdgcn_permlane32_swap(__float_as_uint(e3), __float_as_uint(e3), false, false)[hi ? 0 : 1]);     \
                        const float ein = hi ? eo : eprev; eprev = eo; ip[2 * ((U0) + q4)] = gsum + ein; } } while (0)
                    IMP_GRP(pA0, 0); IMP_GRP(pA1, 4); IMP_GRP(pB0, 8); IMP_GRP(pB1, 12);
#undef IMP_GRP
                }
                att::bf16x8 pa0, pa1, pa2, pa3, pb0, pb1, pb2, pb3;
                ATT_PK4(pA0, 0, pa0); ATT_PK4(pA0, 8, pa1); ATT_PK4(pA1, 0, pa2); ATT_PK4(pA1, 8, pa3);
                ATT_PK4(pB0, 0, pb0); ATT_PK4(pB0, 8, pb1); ATT_PK4(pB1, 0, pb2); ATT_PK4(pB1, 8, pb3);
#pragma unroll
                for (int d_ = 0; d_ < 4; ++d_)
#pragma unroll
                    for (int r = 0; r < 16; ++r) o[d_][r] = 0.f;
                const int vb0 = att::L_V + att::v_rd_base(lane);
                att::pv_tile(o, vb0, pa0, pa1, pa2, pa3);
                att::pv_tile(o, vb0 + att::SHM_V, pb0, pb1, pb2, pb3);
                __syncthreads();
                {
                    const int q = tid >> 3, n4 = (tid & 7) * 4, cur = qb;
                    float vals[32];
#pragma unroll
                    for (int i = 0; i < 8; ++i) {
                        att::f32x4 gv = *(const LAS att::f32x4*)(impH + (0 * 64 + q) * 32 + 4 * i);
                        gv += *(const LAS att::f32x4*)(impH + (1 * 64 + q) * 32 + 4 * i); gv += *(const LAS att::f32x4*)(impH + (2 * 64 + q) * 32 + 4 * i); gv += *(const LAS att::f32x4*)(impH + (3 * 64 + q) * 32 + 4 * i);
#pragma unroll
                        for (int e = 0; e < 4; ++e) { const int n = 4 * i + e; const bool forced = (n == 0) || (n == cur) || (n == cur - 1);
                            vals[n] = forced ? 1e9f : (n > cur ? -1e9f : gv[e]); } }
                    att::f32x4 mine = *(const LAS att::f32x4*)(impH + (0 * 64 + q) * 32 + n4);
                    mine += *(const LAS att::f32x4*)(impH + (1 * 64 + q) * 32 + n4); mine += *(const LAS att::f32x4*)(impH + (2 * 64 + q) * 32 + n4); mine += *(const LAS att::f32x4*)(impH + (3 * 64 + q) * 32 + n4);
                    unsigned bits = 0u;
#pragma unroll
                    for (int e = 0; e < 4; ++e) {
                        const int n = n4 + e; const bool forced = (n == 0) || (n == cur) || (n == cur - 1);
                        const float myv = forced ? 1e9f : (n > cur ? -1e9f : mine[e]);
                        int rank = 0;
#pragma unroll
                        for (int m2 = 0; m2 < 32; ++m2) rank += (vals[m2] > myv || (vals[m2] == myv && m2 < n)) ? 1 : 0;
                        if (rank < 16 && n <= cur) bits |= 1u << n;
                    }
                    bits |= __shfl_xor(bits, 1); bits |= __shfl_xor(bits, 2); bits |= __shfl_xor(bits, 4);
                    if ((tid & 7) == 0) selm[q] = bits;
                }
                __syncthreads();
                if (tid < 64) {
                    unsigned un = selm[lane];
#pragma unroll
                    for (int off = 1; off < 64; off <<= 1) un |= __shfl_xor(un, off);
                    if (lane < 32 && ((un >> lane) & 1u)) tl[__popc(un & ((1u << lane) - 1u))] = lane;
                    if (lane == 0) { tl[32] = __popc(un); tl[33] = (int)un; }
                }
                __syncthreads();
                GateF F{zB + (size_t)grow0 * 6144 + 0 * 2048 + h * HD, gB + (size_t)grow0 * 256 + 0 * 16 + h, a1 + (size_t)grow0 * DM + h * HD, 1};
                att::emit(lds, o, l_c, lane, wave, F);
            }
            {
                SelU U; U.K = kvb + ((size_t)(2 * 4 + gq) * MTOK + b * SEQ) * HD; U.V = kvb + ((size_t)(3 * 4 + gq) * MTOK + b * SEQ) * HD;
                U.un = (unsigned)__builtin_amdgcn_readfirstlane(tl[33]); U.ntl = __builtin_amdgcn_readfirstlane(tl[32]); U.mymask = selm[32 * sub + r32]; U.tq_off = tq - 4 * hi + 5; U.T = Tsh;
#pragma unroll
                for (int d_ = 0; d_ < 4; ++d_)
#pragma unroll
                    for (int r = 0; r < 16; ++r) o[d_][r] = 0.f;
                float m_reg = -1e30f, l_reg = 0.f;
                for (int rf = 0; rf < REP_F7; ++rf) {
                    if (rf) { asm volatile("" :: "v"(o[0]), "v"(o[1]), "v"(o[2]), "v"(o[3]), "v"(m_reg), "v"(l_reg));
#pragma unroll
                        for (int d_ = 0; d_ < 4; ++d_)
#pragma unroll
                            for (int r = 0; r < 16; ++r) o[d_][r] = 0.f;
                        m_reg = -1e30f; l_reg = 0.f; }
                    att::flash_tiles(lds, U, qr, o, m_reg, l_reg, tid, lane, wave);
                }
                GateF F{zB + (size_t)grow0 * 6144 + 1 * 2048 + h * HD, gB + (size_t)grow0 * 256 + 1 * 16 + h, a1 + (size_t)grow0 * DM + h * HD, 0};
                att::emit(lds, o, l_reg, lane, wave, F);
            }
            {
                WinU U; U.K = kvb + ((size_t)(4 * 4 + gq) * MTOK + b * SEQ) * HD; U.V = kvb + ((size_t)(5 * 4 + gq) * MTOK + b * SEQ) * HD;
                const int jlo = qb < 8 ? 8 - qb : 0; U.tk_base = 64 * qb - 512 + 64 * jlo; U.ntl = 9 - jlo; U.tq_off = tq - 4 * hi + 5; U.T = Twh;
#pragma unroll
                for (int d_ = 0; d_ < 4; ++d_)
#pragma unroll
                    for (int r = 0; r < 16; ++r) o[d_][r] = 0.f;
                float m_reg = -1e30f, l_reg = 0.f;
                for (int rf = 0; rf < REP_F7; ++rf) {
                    if (rf) { asm volatile("" :: "v"(o[0]), "v"(o[1]), "v"(o[2]), "v"(o[3]), "v"(m_reg), "v"(l_reg));
#pragma unroll
                        for (int d_ = 0; d_ < 4; ++d_)
#pragma unroll
                            for (int r = 0; r < 16; ++r) o[d_][r] = 0.f;
                        m_reg = -1e30f; l_reg = 0.f; }
                    att::flash_tiles(lds, U, qr, o, m_reg, l_reg, tid, lane, wave);
                }
                GateF F{zB + (size_t)grow0 * 6144 + 2 * 2048 + h * HD, gB + (size_t)grow0 * 256 + 2 * 16 + h, a1 + (size_t)grow0 * DM + h * HD, 0};
                att::emit(lds, o, l_reg, lane, wave, F);
            }
        }
        __syncthreads();
        }
    }
    xcd_barrier(bar);
    for (int rep = 0; rep < REP_G2; ++rep) {
        pg8::Gemm g{a1, WoB_t, MTOK, DM, DM, DM, DM}; pg8::StaticOrder S; S.init(MTOK, DM, G, (int)blockIdx.x);
        pg8::EpiK<2> E{y1b, (bf16_t*)ssq1};
        pg8::gemm_phase<pg8::EpiK<2>, pg8::StaticOrder, true, true>(lds, g, S, E);
    }
    xcd_barrier(bar);
    for (int rep = 0; rep < REP_EW; ++rep) { PHASE_VARS
    for (int m = gw; m < MTOK; m += NGW) {
        float sp = (lane < 32) ? ssq1[(size_t)m * 32 + lane] : 0.f;
        const float r1 = rsqrtf(wave_sum(sp) * (1.f / DM) + 1e-6f), r0 = rstd0[m];
        const float4* xr = (const float4*)(x + (size_t)m * DM) + lane; const uint2* y0r = (const uint2*)(y0b + (size_t)m * DM) + lane; const uint2* y1r = (const uint2*)(y1b + (size_t)m * DM) + lane;
        const float4* g0r = (const float4*)norm_post + lane; const float4* g1r = (const float4*)(norm_post + DM) + lane;
        float4* orow = (float4*)(p.out + (size_t)m * DM) + lane;
#pragma unroll
        for (int j = 0; j < 8; ++j) {
            const float4 xv = ldnt4(xr + 64 * j); const uint2 a = ldnt2(y0r + 64 * j), bb = ldnt2(y1r + 64 * j); const float4 g0 = g0r[64 * j], g1 = g1r[64 * j];
            float4 o;
            o.x = xv.x + bflo(a.x) * r0 * g0.x + bflo(bb.x) * r1 * g1.x; o.y = xv.y + bfhi(a.x) * r0 * g0.y + bfhi(bb.x) * r1 * g1.y;
            o.z = xv.z + bflo(a.y) * r0 * g0.z + bflo(bb.y) * r1 * g1.z; o.w = xv.w + bfhi(a.y) * r0 * g0.w + bfhi(bb.y) * r1 * g1.w;
            { att::f32x4 ov = {o.x, o.y, o.z, o.w}; __builtin_nontemporal_store(ov, (att::f32x4*)(orow + 64 * j)); }
        }
    } }
}

extern "C" void kernel_launch(void* const* d_in, const int* in_sizes, int n_in, void* d_out, int out_size, void* d_ws, size_t ws_size, hipStream_t stream) {
    static int grid = 0;
    if (grid == 0) {
        if (n_in != 16 || ws_size < WS_END) { fprintf(stderr, "kernel_launch: unexpected n_in %d / ws_size %zu\n", n_in, ws_size); grid = -1; return; }
        int dev = 0, cus = 0, per_cu = 0;
        (void)hipGetDevice(&dev); (void)hipDeviceGetAttribute(&cus, hipDeviceAttributeMultiprocessorCount, dev);
        if (hipFuncSetAttribute((const void*)yoco_fwd, hipFuncAttributeMaxDynamicSharedMemorySize, LDS_BYTES) != hipSuccess) { fprintf(stderr, "kernel_launch: hipFuncSetAttribute failed\n"); grid = -1; return; }
        if (hipOccupancyMaxActiveBlocksPerMultiprocessor(&per_cu, (const void*)yoco_fwd, NTHREADS, LDS_BYTES) != hipSuccess || per_cu < 1) { fprintf(stderr, "kernel_launch: occupancy query says %d\n", per_cu); per_cu = 1; }
        (void)hipGetLastError();
        grid = cus;
        if (grid != 256) fprintf(stderr, "kernel_launch: note: %d CUs\n", grid);
    }
    if (grid < 0) return;
    if (hipMemsetAsync((char*)d_ws + WS_BAR, 0, 16384, stream) != hipSuccess) { fprintf(stderr, "kernel_launch: memset failed\n"); return; }
    Params prm{};
    for (int i = 0; i < 16; ++i) prm.in[i] = (const float*)d_in[i];
    prm.out = (float*)d_out; prm.ws = (unsigned char*)d_ws;
    void* args[] = {&prm};
    hipError_t e = hipLaunchCooperativeKernel((const void*)yoco_fwd, dim3(grid), dim3(NTHREADS), args, LDS_BYTES, stream);
    if (e != hipSuccess) fprintf(stderr, "kernel_launch: cooperative launch failed: %s (grid %d)\n", hipGetErrorString(e), grid);
}
```

```cpp
#include <hip/hip_runtime.h>
#include <hip/hip_cooperative_groups.h>
#include <cstdio>
#include <cstdint>
namespace cg = cooperative_groups;

namespace pg8 {
#define PG8_LAS __attribute__((address_space(3)))
typedef unsigned short bf16_t;
typedef short bf16x8 __attribute__((ext_vector_type(8)));
typedef float f32x4 __attribute__((ext_vector_type(4)));
typedef unsigned u32x4 __attribute__((ext_vector_type(4)));
constexpr int BM = 256, BK = 64, HALF = 128, HTB = HALF * BK * 2  , STAGE_BYTES = 8 * HTB, NXCD = 8, WGM = 8;

__host__ __device__ __forceinline__ int lds_byte(int r, int c) { const int st = (r >> 4) * 2 + (c >> 5), rr = r & 15, cc = c & 31, ob = rr * 64 + cc * 2; return st * 1024 + (ob ^ (((ob >> 9) & 1) << 5)); }
__host__ __device__ __forceinline__ void stage_rc(int b, int& R, int& C) { const int st = b / 1024, sb = b % 1024, swz = sb ^ (((sb >> 9) & 1) << 5); R = (st >> 1) * 16 + swz / 64; C = (st & 1) * 32 + (swz % 64) / 2; }
__host__ __device__ __forceinline__ int perm32(int rho) { const int n = rho >> 4, i = rho & 15; return 8 * (i >> 2) + 4 * n + (i & 3); }

struct Unit { int pm, pn; };
struct Gemm { const bf16_t* A; const bf16_t* Bt; int M, N, K, lda, ldb; };

struct StaticOrder {
    int nM, nN, nwg, G, c;
    __host__ __device__ void init(int M, int N, int G_, int c_) { nM = M / BM; nN = N / BM; nwg = nM * nN; G = G_; c = c_; }
    __host__ __device__ bool next(int i, Unit& u) const {
        const long L = (long)i * G + c; if (L >= nwg) return false;
        int wgid = (int)L; { const int q = nwg / NXCD, r = nwg % NXCD, xcd = wgid % NXCD, off = wgid / NXCD; wgid = (xcd < r ? xcd * (q + 1) : r * (q + 1) + (xcd - r) * q) + off; }
        const int nig = WGM * nN, gid = wgid / nig, fm = gid * WGM, gsz = (nM - fm) < WGM ? (nM - fm) : WGM;
        u.pm = fm + ((wgid % nig) % gsz); u.pn = (wgid % nig) / gsz; return true;
    }
    __device__ __forceinline__ void a_ready(const Unit&) const {}
    __device__ __forceinline__ void done(const Unit&) const {}
    __device__ __forceinline__ const char* abase(const Gemm& g, const Unit& u) const { return (const char*)g.A + (size_t)u.pm * BM * g.lda * 2; }
    __device__ __forceinline__ const char* bbase(const Gemm& g, const Unit& u) const { return (const char*)g.Bt + (size_t)u.pn * BM * g.ldb * 2; }
};

__device__ __forceinline__ unsigned cvt_pk_bf16(float lo, float hi) { unsigned r; asm volatile("v_cvt_pk_bf16_f32 %0, %1, %2" : "=v"(r) : "v"(lo), "v"(hi)); return r; }
typedef float f32x2 __attribute__((ext_vector_type(2)));

template <int KIND> struct EpiK {
    static constexpr bool PERM = true, AFTER_DRAIN = false;
    bf16_t* b0; bf16_t* b1;
    __device__ __forceinline__ void operator()(const f32x4 (&acc)[2][2][4][2], const Unit& u, int wr, int wc, int fr, int fq) const {
        bf16_t* base; bool hm; int ld = 2048, pr = u.pn;
        if (KIND == 1) { if (u.pn < 24) { base = b0; hm = true; } else { base = b1; hm = false; pr = u.pn - 24; } }
        else if (KIND == 2) { base = b0; hm = false; }
        else { if (u.pn < 8) { base = b0; hm = true; } else if (u.pn < 32) { base = b0 + (size_t)16 * 1024 * 1024; hm = false; ld = 6144; pr = u.pn - 8; }
               else if (u.pn < 44) { base = b1; hm = true; pr = u.pn - 32; } else { base = b1 + (size_t)24 * 1024 * 1024; hm = false; ld = 256; pr = 0; } }
        const int row0 = u.pm * BM + wr * 64 + fr;
        const int cin = wc * 32 + 8 * fq;
#pragma unroll
        for (int ai = 0; ai < 2; ++ai)
#pragma unroll
            for (int m = 0; m < 4; ++m) {
                const int row = row0 + ai * HALF + m * 16;
                float s = 0.f;
#pragma unroll
                for (int bj = 0; bj < 2; ++bj) {
                    const f32x4 v0 = acc[ai][bj][m][0], v1 = acc[ai][bj][m][1];
                    if (KIND == 2) s += (v0[0] * v0[0] + v0[1] * v0[1]) + (v0[2] * v0[2] + v0[3] * v0[3]) + (v1[0] * v1[0] + v1[1] * v1[1]) + (v1[2] * v1[2] + v1[3] * v1[3]);
                    u32x4 w; w.x = cvt_pk_bf16(v0[0], v0[1]); w.y = cvt_pk_bf16(v0[2], v0[3]); w.z = cvt_pk_bf16(v1[0], v1[1]); w.w = cvt_pk_bf16(v1[2], v1[3]);
                    bf16_t* dst = hm ? base + ((size_t)(pr * 2 + bj) * 8192 + row) * 128 + cin
                                     : base + (size_t)row * ld + pr * 256 + bj * HALF + cin;
                    *(u32x4*)dst = w;
                }
                if (KIND == 2) { s += __shfl_xor(s, 16); s += __shfl_xor(s, 32); if (fq == 0) ((float*)b1)[(size_t)row * 32 + u.pn * 4 + wc] = s; }
            }
    }
};

struct EpiPart {
    static constexpr bool PERM = true, AFTER_DRAIN = false;
    bf16_t* part;
    __device__ __forceinline__ void operator()(const f32x4 (&acc)[2][2][4][2], const Unit& u, int wr, int wc, int fr, int fq) const {
        bf16_t* base = part + ((size_t)u.pn * 4096 + (size_t)u.pm * BM + wr * 64 + fr) * 256 + wc * 32 + 8 * fq;
#pragma unroll
        for (int ai = 0; ai < 2; ++ai)
#pragma unroll
            for (int m = 0; m < 4; ++m)
#pragma unroll
                for (int bj = 0; bj < 2; ++bj) {
                    const f32x4 v0 = acc[ai][bj][m][0], v1 = acc[ai][bj][m][1];
                    u32x4 w; w.x = cvt_pk_bf16(v0[0], v0[1]); w.y = cvt_pk_bf16(v0[2], v0[3]); w.z = cvt_pk_bf16(v1[0], v1[1]); w.w = cvt_pk_bf16(v1[2], v1[3]);
                    *(u32x4*)(base + (size_t)(ai * HALF + m * 16) * 256 + bj * HALF) = w; }
    }
};
struct P1Aff : StaticOrder {
    __device__ __forceinline__ bool next(int i, Unit& u) const { if (G != 256 || nwg != 1024) return StaticOrder::next(i, u); if (i >= 4) return false;
        const int x = c & 7, j = c >> 3; u.pm = 8 * (x >> 1) + (j & 7); u.pn = 8 * i + 4 * (x & 1) + (j >> 3); return true; }
};
struct OutOrder : StaticOrder {
    __device__ __forceinline__ bool next(int i, Unit& u) const { if (G != 256 || nwg != 256) return StaticOrder::next(i, u); if (i != 0) return false; const int w = (c & 7) * 32 + (c >> 3); u.pm = (w >> 5) * 4 + (w & 3); u.pn = (w & 31) >> 2; return true; }
};
struct P5Order : StaticOrder {
    unsigned* cnt; int lastkv; mutable int ui; PG8_LAS unsigned* elect;
    unsigned* xcnt; unsigned nloc;
    __device__ __forceinline__ bool next(int i, Unit& u) const { if (!StaticOrder::next(i, u)) return false; u.pn = u.pn + 32 >= nN ? u.pn + 32 - nN : u.pn + 32; return true; }
    __device__ __forceinline__ void done(const Unit&) const {
        if (ui++ == lastkv) { asm volatile("s_waitcnt vmcnt(0)" ::: "memory");
            unsigned prev = 0u; if ((threadIdx.x & 63) == 0) prev = __hip_atomic_fetch_add(elect, 1u, __ATOMIC_RELAXED, __HIP_MEMORY_SCOPE_WORKGROUP);
            if ((unsigned)__builtin_amdgcn_readfirstlane((int)prev) == 7u) {
                unsigned px = 0u; if ((threadIdx.x & 63) == 0) { __hip_atomic_store(elect, 0u, __ATOMIC_RELAXED, __HIP_MEMORY_SCOPE_WORKGROUP); px = __hip_atomic_fetch_add(xcnt, 1u, __ATOMIC_RELAXED, __HIP_MEMORY_SCOPE_AGENT); }
                if ((unsigned)__builtin_amdgcn_readfirstlane((int)px) + 1u == nloc) {
                    __builtin_amdgcn_fence(__ATOMIC_RELEASE, "agent"); asm volatile("s_waitcnt vmcnt(0)" ::: "memory");
                    if ((threadIdx.x & 63) == 0) (void)__hip_atomic_fetch_add(cnt, 1u, __ATOMIC_RELAXED, __HIP_MEMORY_SCOPE_AGENT); } } }
    }
};
struct CmpOrder {
    int c, G, first; const unsigned* cnt; unsigned need; unsigned* tmo; unsigned* dcnt; PG8_LAS unsigned* elect;
    __device__ __forceinline__ bool next(int i, Unit& u) const { const int j = (c - first + G) % G + i * G; if (j >= 64) return false; u.pm = j >> 2; u.pn = j & 3; return true; }
    __device__ __forceinline__ void a_ready(const Unit&) const {
        if (threadIdx.x < 64) {
            unsigned sp = 0u;
            while ((unsigned)__builtin_amdgcn_readfirstlane(__hip_atomic_load(cnt, __ATOMIC_RELAXED, __HIP_MEMORY_SCOPE_AGENT)) < need) {
                __builtin_amdgcn_s_sleep(2);
                if ((++sp & 255u) == 0u) { if (__hip_atomic_load(tmo, __ATOMIC_RELAXED, __HIP_MEMORY_SCOPE_AGENT)) break; if (sp > (1u << 18)) { atomicAdd(tmo, 1u); break; } } }
            __builtin_amdgcn_fence(__ATOMIC_ACQUIRE, "agent");
            asm volatile("s_waitcnt vmcnt(0)" ::: "memory");
        }
        asm volatile("" ::: "memory"); __builtin_amdgcn_s_barrier(); asm volatile("" ::: "memory");
    }
    __device__ __forceinline__ void done(const Unit&) const {
        asm volatile("s_waitcnt vmcnt(0)" ::: "memory");
        unsigned prev = 0u; if ((threadIdx.x & 63) == 0) prev = __hip_atomic_fetch_add(elect, 1u, __ATOMIC_RELAXED, __HIP_MEMORY_SCOPE_WORKGROUP);
        if ((unsigned)__builtin_amdgcn_readfirstlane((int)prev) == 7u) {
            __builtin_amdgcn_fence(__ATOMIC_RELEASE, "agent"); asm volatile("s_waitcnt vmcnt(0)" ::: "memory");
            if ((threadIdx.x & 63) == 0) { (void)__hip_atomic_fetch_add(dcnt, 1u, __ATOMIC_RELAXED, __HIP_MEMORY_SCOPE_AGENT); __hip_atomic_store(elect, 0u, __ATOMIC_RELAXED, __HIP_MEMORY_SCOPE_WORKGROUP); } } }
    __device__ __forceinline__ const char* abase(const Gemm& g, const Unit& u) const { const int cb = u.pm >> 1, mt = u.pm & 1; return (const char*)g.A + ((size_t)cb * 8192 * 128 + (size_t)mt * 256 * 2048 + (size_t)u.pn * 1024) * 2; }
    __device__ __forceinline__ const char* bbase(const Gemm& g, const Unit& u) const { const int sec = u.pm >> 3; return (const char*)g.Bt + ((size_t)sec * 256 * 4096 + (size_t)u.pn * 1024) * 2; }
};
template <class Epi, class Sched, bool ALIGN_EPI = false, bool SP2 = false>
__device__ __forceinline__ void gemm_phase(PG8_LAS unsigned char* lds, const Gemm g, const Sched& S, const Epi& E) {
    int tid_raw = threadIdx.x; asm volatile("" : "+v"(tid_raw));
    const int tid = tid_raw, wid = __builtin_amdgcn_readfirstlane(tid >> 6), lane = tid & 63, wr = wid >> 2, wc = wid & 3, fr = lane & 15, fq = lane >> 4;
    const int K = g.K, nt = K / BK;
    unsigned voffA[2], voffB[2];
#pragma unroll
    for (int i = 0; i < 2; ++i) { int R, C; stage_rc(tid * 16 + i * 8192, R, C); const int Rb = Epi::PERM ? ((R & ~31) + perm32(R & 31)) : R;
        voffA[i] = (unsigned)(R * g.lda + C) * 2u; voffB[i] = (unsigned)(Rb * g.ldb + C) * 2u; }
    const size_t kstep = (size_t)(BK * 2);
    const size_t hstepA = (size_t)HALF * g.lda * 2, hstepB = (size_t)HALF * g.ldb * 2;
    const unsigned ldsw = (unsigned)wid * 1024u;
    const int aoff = lds_byte(wr * 64 + fr, fq * 8), boff = lds_byte(wc * 32 + fr, fq * 8);
#define PG8_SA(b, h) (((b) * 2 + (h)) * HTB)
#define PG8_SB(b, h) ((4 + (b) * 2 + (h)) * HTB)
#define PG8_STAGE(bufoff, gbase, voff) do { _Pragma("unroll") for (int _i = 0; _i < 2; ++_i) \
        __builtin_amdgcn_global_load_lds((const unsigned*)((const char*)(gbase) + (voff)[_i]), (PG8_LAS unsigned*)(lds + (bufoff) + ldsw + _i * 8192), 16, 0, 0); } while (0)
#define PG8_LDA(dst, b, h) do { _Pragma("unroll") for (int m = 0; m < 4; ++m) _Pragma("unroll") for (int k = 0; k < 2; ++k) dst[m][k] = *(const PG8_LAS bf16x8*)(lds + PG8_SA(b, h) + aoff + m * 2048 + k * 1024); } while (0)
#define PG8_LDB(dst, b, h) do { _Pragma("unroll") for (int n = 0; n < 2; ++n) _Pragma("unroll") for (int k = 0; k < 2; ++k) dst[n][k] = *(const PG8_LAS bf16x8*)(lds + PG8_SB(b, h) + boff + n * 2048 + k * 1024); } while (0)
#define PG8_MMA(ai, bj, At, Bt) do { __builtin_amdgcn_s_setprio(1); _Pragma("unroll") for (int m = 0; m < 4; ++m) _Pragma("unroll") for (int n = 0; n < 2; ++n) _Pragma("unroll") for (int k = 0; k < 2; ++k) \
        acc[ai][bj][m][n] = __builtin_amdgcn_mfma_f32_16x16x32_bf16(Bt[n][k], At[m][k], acc[ai][bj][m][n], 0, 0, 0); __builtin_amdgcn_s_setprio(0); } while (0)
#define PG8_WAIT_V(n) asm volatile("s_waitcnt vmcnt(" #n ")" ::: "memory")
#define PG8_WAIT_L(n) asm volatile("s_waitcnt lgkmcnt(" #n ")" ::: "memory")
#define PG8_BAR __builtin_amdgcn_s_barrier()
#define PG8_SCHED __builtin_amdgcn_sched_barrier(0)
    Unit cur, nxt; int ui = 0;
    if (!S.next(0, cur)) return;
    f32x4 acc[2][2][4][2];
#pragma unroll
    for (int a = 0; a < 2; ++a)
#pragma unroll
        for (int b = 0; b < 2; ++b)
#pragma unroll
            for (int m = 0; m < 4; ++m)
#pragma unroll
                for (int n = 0; n < 2; ++n) acc[a][b][m][n] = (f32x4){0.f, 0.f, 0.f, 0.f};
    bf16x8 At[4][2], B0[2][2], B1[2][2];
    const char* cA = S.abase(g, cur); const char* cB = S.bbase(g, cur);
    S.a_ready(cur);
    if constexpr (SP2) {
        PG8_STAGE(PG8_SB(0, 0), cB, voffB); PG8_STAGE(PG8_SB(0, 1), cB + hstepB, voffB); PG8_STAGE(PG8_SA(0, 0), cA, voffA); PG8_STAGE(PG8_SA(0, 1), cA + hstepA, voffA);
        if (wr == 1) PG8_BAR;
        PG8_WAIT_V(2); PG8_BAR;
        PG8_STAGE(PG8_SB(1, 0), cB + kstep, voffB); PG8_STAGE(PG8_SA(1, 0), cA + kstep, voffA); PG8_STAGE(PG8_SB(1, 1), cB + hstepB + kstep, voffB);
        PG8_WAIT_V(6); PG8_BAR;
    } else {
        PG8_STAGE(PG8_SB(0, 0), cB, voffB); PG8_STAGE(PG8_SA(0, 0), cA, voffA); PG8_STAGE(PG8_SB(0, 1), cB + hstepB, voffB); PG8_STAGE(PG8_SA(0, 1), cA + hstepA, voffA);
        if (wr == 1) PG8_BAR;
        PG8_WAIT_V(4); PG8_BAR;
        PG8_STAGE(PG8_SB(1, 0), cB + kstep, voffB); PG8_STAGE(PG8_SA(1, 0), cA + kstep, voffA); PG8_STAGE(PG8_SB(1, 1), cB + hstepB + kstep, voffB);
        PG8_WAIT_V(6); PG8_BAR;
    }
    for (;;) {
        const bool has_next = S.next(ui + 1, nxt);
        const char* nA = has_next ? S.abase(g, nxt) : cA; const char* nB = has_next ? S.bbase(g, nxt) : cB;
        for (int t = 0; t < nt; t += 2) {
            const bool last = (t == nt - 2);
            const char* a1 = cA + (size_t)(t + 1) * kstep;
            const char* a2 = last ? nA : cA + (size_t)(t + 2) * kstep; const char* b2 = last ? nB : cB + (size_t)(t + 2) * kstep;
            const char* a3 = a2 + kstep; const char* b3 = b2 + kstep;
            if (last && has_next) S.a_ready(nxt);
            if constexpr (SP2) {
            PG8_LDB(B0, 0, 0); PG8_LDB(B1, 0, 1); PG8_SCHED; PG8_LDA(At, 0, 0); PG8_STAGE(PG8_SA(1, 1), a1 + hstepA, voffA);
            PG8_WAIT_V(8); PG8_WAIT_L(0); PG8_BAR; PG8_MMA(0, 0, At, B0); PG8_MMA(0, 1, At, B1); PG8_BAR; PG8_SCHED;
            PG8_LDA(At, 0, 1); PG8_STAGE(PG8_SB(0, 0), b2, voffB); PG8_STAGE(PG8_SB(0, 1), b2 + hstepB, voffB); PG8_STAGE(PG8_SA(0, 0), a2, voffA);
            PG8_WAIT_V(8); PG8_WAIT_L(0); PG8_BAR; PG8_MMA(1, 0, At, B0); PG8_MMA(1, 1, At, B1); PG8_BAR; PG8_SCHED;
            PG8_LDB(B0, 1, 0); PG8_LDB(B1, 1, 1); PG8_SCHED; PG8_LDA(At, 1, 0); PG8_STAGE(PG8_SA(0, 1), a2 + hstepA, voffA);
            PG8_WAIT_V(8); PG8_WAIT_L(0); PG8_BAR; PG8_MMA(0, 0, At, B0); PG8_MMA(0, 1, At, B1); PG8_BAR; PG8_SCHED;
            PG8_LDA(At, 1, 1); PG8_STAGE(PG8_SB(1, 0), b3, voffB); PG8_STAGE(PG8_SB(1, 1), b3 + hstepB, voffB); PG8_STAGE(PG8_SA(1, 0), a3, voffA);
            PG8_WAIT_V(8); PG8_WAIT_L(0); PG8_BAR; PG8_MMA(1, 0, At, B0); PG8_MMA(1, 1, At, B1); PG8_BAR; PG8_SCHED;
            } else {
            PG8_LDB(B0, 0, 0); PG8_SCHED; PG8_LDA(At, 0, 0); PG8_STAGE(PG8_SA(1, 1), a1 + hstepA, voffA);
            PG8_WAIT_L(8); PG8_BAR; PG8_WAIT_L(0); PG8_MMA(0, 0, At, B0); PG8_BAR; PG8_SCHED;
            PG8_LDB(B1, 0, 1); PG8_STAGE(PG8_SB(0, 0), b2, voffB);
            PG8_BAR; PG8_WAIT_L(0); PG8_MMA(0, 1, At, B1); PG8_BAR;
            PG8_LDA(At, 0, 1); PG8_STAGE(PG8_SA(0, 0), a2, voffA);
            PG8_BAR; PG8_WAIT_L(0); PG8_MMA(1, 0, At, B0); PG8_BAR; PG8_SCHED;
            PG8_STAGE(PG8_SB(0, 1), b2 + hstepB, voffB);
            PG8_WAIT_V(6); PG8_BAR; PG8_MMA(1, 1, At, B1); PG8_BAR;
            PG8_LDB(B0, 1, 0); PG8_SCHED; PG8_LDA(At, 1, 0); PG8_STAGE(PG8_SA(0, 1), a2 + hstepA, voffA);
            PG8_WAIT_L(8); PG8_BAR; PG8_WAIT_L(0); PG8_MMA(0, 0, At, B0); PG8_BAR; PG8_SCHED;
            PG8_LDB(B1, 1, 1); PG8_STAGE(PG8_SB(1, 0), b3, voffB);
            PG8_BAR; PG8_WAIT_L(0); PG8_MMA(0, 1, At, B1); PG8_BAR;
            PG8_LDA(At, 1, 1); PG8_STAGE(PG8_SA(1, 0), a3, voffA);
            PG8_BAR; PG8_WAIT_L(0); PG8_MMA(1, 0, At, B0); PG8_BAR; PG8_SCHED;
            PG8_STAGE(PG8_SB(1, 1), b3 + hstepB, voffB);
            PG8_WAIT_V(6); PG8_BAR; PG8_MMA(1, 1, At, B1); PG8_BAR;
            }
        }
        if constexpr (ALIGN_EPI) { if (wr == 0) PG8_BAR; }
        if constexpr (!Epi::AFTER_DRAIN) { E(acc, cur, wr, wc, fr, fq); S.done(cur); }
        if (!has_next) break;
#pragma unroll
        for (int a = 0; a < 2; ++a)
#pragma unroll
            for (int b = 0; b < 2; ++b)
#pragma unroll
                for (int m = 0; m < 4; ++m)
#pragma unroll
                    for (int n = 0; n < 2; ++n) acc[a][b][m][n] = (f32x4){0.f, 0.f, 0.f, 0.f};
        cur = nxt; cA = nA; cB = nB; ++ui;
        if constexpr (ALIGN_EPI) { if (wr == 1) PG8_BAR; }
    }
    PG8_WAIT_V(0);
    if constexpr (!ALIGN_EPI) { if (wr == 0) PG8_BAR; }
    PG8_BAR;
    if constexpr (Epi::AFTER_DRAIN) { E.fused(acc, cur, wr, wc, fr, fq, lds, wid, lane); S.done(cur); }
#undef PG8_SA
#undef PG8_SB
#undef PG8_STAGE
#undef PG8_LDA
#undef PG8_LDB
#undef PG8_MMA
#undef PG8_WAIT_V
#undef PG8_WAIT_L
#undef PG8_BAR
#undef PG8_SCHED
}
}

#define LAS __attribute__((address_space(3)))
typedef unsigned short bf16_t;
typedef unsigned u32x4 __attribute__((ext_vector_type(4)));
constexpr int DM = 2048, NB = 4, SEQ = 2048, NH = 16, HD = 128, MTOK = NB * SEQ;
constexpr int NCMP = 127;
constexpr float ATT_SCALE = 0.08838834764831845f;
constexpr float QSC = ATT_SCALE * 1.4426950408889634f;
constexpr float NEGF = -1e30f;
constexpr size_t MiB = 1u << 20;
constexpr size_t WS_QKVA = 0, WS_ZA = 96 * MiB;
constexpr size_t WS_QB = 0, WS_ZB = 32 * MiB;
constexpr size_t WS_Y1 = 0;
constexpr size_t WS_B = 128 * MiB;
constexpr size_t WS_WB = 160 * MiB;
constexpr size_t WS_WOA = 205 * MiB, WS_WOB = 213 * MiB;
constexpr size_t WS_Y0 = 221 * MiB;
constexpr size_t WS_SSQ0 = 253 * MiB, WS_SSQ1 = 254 * MiB, WS_RSTD0 = 255 * MiB;
constexpr size_t WS_BAR = 255 * MiB + 131072;
constexpr size_t WS_END = 256 * MiB;
constexpr size_t DO_XHAT0 = 0;
constexpr size_t DO_KVB = 0;
constexpr size_t DO_GB = 48 * MiB;
constexpr size_t DO_KCMP = 52 * MiB, DO_VCMP = 53 * MiB;
constexpr int NWB = 11520;

struct Params { const float* in[16]; float* out; unsigned char* ws; };

__device__ __forceinline__ float4 ldnt4(const float4* p) { typedef float f4v __attribute__((ext_vector_type(4))); const f4v v = __builtin_nontemporal_load((const f4v*)p); return make_float4(v[0], v[1], v[2], v[3]); }
__device__ __forceinline__ uint2 ldnt2(const uint2* p) { typedef unsigned u2v __attribute__((ext_vector_type(2))); const u2v v = __builtin_nontemporal_load((const u2v*)p); return make_uint2(v[0], v[1]); }
__device__ __forceinline__ uint4 ldnt4u(const uint4* p) { typedef unsigned u4v __attribute__((ext_vector_type(4))); const u4v v = __builtin_nontemporal_load((const u4v*)p); return make_uint4(v[0], v[1], v[2], v[3]); }
__device__ __forceinline__ float bf2f(unsigned u16) { return __uint_as_float(u16 << 16); }
__device__ __forceinline__ float bflo(unsigned w) { return __uint_as_float(w << 16); }
__device__ __forceinline__ float bfhi(unsigned w) { return __uint_as_float(w & 0xffff0000u); }
__device__ __forceinline__ unsigned f2bf(float f) { unsigned u = __float_as_uint(f); return (u + 0x7fffu + ((u >> 16) & 1u)) >> 16; }
__device__ __forceinline__ unsigned pk2(float lo, float hi) { return f2bf(lo) | (f2bf(hi) << 16); }
__device__ __forceinline__ float wave_sum(float v) {
#pragma unroll
    for (int o = 32; o >= 1; o >>= 1) v += __shfl_xor(v, o);
    return v;
}
__device__ __forceinline__ float wave_max(float v) {
#pragma unroll
    for (int o = 32; o >= 1; o >>= 1) v = fmaxf(v, __shfl_xor(v, o));
    return v;
}
__device__ __forceinline__ int rel_bucket(int dist) {
    int n = dist > 0 ? dist : 0;
    if (n < 16) return n;
    int b = 16;
    b += (n >= 22); b += (n >= 30); b += (n >= 40); b += (n >= 54); b += (n >= 73); b += (n >= 99); b += (n >= 134); b += (n >= 182);
    b += (n >= 246); b += (n >= 332); b += (n >= 450); b += (n >= 609); b += (n >= 825); b += (n >= 1117); b += (n >= 1513);
    return b;
}
__device__ __forceinline__ float frcp(float x) { return __builtin_amdgcn_rcpf(x); }
__device__ __forceinline__ float silu(float z) { return z * frcp(1.f + __expf(-z)); }

struct TItem { const float* W; const float* g; bf16_t* WT; int ldw, c0, ncv, k0, K, r0; float sc; };
__device__ __forceinline__ void titem_load64(const TItem& t, float (&v)[64], int lane) {
    const int c = t.c0 + lane; const float* p = t.W + (size_t)t.k0 * t.ldw + c; const bool ok = c < t.ncv;
#pragma unroll
    for (int i = 0; i < 64; ++i) v[i] = ok ? __builtin_nontemporal_load(p + (size_t)i * t.ldw) : 0.f;
}
__device__ __forceinline__ void titem_store64(const TItem& t, const float (&v)[64], LAS float* scr, int lane) {
#pragma unroll
    for (int i = 0; i < 64; ++i) scr[i * 65 + lane] = v[i];
    const int c = lane & 7;
    float gk[8];
#pragma unroll
    for (int j = 0; j < 8; ++j) gk[j] = (t.g ? t.g[t.k0 + 8 * c + j] : 1.f) * t.sc;
    asm volatile("s_waitcnt lgkmcnt(0)" ::: "memory");
#pragma unroll
    for (int j = 0; j < 8; ++j) {
        const int n = (lane >> 3) + 8 * j; const LAS float* s = scr + (8 * c) * 65 + n;
        u32x4 o; o.x = pk2(s[0 * 65] * gk[0], s[1 * 65] * gk[1]); o.y = pk2(s[2 * 65] * gk[2], s[3 * 65] * gk[3]); o.z = pk2(s[4 * 65] * gk[4], s[5 * 65] * gk[5]); o.w = pk2(s[6 * 65] * gk[6], s[7 * 65] * gk[7]);
        *(u32x4*)(t.WT + (size_t)(t.r0 + n) * t.K + t.k0 + 8 * c) = o;
    }
    asm volatile("s_waitcnt lgkmcnt(0)" ::: "memory");
}
__device__ __forceinline__ void titem_load(const TItem& t, float (&v)[32], int lane) {
    const int c = t.c0 + (lane & 31); const float* p = t.W + (size_t)(t.k0 + (lane >> 5)) * t.ldw + c; const bool ok = c < t.ncv;
#pragma unroll
    for (int i = 0; i < 32; ++i) v[i] = ok ? p[(size_t)(2 * i) * t.ldw] : 0.f;
}
__device__ __forceinline__ void titem_store(const TItem& t, const float (&v)[32], LAS float* scr, int lane) {
#pragma unroll
    for (int i = 0; i < 32; ++i) scr[(2 * i + (lane >> 5)) * 33 + (lane & 31)] = v[i];
    const int c = lane & 7;
    float gk[8];
#pragma unroll
    for (int j = 0; j < 8; ++j) gk[j] = (t.g ? t.g[t.k0 + 8 * c + j] : 1.f) * t.sc;
    asm volatile("s_waitcnt lgkmcnt(0)" ::: "memory");
#pragma unroll
    for (int j = 0; j < 4; ++j) {
        const int n = (lane >> 3) + 8 * j; const LAS float* s = scr + (8 * c) * 33 + n;
        u32x4 o; o.x = pk2(s[0 * 33] * gk[0], s[1 * 33] * gk[1]); o.y = pk2(s[2 * 33] * gk[2], s[3 * 33] * gk[3]); o.z = pk2(s[4 * 33] * gk[4], s[5 * 33] * gk[5]); o.w = pk2(s[6 * 33] * gk[6], s[7 * 33] * gk[7]);
        *(u32x4*)(t.WT + (size_t)(t.r0 + n) * t.K + t.k0 + 8 * c) = o;
    }
    asm volatile("s_waitcnt lgkmcnt(0)" ::: "memory");
}
__device__ __forceinline__ void transpose_item(const float* W, int ldw, int c0, int ncv, int k0, const float* g, bf16_t* WT, int K, int r0, LAS float* scr, int lane) {
    TItem t{W, g, WT, ldw, c0, ncv, k0, K, r0, 1.f}; float v[32]; titem_load(t, v, lane); titem_store(t, v, scr, lane);
}
__device__ __forceinline__ void rms_row_bf16(const float* xrow, bf16_t* orow, int lane) {
    const float4* xr = (const float4*)xrow + lane;
    float4 v[8]; float ss = 0.f;
#pragma unroll
    for (int j = 0; j < 8; ++j) { v[j] = ldnt4(xr + 64 * j); ss += (v[j].x * v[j].x + v[j].y * v[j].y) + (v[j].z * v[j].z + v[j].w * v[j].w); }
    const float r = rsqrtf(wave_sum(ss) * (1.f / DM) + 1e-6f);
    uint2* o8 = (uint2*)orow + lane;
#pragma unroll
    for (int j = 0; j < 8; ++j) o8[64 * j] = make_uint2(pk2(v[j].x * r, v[j].y * r), pk2(v[j].z * r, v[j].w * r));
}

__device__ __forceinline__ float dot_row(const LAS float* qs, const bf16_t* krow) {
    const uint4* kp = (const uint4*)krow; float acc = 0.f;
#pragma unroll 4
    for (int i = 0; i < 16; ++i) {
        const uint4 w = kp[i]; const LAS float* q = qs + 8 * i;
        acc += q[0] * bflo(w.x) + q[1] * bfhi(w.x) + q[2] * bflo(w.y) + q[3] * bfhi(w.y) + q[4] * bflo(w.z) + q[5] * bfhi(w.z) + q[6] * bflo(w.w) + q[7] * bfhi(w.w);
    }
    return acc;
}
__device__ __forceinline__ void wave_chunk(const LAS float* qs, const bf16_t* Kb, const bf16_t* Vb, bool valid, int row, float bias,
                                           float& m, float& l, float& o0, float& o1, int lane) {
    float s = NEGF;
    if (valid) s = dot_row(qs, Kb + (size_t)row * HD) * ATT_SCALE + bias;
    const float cm = wave_max(s);
    const float mn = fmaxf(m, cm);
    const float p = valid ? __expf(s - mn) : 0.f;
    const float alpha = __expf(m - mn);
    l = l * alpha + wave_sum(p);
    o0 *= alpha; o1 *= alpha; m = mn;
    const float pb = bf2f(f2bf(p));
    const unsigned long long act = __ballot(pb != 0.f);
    for (int j = 0; j < 64; ++j) {
        if (!((act >> j) & 1ull)) continue;
        const float pj = __shfl(pb, j); const int rj = __shfl(row, j);
        const unsigned w = ((const unsigned*)(Vb + (size_t)rj * HD))[lane];
        o0 += pj * bflo(w); o1 += pj * bfhi(w);
    }
}
__device__ __forceinline__ void load_q(LAS float* qs, const bf16_t* qrow, int lane) {
    const unsigned w = ((const unsigned*)qrow)[lane];
    qs[2 * lane] = bflo(w); qs[2 * lane + 1] = bfhi(w);
    asm volatile("s_waitcnt lgkmcnt(0)" ::: "memory");
}

__device__ __forceinline__ unsigned long long rt() { return __builtin_amdgcn_s_memrealtime(); }
#define XB_TMO      128
#define XB_XCNT(j)  (256  + 64 * (j))
#define XB_XSUB(j)  (1280 + 64 * (j))
#define XB_XGEN(j)  (2304 + 64 * (j))
#define XB_TOP      3328
#define XB_TOPGEN   3392
#define XCD_BAR_WORDS 3456
#define XB_SPIN_CAP (1u << 18)

__device__ __forceinline__ unsigned xb_ld(unsigned* p)              { return __hip_atomic_load(p, __ATOMIC_RELAXED, __HIP_MEMORY_SCOPE_AGENT); }
__device__ __forceinline__ unsigned xb_add(unsigned* p, unsigned v) { return __hip_atomic_fetch_add(p, v, __ATOMIC_RELAXED, __HIP_MEMORY_SCOPE_AGENT); }
__device__ __forceinline__ unsigned xb_xcc_id() { return (unsigned)__builtin_amdgcn_s_getreg((3 << 11) | 20) & 0xFu; }
#define XB_SPIN(cond, bar) do { unsigned _sp = 0; while (cond) { __builtin_amdgcn_s_sleep(1); \
    if ((++_sp & 255u) == 0u) { if (xb_ld(&(bar)[XB_TMO])) break; if (_sp > XB_SPIN_CAP) { atomicAdd(&(bar)[XB_TMO], 1u); break; } } } } while (0)

struct XcdBarrier {
    unsigned* bar; unsigned x;
    volatile LAS unsigned* st;
};

__device__ __forceinline__ XcdBarrier xcd_barrier_post(unsigned* bar, volatile LAS unsigned* st) {
    XcdBarrier b; b.bar = bar; b.x = xb_xcc_id(); b.st = st;
    if (threadIdx.x == 0) (void)xb_add(&bar[XB_XCNT(b.x)], 1u);
    return b;
}
__device__ __forceinline__ void xcd_barrier_complete(unsigned* bar, unsigned x, unsigned& nloc, unsigned& nx) {
    const unsigned G = gridDim.x * gridDim.y * gridDim.z;
    unsigned sum, cnt, mine, sp = 0u;
    for (;;) {
        sum = 0u; cnt = 0u; mine = 0u;
#pragma unroll
        for (unsigned j = 0; j < 16; ++j) { const unsigned c = xb_ld(&bar[XB_XCNT(j)]); sum += c; cnt += (c > 0u) ? 1u : 0u; mine = (j == x) ? c : mine; }
        if (sum == G) break;
        __builtin_amdgcn_s_sleep(1);
        if ((++sp & 255u) == 0u) { if (xb_ld(&bar[XB_TMO])) break; if (sp > XB_SPIN_CAP) { atomicAdd(&bar[XB_TMO], 1u); break; } }
    }
    nloc = mine > 0u ? mine : 1u; nx = cnt > 0u ? cnt : 1u;
}

struct XbNoWork { __device__ __forceinline__ void operator()() const {} };
template <class W = XbNoWork>
__device__ __forceinline__ void xcd_barrier(const XcdBarrier& b, const W& work = W()) {
    asm volatile("s_waitcnt vmcnt(0)" ::: "memory");
    __syncthreads();
    if (threadIdx.x >= 64) { work(); asm volatile("s_waitcnt vmcnt(0) lgkmcnt(0)" ::: "memory"); }
    if (threadIdx.x == 0) {
        unsigned* bar = b.bar;
        __builtin_amdgcn_s_waitcnt(0);
        unsigned nloc = b.st[0], nx = b.st[1];
        if (nloc == 0u) { xcd_barrier_complete(bar, b.x, nloc, nx); b.st[0] = nloc; b.st[1] = nx; }
        const unsigned old = xb_add(&bar[XB_XSUB(b.x)], 1u);
        const unsigned gen = old / nloc;
        if (old + 1u == (gen + 1u) * nloc) {
            __builtin_amdgcn_fence(__ATOMIC_RELEASE, "agent");
            asm volatile("s_waitcnt vmcnt(0)" ::: "memory");
            const unsigned og = xb_add(&bar[XB_TOP], 1u);
            const unsigned tg = og / nx;
            if (og + 1u == (tg + 1u) * nx) xb_add(&bar[XB_TOPGEN], 1u);
            else XB_SPIN(xb_ld(&bar[XB_TOPGEN]) == tg, bar);
            __builtin_amdgcn_fence(__ATOMIC_ACQUIRE, "agent");
            asm volatile("s_waitcnt vmcnt(0)" ::: "memory");
        } else {
            XB_SPIN(xb_ld(&bar[XB_TOPGEN]) == gen, bar);
            __builtin_amdgcn_fence(__ATOMIC_ACQUIRE, "agent");
            asm volatile("s_waitcnt vmcnt(0)" ::: "memory");
        }
    }
    __syncthreads();
}


namespace att {
typedef short bf16x8 __attribute__((ext_vector_type(8)));
typedef short s16x4 __attribute__((ext_vector_type(4)));
typedef float f32x16 __attribute__((ext_vector_type(16)));
typedef float f32x4 __attribute__((ext_vector_type(4)));
constexpr int SHM_V = 16384, SHM_K = 16384;
constexpr int L_V = 0, L_K = 65536, L_WS = 114688, L_TBL = 116736;
constexpr float SCALE = 0.08838834764831845f, THR = 8.f;
constexpr float C2 = 1.4426950408889634f * SCALE;
constexpr float LOG2E = 1.4426950408889634f, LN2 = 0.6931471805599453f, THR2 = THR * LOG2E;
constexpr int L_FLAG = 163840 - 56;
#define ATT_KSWZ(row, colB) ((row) * 256 + ((colB) ^ (((row) & 7) << 4)))
#define ATT_SBAR() __builtin_amdgcn_sched_barrier(0)
__device__ __forceinline__ int v_st(int k, int c) { const int kk = (k & ~0xC) | ((k & 4) << 1) | ((k & 8) >> 1); return ((kk >> 3) * 4 + (c >> 5)) * 512 + ((kk & 7) * 32 + (c & 31)) * 2; }
__device__ __forceinline__ int v_rd_base(int lane) { return ((lane & 3) << 3) | (((lane >> 2) & 3) << 6) | (((lane >> 4) & 1) << 5) | (((lane >> 5) & 1) << 8); }
constexpr int v_rd_off(int d0, int ks, int half) { return d0 * 512 + ks * 4096 + half * 2048; }
__device__ __forceinline__ int crow(int r, int hi) { return (r & 3) + 8 * (r >> 2) + 4 * hi; }
__device__ __forceinline__ unsigned cvtpk(float lo, float hi) { unsigned r; asm volatile("v_cvt_pk_bf16_f32 %0, %1, %2" : "=v"(r) : "v"(lo), "v"(hi)); return r; }

__device__ __forceinline__ void partialSM(f32x16& p0, f32x16& p1, float& m_reg, float& alpha) {
    float pmax = p0[0];
#pragma unroll
    for (int r = 1; r < 16; ++r) pmax = fmaxf(pmax, p0[r]);
#pragma unroll
    for (int r = 0; r < 16; ++r) pmax = fmaxf(pmax, p1[r]);
    { auto rr = __builtin_amdgcn_permlane32_swap(__float_as_uint(pmax), __float_as_uint(pmax), false, false);
      pmax = fmaxf(__uint_as_float(rr[0]), __uint_as_float(rr[1])); }
    float mn;
    if (__builtin_expect(__all((pmax - m_reg) * SCALE <= THR), 1)) { mn = m_reg; alpha = 1.f; }
    else { mn = fmaxf(m_reg, pmax); alpha = __builtin_amdgcn_exp2f((m_reg - mn) * C2); m_reg = mn; }
    const float mnL = -mn * C2;
#pragma unroll
    for (int r = 0; r < 16; ++r) p0[r] = fmaf(p0[r], C2, mnL);
#pragma unroll
    for (int r = 0; r < 16; ++r) p1[r] = fmaf(p1[r], C2, mnL);
#pragma unroll
    for (int r = 0; r < 16; ++r) p0[r] = __builtin_amdgcn_exp2f(p0[r]);
}
#define ATT_PK4(P, B_, OUT) do { unsigned a0 = att::cvtpk(P[B_+0], P[B_+1]), a1 = att::cvtpk(P[B_+2], P[B_+3]);                          \
        unsigned b0 = att::cvtpk(P[B_+4], P[B_+5]), b1 = att::cvtpk(P[B_+6], P[B_+7]);                                             \
        auto r0 = __builtin_amdgcn_permlane32_swap(a0, b0, false, false); auto r1 = __builtin_amdgcn_permlane32_swap(a1, b1, false, false); \
        u32x4 w = {r0[0], r1[0], r0[1], r1[1]}; OUT = __builtin_bit_cast(att::bf16x8, w); } while (0)
__device__ __forceinline__ void finishSM(f32x16& p0, f32x16& p1, float alpha, float& l_reg, bf16x8& pa0, bf16x8& pa1, bf16x8& pa2, bf16x8& pa3) {
#pragma unroll
    for (int r = 0; r < 16; ++r) p1[r] = __builtin_amdgcn_exp2f(p1[r]);
    float ps = 0;
#pragma unroll
    for (int r = 0; r < 16; ++r) ps += p0[r];
#pragma unroll
    for (int r = 0; r < 16; ++r) ps += p1[r];
    { auto rr = __builtin_amdgcn_permlane32_swap(__float_as_uint(ps), __float_as_uint(ps), false, false);
      ps = __uint_as_float(rr[0]) + __uint_as_float(rr[1]); }
    l_reg = l_reg * alpha + ps;
    ATT_PK4(p0, 0, pa0); ATT_PK4(p0, 8, pa1); ATT_PK4(p1, 0, pa2); ATT_PK4(p1, 8, pa3);
}
__device__ __forceinline__ void qkt(f32x16& p0, f32x16& p1, const LAS unsigned char* Kt, int r32, int hi, const bf16x8 (&qr)[8], const LAS float* tb) {
#pragma unroll
    for (int r = 0; r < 16; ++r) { p0[r] = tb[59 - ((r & 3) + 8 * (r >> 2))]; p1[r] = tb[27 - ((r & 3) + 8 * (r >> 2))]; }
    const LAS unsigned char* kb[4];
#pragma unroll
    for (int dd = 0; dd < 4; ++dd) kb[dd] = Kt + ATT_KSWZ(r32, (dd * 16 + hi * 8) * 2);
#pragma unroll
    for (int d0 = 0; d0 < 8; ++d0) { const LAS unsigned char* a = kb[d0 & 3] + (d0 >> 2) * 128;
        const bf16x8 b0 = *(const LAS bf16x8*)a;
        const bf16x8 b1 = *(const LAS bf16x8*)(a + 32 * 256);
        p0 = __builtin_amdgcn_mfma_f32_32x32x16_bf16(b0, qr[d0], p0, 0, 0, 0);
        p1 = __builtin_amdgcn_mfma_f32_32x32x16_bf16(b1, qr[d0], p1, 0, 0, 0); }
}
__device__ __forceinline__ void pv_tile(f32x16 (&o)[4], int vb, bf16x8 pa0, bf16x8 pa1, bf16x8 pa2, bf16x8 pa3) {
#define ATT_TRRD(dst, off) asm volatile("ds_read_b64_tr_b16 %0, %1 offset:%2" : "=&v"(dst) : "v"(vb), "i"(off) : "memory")
#define ATT_VLD(L, H, d0) do { constexpr int b_ = v_rd_off(d0, 0, 0); \
        ATT_TRRD(L[0], b_); ATT_TRRD(H[0], b_ + 2048); ATT_TRRD(L[1], b_ + 4096); ATT_TRRD(H[1], b_ + 6144); ATT_TRRD(L[2], b_ + 8192); ATT_TRRD(H[2], b_ + 10240); ATT_TRRD(L[3], b_ + 12288); ATT_TRRD(H[3], b_ + 14336); } while (0)
#define ATT_VF(L, H, k) (bf16x8){L[k][0], L[k][1], L[k][2], L[k][3], H[k][0], H[k][1], H[k][2], H[k][3]}
#define ATT_PVM(L, H, d0) do { \
        o[d0] = __builtin_amdgcn_mfma_f32_32x32x16_bf16(pa0, ATT_VF(L, H, 0), o[d0], 0, 0, 0); o[d0] = __builtin_amdgcn_mfma_f32_32x32x16_bf16(pa1, ATT_VF(L, H, 1), o[d0], 0, 0, 0); \
        o[d0] = __builtin_amdgcn_mfma_f32_32x32x16_bf16(pa2, ATT_VF(L, H, 2), o[d0], 0, 0, 0); o[d0] = __builtin_amdgcn_mfma_f32_32x32x16_bf16(pa3, ATT_VF(L, H, 3), o[d0], 0, 0, 0); } while (0)
    s16x4 la[4], ha[4], lb[4], hb[4];
    ATT_VLD(la, ha, 0);
    ATT_VLD(lb, hb, 1);
    asm volatile("s_waitcnt lgkmcnt(8)" ::: "memory"); ATT_SBAR();
    ATT_PVM(la, ha, 0); ATT_SBAR();
    ATT_VLD(la, ha, 2);
    asm volatile("s_waitcnt lgkmcnt(8)" ::: "memory"); ATT_SBAR();
    ATT_PVM(lb, hb, 1); ATT_SBAR();
    ATT_VLD(lb, hb, 3);
    asm volatile("s_waitcnt lgkmcnt(8)" ::: "memory"); ATT_SBAR();
    ATT_PVM(la, ha, 2); ATT_SBAR();
    asm volatile("s_waitcnt lgkmcnt(0)" ::: "memory"); ATT_SBAR();
    ATT_PVM(lb, hb, 3);
#undef ATT_PVM
#undef ATT_VF
#undef ATT_VLD
#undef ATT_TRRD
}
typedef short v4i16_t __attribute__((ext_vector_type(4)));
__device__ __forceinline__ s16x4 vtr(const LAS unsigned char* p) { return __builtin_bit_cast(s16x4, __builtin_amdgcn_ds_read_tr16_b64_v4i16((LAS v4i16_t*)p)); }
__device__ __forceinline__ void gather_half(f32x16& p, const LAS float* tb, int half) {
#pragma unroll
    for (int r = 0; r < 16; ++r) p[r] = tb[32 * half + ((r & 3) + 8 * (r >> 2))];
}
__device__ __forceinline__ void qk_mma(f32x16& p, const LAS unsigned char* Kt, int half, int r32, int hi, const bf16x8 (&qr)[8]) {
    const LAS unsigned char* kb[4];
#pragma unroll
    for (int dd = 0; dd < 4; ++dd) kb[dd] = Kt + half * 8192 + ATT_KSWZ(r32, (dd * 16 + hi * 8) * 2);
#pragma unroll
    for (int d0 = 0; d0 < 8; ++d0) p = __builtin_amdgcn_mfma_f32_32x32x16_bf16(*(const LAS bf16x8*)(kb[d0 & 3] + (d0 >> 2) * 128), qr[d0], p, 0, 0, 0);
}
__device__ __forceinline__ void qk_half(f32x16& p, const LAS unsigned char* Kt, int half, int r32, int hi, const bf16x8 (&qr)[8], const LAS float* tb) {
#pragma unroll
    for (int r = 0; r < 16; ++r) p[r] = tb[32 * half + ((r & 3) + 8 * (r >> 2))];
    const LAS unsigned char* kb[4];
#pragma unroll
    for (int dd = 0; dd < 4; ++dd) kb[dd] = Kt + half * 8192 + ATT_KSWZ(r32, (dd * 16 + hi * 8) * 2);
#pragma unroll
    for (int d0 = 0; d0 < 8; ++d0) p = __builtin_amdgcn_mfma_f32_32x32x16_bf16(*(const LAS bf16x8*)(kb[d0 & 3] + (d0 >> 2) * 128), qr[d0], p, 0, 0, 0);
}
__device__ __forceinline__ void exp_half(f32x16& p) {
#pragma unroll
    for (int r = 0; r < 16; ++r) p[r] = __builtin_amdgcn_exp2f(p[r]);
}
__device__ __forceinline__ bool partial_half(f32x16& p, float& m_reg, float& mthr, float& alpha) {
    float pmax = p[0];
#pragma unroll
    for (int r = 1; r < 16; ++r) pmax = fmaxf(pmax, p[r]);
    { auto rr = __builtin_amdgcn_permlane32_swap(__float_as_uint(pmax), __float_as_uint(pmax), false, false);
      pmax = fmaxf(__uint_as_float(rr[0]), __uint_as_float(rr[1])); }
    bool moved = false;
    if (__builtin_expect(!__all(pmax <= mthr), 0)) { const float mn = fmaxf(m_reg, pmax); alpha = __builtin_amdgcn_exp2f(m_reg - mn); m_reg = mn; mthr = mn + THR2; moved = true; }
#pragma unroll
    for (int r = 0; r < 16; ++r) p[r] = __builtin_amdgcn_exp2f(p[r] - m_reg);
    return moved;
}
__device__ __forceinline__ void finish_half(const f32x16& p, float& l_reg, bf16x8& pa0, bf16x8& pa1) {
    float ps = p[0];
#pragma unroll
    for (int r = 1; r < 16; ++r) ps += p[r];
    { auto rr = __builtin_amdgcn_permlane32_swap(__float_as_uint(ps), __float_as_uint(ps), false, false);
      ps = __uint_as_float(rr[0]) + __uint_as_float(rr[1]); }
    l_reg += ps;
    ATT_PK4(p, 0, pa0); ATT_PK4(p, 8, pa1);
}
template <int HALF>
__device__ __forceinline__ void pv_half(f32x16 (&o)[4], int vb, bf16x8 pa0, bf16x8 pa1) {
#define ATT_TRRD(dst, off) asm volatile("ds_read_b64_tr_b16 %0, %1 offset:%2" : "=&v"(dst) : "v"(vb), "i"(off) : "memory")
#define ATT_VLD2(L0, H0, L1, H1, d0) do { constexpr int b_ = (d0) * 512 + HALF * 8192; ATT_TRRD(L0, b_); ATT_TRRD(H0, b_ + 2048); ATT_TRRD(L1, b_ + 4096); ATT_TRRD(H1, b_ + 6144); } while (0)
#define ATT_VF(L, H) (bf16x8){L[0], L[1], L[2], L[3], H[0], H[1], H[2], H[3]}
    s16x4 a0, a1, a2, a3, b0, b1, b2, b3, c0, c1, c2, c3, d0_, d1_, d2_, d3_;
    ATT_VLD2(a0, a1, a2, a3, 0); ATT_VLD2(b0, b1, b2, b3, 1); ATT_VLD2(c0, c1, c2, c3, 2); ATT_VLD2(d0_, d1_, d2_, d3_, 3);
    asm volatile("s_waitcnt lgkmcnt(8)" ::: "memory"); ATT_SBAR();
    o[0] = __builtin_amdgcn_mfma_f32_32x32x16_bf16(pa0, ATT_VF(a0, a1), o[0], 0, 0, 0); o[0] = __builtin_amdgcn_mfma_f32_32x32x16_bf16(pa1, ATT_VF(a2, a3), o[0], 0, 0, 0);
    o[1] = __builtin_amdgcn_mfma_f32_32x32x16_bf16(pa0, ATT_VF(b0, b1), o[1], 0, 0, 0); o[1] = __builtin_amdgcn_mfma_f32_32x32x16_bf16(pa1, ATT_VF(b2, b3), o[1], 0, 0, 0);
    ATT_SBAR(); asm volatile("s_waitcnt lgkmcnt(0)" ::: "memory"); ATT_SBAR();
    o[2] = __builtin_amdgcn_mfma_f32_32x32x16_bf16(pa0, ATT_VF(c0, c1), o[2], 0, 0, 0); o[2] = __builtin_amdgcn_mfma_f32_32x32x16_bf16(pa1, ATT_VF(c2, c3), o[2], 0, 0, 0);
    o[3] = __builtin_amdgcn_mfma_f32_32x32x16_bf16(pa0, ATT_VF(d0_, d1_), o[3], 0, 0, 0); o[3] = __builtin_amdgcn_mfma_f32_32x32x16_bf16(pa1, ATT_VF(d2_, d3_), o[3], 0, 0, 0);
#undef ATT_VF
#undef ATT_VLD2
#undef ATT_TRRD
}
__device__ __forceinline__ void dma16(const void* g, LAS unsigned char* l) { __builtin_amdgcn_global_load_lds((const unsigned*)g, (LAS unsigned*)l, 16, 0, 0); }
template <class U>
__device__ __forceinline__ void dma_tile(LAS unsigned char* lds, const U& u, int t, int kb, int vs, int lane, int wid) {
    int l_ = lane; asm volatile("" : "+v"(l_));
    const int kkey0 = 8 * wid + (l_ >> 4), kkey1 = kkey0 + 4;
    const int kc0 = ((l_ & 15) ^ (kkey0 & 7)) * 8, kc1 = ((l_ & 15) ^ (kkey1 & 7)) * 8;
    const int vkk = 8 * wid + ((l_ & 31) >> 2), vkey = (vkk & ~0xC) | ((vkk & 4) << 1) | ((vkk & 8) >> 1);
    const int vc0 = 32 * (l_ >> 5) + 8 * (l_ & 3), vc1 = vc0 + 64;
    const int ro0 = u.rowoff(t, kkey0), ro1 = u.rowoff(t, kkey1), rov = u.rowoff(t, vkey);
    LAS unsigned char* kdst = lds + L_K + wid * 2048 + kb * SHM_K; LAS unsigned char* vdst = lds + L_V + wid * 2048 + vs * SHM_V;
    dma16(u.K + ro0 + kc0, kdst); dma16(u.K + ro1 + kc1, kdst + 1024);
    dma16(u.V + rov + vc0, vdst); dma16(u.V + rov + vc1, vdst + 1024);
}
template <class U>
__device__ __forceinline__ void dma_tile_u(LAS unsigned char* lds, const U& u, int t, int kb, int vs, unsigned kof0, unsigned kof1, unsigned vof, int wid) {
    const int tb = __builtin_amdgcn_readfirstlane(u.rowoff(t, 0));
    const char* kbase = (const char*)(u.K + tb); const char* vbase = (const char*)(u.V + tb);
    LAS unsigned char* kdst = lds + L_K + wid * 2048 + kb * SHM_K; LAS unsigned char* vdst = lds + L_V + wid * 2048 + vs * SHM_V;
    dma16(kbase + kof0, kdst); dma16(kbase + kof1, kdst + 1024);
    dma16(vbase + vof, vdst); dma16(vbase + vof + 128, vdst + 1024);
}
template <bool FAST, class U>
__device__ __forceinline__ void flash_impl(LAS unsigned char* lds, const U& u, const bf16x8 (&qr)[8], f32x16 (&o)[4], float& m_reg, float& l_reg, int tid, int lane, int wid, bool tile0_issued) {
    const int r32 = lane & 31, hi = lane >> 5;
    u.reset();
    const int vp0 = L_V + v_rd_base(lane);
    LAS float* al_l = (LAS float*)(lds + L_WS) + wid * 64 + 32;
    const int NT = u.nt();
    unsigned kof0, kof1, vof;
    { const int rs = u.rs(), kkey0 = 8 * wid + (lane >> 4), kc0 = ((lane & 15) ^ (kkey0 & 7)) * 8;
      const int vkk = 8 * wid + ((lane & 31) >> 2), vkey = (vkk & ~0xC) | ((vkk & 4) << 1) | ((vkk & 8) >> 1), vc0 = 32 * (lane >> 5) + 8 * (lane & 3);
      kof0 = (unsigned)(kkey0 * rs + kc0) * 2u; kof1 = (unsigned)((kkey0 + 4) * rs + (kc0 ^ 32)) * 2u; vof = (unsigned)(vkey * rs + vc0) * 2u; }
#define ATT_DMA(t_, kb_, vs_) dma_tile_u(lds, u, t_, kb_, vs_, kof0, kof1, vof, wid)
#define ATT_RESC(a) do { l_reg *= (a); if (hi == 0) al_l[r32] = (a); asm volatile("s_waitcnt lgkmcnt(0)" ::: "memory"); \
        _Pragma("unroll") for (int d_ = 0; d_ < 4; ++d_) _Pragma("unroll") for (int r = 0; r < 16; ++r) o[d_][r] *= al_l[crow(r, hi)]; } while (0)
    f32x16 pA, pB; float alp = 1.f; bf16x8 pa0, pa1;
    float mthr = m_reg + THR2;
    bool actP = false;
    int ks_cur = 0, ks_n1 = 1, ks_n2 = 2;
    int vs_prev = 3, vs_cur = 0, vs_n1 = 1, vs_n2 = 2;
    if (!tile0_issued) ATT_DMA(0, 0, 0);
    if (NT > 1) ATT_DMA(1, 1, 1);
    for (int t = 0; t < NT; ++t) {
        if (t + 1 < NT) asm volatile("s_waitcnt vmcnt(4) lgkmcnt(0)" ::: "memory"); else asm volatile("s_waitcnt vmcnt(0) lgkmcnt(0)" ::: "memory");
        __builtin_amdgcn_s_barrier(); asm volatile("" ::: "memory");
        const bool actC = u.act(t);
        const LAS unsigned char* Kt = lds + L_K + ks_cur * SHM_K; const LAS float* tb = u.tbl(t); asm volatile("" : "+v"(tb));
        if (actC) gather_half(pA, tb, 0);
        if (t + 2 < NT) ATT_DMA(t + 2, ks_n2, vs_n2);
        ATT_SBAR();
        if (actC) qk_mma(pA, Kt, 0, r32, hi, qr);
        if (actP) finish_half(pB, l_reg, pa0, pa1);
        if (actP) pv_half<1>(o, vp0 + vs_prev * SHM_V, pa0, pa1);
        if (actC) { if constexpr (FAST) exp_half(pA); else { if (partial_half(pA, m_reg, mthr, alp)) ATT_RESC(alp); } }
        ATT_SBAR();
        if (actC) { qk_half(pB, Kt, 1, r32, hi, qr, tb);
            finish_half(pA, l_reg, pa0, pa1);
            pv_half<0>(o, vp0 + vs_cur * SHM_V, pa0, pa1);
            if constexpr (FAST) exp_half(pB); else { if (partial_half(pB, m_reg, mthr, alp)) ATT_RESC(alp); } }
        actP = actC;
        { const int tk_ = ks_cur; ks_cur = ks_n1; ks_n1 = ks_n2; ks_n2 = tk_; }
        { const int tv_ = vs_prev; vs_prev = vs_cur; vs_cur = vs_n1; vs_n1 = vs_n2; vs_n2 = tv_; }
    }
    if (actP) { finish_half(pB, l_reg, pa0, pa1); pv_half<1>(o, vp0 + vs_prev * SHM_V, pa0, pa1); }
    if constexpr (FAST) {
#ifdef ATT_FORCE_FALLBACK
        const bool bad = true;
#else
        const bool bad = !(l_reg > 0.f && l_reg < 1.2676506e30f);
#endif
        if (__any(bad) && lane == 0) *(volatile LAS unsigned*)(lds + L_FLAG) = 1u;
    }
    asm volatile("s_waitcnt vmcnt(0) lgkmcnt(0)" ::: "memory");
    __syncthreads();
#undef ATT_RESC
#undef ATT_DMA
}
template <class U>
__device__ __forceinline__ void flash_tiles(LAS unsigned char* lds, const U& u, const bf16x8 (&qr)[8], f32x16 (&o)[4], float& m_reg, float& l_reg, int tid, int lane, int wid, bool tile0_issued = false) {
    if (tid == 0) *(volatile LAS unsigned*)(lds + L_FLAG) = 0u;
    m_reg = 0.f;
    flash_impl<true>(lds, u, qr, o, m_reg, l_reg, tid, lane, wid, tile0_issued);
    if (__builtin_expect(*(volatile LAS unsigned*)(lds + L_FLAG) != 0u, 0)) {
#pragma unroll
        for (int d_ = 0; d_ < 4; ++d_)
#pragma unroll
            for (int r = 0; r < 16; ++r) o[d_][r] = 0.f;
        m_reg = -1e30f; l_reg = 0.f;
        flash_impl<false>(lds, u, qr, o, m_reg, l_reg, tid, lane, wid, false);
    }
}
template <class F>
__device__ __forceinline__ void emit(LAS unsigned char* lds, const f32x16 (&o)[4], float l_reg, int lane_in, int wid, const F& f, int stg_off = 0) {
    int lane = lane_in; asm volatile("" : "+v"(lane));
    const int r32 = lane & 31, hi = lane >> 5;
    LAS float* li_l = (LAS float*)(lds + L_WS) + wid * 64;
    if (hi == 0) li_l[r32] = (l_reg > 0.f ? frcp(l_reg) : 0.f) * f.rowscale(r32);
    asm volatile("s_waitcnt lgkmcnt(0)" ::: "memory");
    float rli[16];
#pragma unroll
    for (int r = 0; r < 16; ++r) rli[r] = li_l[crow(r, hi)];
    LAS float* stg = (LAS float*)(lds + stg_off + wid * 8192);
#pragma unroll
    for (int hf = 0; hf < 2; ++hf) {
#pragma unroll
        for (int r = 0; r < 16; ++r) { const int row = crow(r, hi);
            stg[row * 64 + r32] = o[2 * hf][r] * rli[r]; stg[row * 64 + 32 + r32] = o[2 * hf + 1][r] * rli[r]; }
        asm volatile("s_waitcnt lgkmcnt(0)" ::: "memory");
        {
            typename F::Ld ld[4];
#pragma unroll
            for (int i = 0; i < 4; ++i) { const int idx = i * 64 + lane; ld[i] = f.load(idx >> 3, hf * 64 + (idx & 7) * 8); }
#pragma unroll
            for (int i = 0; i < 4; ++i) { const int idx = i * 64 + lane, row = idx >> 3, c8 = (idx & 7) * 8;
                const f32x4 v0 = *(const LAS f32x4*)(stg + row * 64 + c8), v1 = *(const LAS f32x4*)(stg + row * 64 + c8 + 4); f.store(row, hf * 64 + c8, v0, v1, ld[i]); }
        }
        asm volatile("s_waitcnt lgkmcnt(0)" ::: "memory");
    }
    __syncthreads();
}
}

struct DilU {
    const bf16_t* K; const bf16_t* V;
    int d, m16, lbase, res, jlo, ntl, lw0, wsel, lane_off;
    const LAS float* T;
    __device__ __forceinline__ int nt() const { return ntl; }
    __device__ __forceinline__ int rs() const { return d * HD; }
    __device__ __forceinline__ void reset() const {}
    __device__ __forceinline__ void tile(int t, int& lk0, int& rt, int& jj) const { const int j = jlo + t; jj = j; if (!m16) { lk0 = lbase + 64 * j; rt = res; } else { lk0 = 64 * (j & 1); rt = res + (j >> 1); } }
    __device__ __forceinline__ int rowoff(int t, int key) const { int lk0, rt, jj; tile(t, lk0, rt, jj); return ((lk0 + key) * d + rt) * HD; }
    __device__ __forceinline__ bool act(int t) const { int lk0, rt, jj; tile(t, lk0, rt, jj);
        return m16 ? ((jj >> 1) == wsel && lk0 <= lw0 + 31) : (lk0 <= lw0 + 31 && lk0 + 63 >= lw0 - 128); }
    __device__ __forceinline__ const LAS float* tbl(int t) const { int lk0, rt, jj; tile(t, lk0, rt, jj); return T + (260 - (lw0 - lk0 + lane_off)); }
};

struct DilStoreF {
    static constexpr int BATCH = 8;
    bf16_t* base; int rstride;
    struct Ld { };
    __device__ __forceinline__ float rowscale(int) const { return 1.f; }
    __device__ __forceinline__ Ld load(int, int) const { return Ld{}; }
    __device__ __forceinline__ void store(int row, int col, att::f32x4 v, att::f32x4 w, const Ld&) const {
        *(uint4*)(base + (size_t)row * rstride + col) = make_uint4(pg8::cvt_pk_bf16(v[0], v[1]), pg8::cvt_pk_bf16(v[2], v[3]), pg8::cvt_pk_bf16(w[0], w[1]), pg8::cvt_pk_bf16(w[2], w[3])); }
};

struct DilMergeF {
    const bf16_t* o2; const bf16_t* o3; const bf16_t* z; bf16_t* a0;
    float l2v, l3v;
    const LAS float* lse1;
    LAS float* w23;
    static constexpr int BATCH = 4;
    struct Ld { uint4 o2, o3, z; };
    __device__ __forceinline__ float rowscale(int row) const {
        const float l1 = lse1[row], l2 = l2v, l3 = l3v; const float mx = fmaxf(l1, fmaxf(l2, l3));
        float w1 = __expf(l1 - mx), w2 = __expf(l2 - mx), w3 = __expf(l3 - mx); const float inv = frcp(w1 + w2 + w3);
        w23[row] = w2 * inv; w23[32 + row] = w3 * inv; return w1 * inv; }
    __device__ __forceinline__ Ld load(int row, int col) const { Ld l; const size_t e = (size_t)row * DM + col;
        l.o2 = ldnt4u((const uint4*)(o2 + e)); l.o3 = ldnt4u((const uint4*)(o3 + e)); l.z = ldnt4u((const uint4*)(z + e)); return l; }
    __device__ __forceinline__ unsigned mix2(float va, float vb, float w2, float w3, unsigned p2, unsigned p3, unsigned pz) const {
        return pg8::cvt_pk_bf16((va + w2 * bflo(p2) + w3 * bflo(p3)) * silu(bflo(pz)), (vb + w2 * bfhi(p2) + w3 * bfhi(p3)) * silu(bfhi(pz))); }
    __device__ __forceinline__ void store(int row, int col, att::f32x4 v, att::f32x4 u, const Ld& l) const {
        const float w2 = w23[row], w3 = w23[32 + row];
        *(uint4*)(a0 + (size_t)row * DM + col) = make_uint4(mix2(v[0], v[1], w2, w3, l.o2.x, l.o3.x, l.z.x), mix2(v[2], v[3], w2, w3, l.o2.y, l.o3.y, l.z.y),
                                                            mix2(u[0], u[1], w2, w3, l.o2.z, l.o3.z, l.z.z), mix2(u[2], u[3], w2, w3, l.o2.w, l.o3.w, l.z.w));
    }
};

struct DilCtx { DilU U; int pat, h, d, grow_l, rbase; };
template <int PASS>
__device__ __forceinline__ void dil_setup(int ui, DilCtx& c, LAS float* T, const bf16_t* qkvA, const float* table, int tid, int lane, int wave) {
    const int r32 = lane & 31, hi = lane >> 5;
    int bh, kk;
    if (PASS == 0) { bh = ui >> 4; const int w = ui & 15; kk = (w & 1) * 8 + (w >> 1); } else { bh = ui >> 3; kk = ui & 7; }
    const int pat = PASS ? 0 : 1 + (kk >> 3), idx = kk & 7, b = bh >> 4, h = bh & 15;
    const int d = pat == 0 ? 1 : (pat == 1 ? 4 : 16);
    DilU& U = c.U; U.d = d; U.m16 = (pat == 2); U.T = T; U.lane_off = r32 - 4 * hi + 37;
    int rw;
    if (pat == 2) { U.res = 2 * idx; U.lbase = 0; U.jlo = 0; U.ntl = 4; U.lw0 = 32 * (wave & 3); U.wsel = wave >> 2; rw = 2 * idx + (wave >> 2); }
    else { const int mm = (pat == 0) ? idx : (idx & 1); U.res = (pat == 0) ? 0 : (idx >> 1); U.lbase = 256 * mm - 128; U.jlo = (mm == 0) ? 2 : 0; U.ntl = 6 - U.jlo; U.lw0 = 256 * mm + 32 * wave; U.wsel = 0; rw = U.res; }
    U.K = qkvA + ((size_t)(16 + h) * MTOK + b * SEQ) * HD; U.V = qkvA + ((size_t)(32 + h) * MTOK + b * SEQ) * HD;
    if (tid < 320) { const int delta = tid - 96; T[319 - tid] = (delta >= 0 && delta <= 128) ? table[rel_bucket(delta * d) * NH + h] * att::LOG2E : -__builtin_inff(); }
    c.pat = pat; c.h = h; c.d = d; c.grow_l = b * SEQ + (U.lw0 + r32) * d + rw; c.rbase = b * SEQ + U.lw0 * d + rw;
}
template <int PASS>
__device__ __forceinline__ void dil_phase(LAS unsigned char* lds, int G, unsigned char* dob, unsigned char* ws, const bf16_t* qkvA, const bf16_t* zA, bf16_t* a0, const float* table) {
    int tid = threadIdx.x; asm volatile("" : "+v"(tid)); const int lane = tid & 63, wave = __builtin_amdgcn_readfirstlane(tid >> 6);
    bf16_t* op1 = (bf16_t*)(dob); bf16_t* op2 = (bf16_t*)(dob + 32 * MiB);
    float* lseb = (float*)(ws + WS_SSQ0);
    const int r32 = lane & 31, hi = lane >> 5;
    const int vcu = (G % 8 == 0) ? ((int)blockIdx.x % 8) * (G / 8) + (int)blockIdx.x / 8 : (int)blockIdx.x;
    constexpr int upb = PASS ? 8 : 16, NU = 64 * upb; const int per = (NU + G - 1) / G;
    const int ui0 = vcu * per, ui1 = (ui0 + per < NU) ? ui0 + per : NU;
    if (ui0 >= ui1) return;
    DilCtx cur; att::bf16x8 qn[8];
    dil_setup<PASS>(ui0, cur, (LAS float*)(lds + att::L_TBL), qkvA, table, tid, lane, wave);
    { const bf16_t* qp = qkvA + ((size_t)cur.h * MTOK + cur.grow_l) * HD + hi * 8;
#pragma unroll
      for (int d0 = 0; d0 < 8; ++d0) qn[d0] = *(const att::bf16x8*)(qp + d0 * 16); }
    att::dma_tile(lds, cur.U, 0, 0, 0, lane, wave);
    for (int ui = ui0; ui < ui1; ++ui) {
        att::bf16x8 qr[8];
#pragma unroll
        for (int d0 = 0; d0 < 8; ++d0) qr[d0] = qn[d0];
        att::f32x16 o[4];
#pragma unroll
        for (int d_ = 0; d_ < 4; ++d_)
#pragma unroll
            for (int r = 0; r < 16; ++r) o[d_][r] = 0.f;
        float m_reg = -1e30f, l_reg = 0.f;
        float pl2 = 0.f, pl3 = 0.f;
        if constexpr (PASS == 1) { pl2 = lseb[((size_t)1 * MTOK + cur.rbase + r32) * NH + cur.h]; pl3 = lseb[((size_t)2 * MTOK + cur.rbase + r32) * NH + cur.h]; }
        att::flash_tiles(lds, cur.U, qr, o, m_reg, l_reg, tid, lane, wave, true);
        const float lse = m_reg * att::LN2 + __logf(l_reg);
        if constexpr (PASS == 0) {
            if (hi == 0) lseb[((size_t)cur.pat * MTOK + cur.grow_l) * NH + cur.h] = lse;
            bf16_t* opp = (cur.pat == 1 ? op1 : op2) + cur.h * HD;
            att::emit(lds, o, l_reg, lane, wave, DilStoreF{opp + (size_t)cur.rbase * DM, cur.d * DM});
        } else {
            LAS float* l1s = (LAS float*)(lds + att::L_WS) + wave * 64 + 32;
            if (hi == 0) l1s[r32] = lse;
            const size_t e0 = (size_t)cur.rbase * DM + cur.h * HD;
            att::emit(lds, o, l_reg, lane, wave, DilMergeF{op1 + e0, op2 + e0, zA + e0, a0 + e0, pl2, pl3, l1s, (LAS float*)(lds + att::L_TBL + 4096) + wave * 64});
        }
        DilCtx nxt = cur; const bool has = ui + 1 < ui1;
        if (has) {
            dil_setup<PASS>(ui + 1, nxt, (LAS float*)(lds + att::L_TBL + (((ui + 1 - ui0) & 1) ? 2048 : 0)), qkvA, table, tid, lane, wave);
            const bf16_t* qp = qkvA + ((size_t)nxt.h * MTOK + nxt.grow_l) * HD + hi * 8;
#pragma unroll
            for (int d0 = 0; d0 < 8; ++d0) qn[d0] = *(const att::bf16x8*)(qp + d0 * 16);
            att::dma_tile(lds, nxt.U, 0, 0, 0, lane, wave);
        }
        cur = nxt;
    }
}

constexpr int L_TSEL = att::L_TBL, L_TWIN = L_TSEL + 4 * 2112 * 4, L_SELM = L_TWIN + 4 * 640 * 4, L_TL = L_SELM + 256;
constexpr int L_TAB4 = L_TL + 256;
constexpr int L_IMPH = att::L_V + 2 * att::SHM_V;
static_assert(L_TAB4 + 512 <= 163840 - 64, "LDS map");
struct SelU {
    const bf16_t* K; const bf16_t* V;
    unsigned un; mutable unsigned rd, ra, rt; int ntl; unsigned mymask; int tq_off;
    __device__ __forceinline__ void reset() const { rd = un; ra = un; rt = un; }
    const LAS float* T;
    __device__ __forceinline__ int nt() const { return ntl; }
    __device__ __forceinline__ int rs() const { return HD; }
    __device__ __forceinline__ int rowoff(int, int key) const { const int n = __builtin_ctz(rd); rd &= rd - 1u; return (64 * n + key) * HD; }
    __device__ __forceinline__ bool act(int) const { const int n = __builtin_ctz(ra); ra &= ra - 1u; return __any((mymask >> n) & 1u); }
    __device__ __forceinline__ const LAS float* tbl(int) const { const int n = __builtin_ctz(rt); rt &= rt - 1u; int idx = ((mymask >> n) & 1u) ? 2052 - tq_off + 64 * n : 2052; asm volatile("" : "+v"(idx)); return T + idx; }
};
struct WinU {
    const bf16_t* K; const bf16_t* V;
    int tk_base, ntl, tq_off;
    __device__ __forceinline__ void reset() const {}
    const LAS float* T;
    __device__ __forceinline__ int nt() const { return ntl; }
    __device__ __forceinline__ int rs() const { return HD; }
    __device__ __forceinline__ int rowoff(int t, int key) const { return (tk_base + 64 * t + key) * HD; }
    __device__ __forceinline__ bool act(int) const { return true; }
    __device__ __forceinline__ const LAS float* tbl(int t) const { return T + (580 - tq_off + tk_base + 64 * t); }
};
struct GateF {
    const bf16_t* zrow; float gs; bf16_t* arow;
    int first;
    static constexpr int BATCH = 8;
    struct Ld { uint4 z, a; };
    __device__ __forceinline__ float rowscale(int) const { return gs; }
    __device__ __forceinline__ Ld load(int row, int col) const { Ld l; l.z = ldnt4u((const uint4*)(zrow + (size_t)row * 6144 + col));
        l.a = first ? make_uint4(0u, 0u, 0u, 0u) : *(const uint4*)(arow + (size_t)row * DM + col); return l; }
    __device__ __forceinline__ unsigned gate2(float va, float vb, unsigned pz, unsigned pa) const { return pg8::cvt_pk_bf16(va * silu(bflo(pz)) + bflo(pa), vb * silu(bfhi(pz)) + bfhi(pa)); }
    __device__ __forceinline__ void store(int row, int col, att::f32x4 v, att::f32x4 u, const Ld& l) const {
        *(uint4*)(arow + (size_t)row * DM + col) = make_uint4(gate2(v[0], v[1], l.z.x, l.a.x), gate2(v[2], v[3], l.z.y, l.a.y), gate2(u[0], u[1], l.z.z, l.a.z), gate2(u[2], u[3], l.z.w, l.a.w));
    }
};

constexpr int I_B = 32 * (NWB / 64), WB_P0 = I_B;
__device__ __forceinline__ TItem decode_wb(int r) {
    const float* const* ka = (const float* const*)__builtin_amdgcn_kernarg_segment_ptr();
    const float* norm_pre = ka[1]; const float* kv_norm = ka[6]; const float* w_kv = ka[7]; const float* w_in_b = ka[14];
    bf16_t* WB_t = (bf16_t*)(((unsigned char* const*)ka)[17] + WS_WB);
    const int kb = r / (NWB / 64), nb = r % (NWB / 64); const int n0 = nb * 64;
    if (n0 < 8192) return TItem{w_in_b, norm_pre + DM, WB_t, 8240, n0, 8240, kb * 64, DM, n0, n0 < 2048 ? QSC : 1.f};
    if (n0 < 11264) return TItem{w_kv, kv_norm, WB_t, 3072, n0 - 8192, 3072, kb * 64, DM, n0, 1.f};
    return TItem{w_in_b, norm_pre + DM, WB_t, 8240, 8192 + (n0 - 11264), 8240, kb * 64, DM, n0, 1.f};
}
__device__ __forceinline__ void wbt_under(LAS unsigned char* lds, int G, int slot0, int lo, int hi) {
    int tid = threadIdx.x; asm volatile("" : "+v"(tid)); const int lane = tid & 63, wave = __builtin_amdgcn_readfirstlane(tid >> 6);
    LAS float* scr64 = (LAS float*)(lds + wave * 20480);
    for (int it = lo + (int)blockIdx.x * 7 + wave - 1 - slot0; it >= lo && it < hi; it += G * 7) { const TItem ta = decode_wb(it); float va[64]; titem_load64(ta, va, lane); titem_store64(ta, va, scr64, lane); }
}

constexpr int NWAVES = 8, NTHREADS = 512;
#ifndef REP_P2
#define REP_P2 1
#endif
#ifndef REP_P7
#define REP_P7 1
#endif
#ifndef REP_P1
#define REP_P1 1
#endif
#ifndef REP_EW
#define REP_EW 1
#endif
#ifndef REP_G2
#define REP_G2 1
#endif
#ifndef REP_FD
#define REP_FD 1
#endif
#ifndef REP_F7
#define REP_F7 1
#endif
#ifndef REP_P5
#define REP_P5 1
#endif
#ifndef REP_P0
#define REP_P0 1
#endif
constexpr int LDS_BYTES = 163840;

__global__ void __launch_bounds__(NTHREADS, 2) yoco_fwd(Params p) {
    extern __shared__ __attribute__((aligned(16))) unsigned char lds_raw[];
    LAS unsigned char* lds = (LAS unsigned char*)lds_raw;
    cg::grid_group grid = cg::this_grid();
    const int G = gridDim.x, NGW = G * NWAVES;
    { volatile LAS unsigned* st = (volatile LAS unsigned*)(lds + LDS_BYTES - 64); if (threadIdx.x == 0) { st[0] = 0u; st[1] = 0u; st[3] = 0u; } __syncthreads(); }
    XcdBarrier bar = xcd_barrier_post((unsigned*)(p.ws + WS_BAR), (volatile LAS unsigned*)(lds + LDS_BYTES - 64));
#define PHASE_VARS int tid = threadIdx.x; asm volatile("" : "+v"(tid)); const int lane = tid & 63, wave = __builtin_amdgcn_readfirstlane(tid >> 6), gw = blockIdx.x * NWAVES + wave; (void)lane; (void)gw;
    unsigned char* ws = p.ws; unsigned char* dob = (unsigned char*)p.out;
    const float* x = p.in[0]; const float* norm_pre = p.in[1]; const float* norm_post = p.in[2]; const float* table = p.in[3];
    const float* w_in_a = p.in[4]; const float* w_out_a = p.in[5]; const float* kv_norm = p.in[6]; const float* w_kv = p.in[7];
    const float* pos_k = p.in[8]; const float* pos_v = p.in[9]; const float* w1k = p.in[10]; const float* w2k = p.in[11];
    const float* w1v = p.in[12]; const float* w2v = p.in[13]; const float* w_in_b = p.in[14]; const float* w_out_b = p.in[15];
    bf16_t* WA_t = (bf16_t*)(ws + WS_B); bf16_t* WoA_t = (bf16_t*)(ws + WS_WOA); bf16_t* WB_t = (bf16_t*)(ws + WS_WB); bf16_t* WoB_t = (bf16_t*)(ws + WS_WOB);
    bf16_t* xhat0 = (bf16_t*)(dob + DO_XHAT0);
    bf16_t* qkvA = (bf16_t*)(ws + WS_QKVA); bf16_t* zA = (bf16_t*)(ws + WS_ZA); bf16_t* a0 = (bf16_t*)(ws + WS_B);
    bf16_t* y0b = (bf16_t*)(ws + WS_Y0); float* ssq0 = (float*)(ws + WS_SSQ0); float* ssq1 = (float*)(ws + WS_SSQ1); float* rstd0 = (float*)(ws + WS_RSTD0);
    bf16_t* xhat1 = (bf16_t*)(ws + WS_B); bf16_t* qB = (bf16_t*)(ws + WS_QB); bf16_t* zB = (bf16_t*)(ws + WS_ZB);
    bf16_t* kvb = (bf16_t*)(dob + DO_KVB); bf16_t* gB = (bf16_t*)(dob + DO_GB); bf16_t* kcmp = (bf16_t*)(dob + DO_KCMP); bf16_t* vcmp = (bf16_t*)(dob + DO_VCMP);
    bf16_t* a1 = (bf16_t*)(ws + WS_B); bf16_t* y1b = (bf16_t*)(ws + WS_Y1);
    float* posvec = (float*)(ws + WS_RSTD0 + 65536); bf16_t* W1t = (bf16_t*)(dob + 54 * MiB); bf16_t* cpart = (bf16_t*)(ws + WS_WOA);
    unsigned* cpcnt = (unsigned*)(ws + WS_BAR) + 3648;
    unsigned* kvcnt = (unsigned*)(ws + WS_BAR) + 3584;

    for (int rep = 0; rep < REP_P0; ++rep) {
        PHASE_VARS
        LAS float* scr = (LAS float*)(lds + wave * 16384);
        constexpr int I_A = 32 * 128;
        constexpr int NIT = I_A + (I_B - WB_P0);
        auto decode = [&](int it) -> TItem {
            int r = it;
            if (r < I_A) { const int kb = r / 128, nb = r % 128; return TItem{w_in_a, norm_pre, WA_t, 8192, nb * 64, 8192, kb * 64, DM, nb * 64, nb < 32 ? QSC : 1.f}; } r -= I_A;
            return decode_wb(WB_P0 + r);
        };
        LAS float* scr64 = (LAS float*)(lds + wave * 20480);
        for (int it = gw; it < NIT; it += 2 * NGW) {
            const TItem ta = decode(it); const bool hasb = it + NGW < NIT; const TItem tb = decode(hasb ? it + NGW : it);
            float va[64], vb[64];
            titem_load64(ta, va, lane); if (hasb) titem_load64(tb, vb, lane);
            titem_store64(ta, va, scr64, lane); if (hasb) titem_store64(tb, vb, scr64, lane);
        }
        for (int m = gw; m < MTOK; m += NGW) rms_row_bf16(x + (size_t)m * DM, xhat0 + (size_t)m * DM, lane);
    }
    if (__builtin_expect(G > 65535, 0)) grid.sync();
    xcd_barrier(bar, [&]() { int tid = threadIdx.x; asm volatile("" : "+v"(tid)); const int lane = tid & 63, wave = __builtin_amdgcn_readfirstlane(tid >> 6);
        for (int it = (int)blockIdx.x * 7 + wave - 1; it < 2048; it += G * 7) {
            const int q = it >> 9, sec = (it >> 8) & 1, n = it & 255; const float* pos = (sec ? pos_v : pos_k) + q * 1024 + lane; const float* w1 = (sec ? w1v : w1k) + (size_t)(q * 1024 + lane) * 256 + n;
            float pv[16], wv[16];
#pragma unroll
            for (int j = 0; j < 16; ++j) { pv[j] = pos[64 * j]; wv[j] = w1[(size_t)64 * j * 256]; }
            float a = 0.f;
#pragma unroll
            for (int j = 0; j < 16; ++j) a += pv[j] * wv[j];
            a = wave_sum(a); if (lane == 0) posvec[it] = a;
        }
        wbt_under(lds, G, 1152, 5120, 5760);
    });
    for (int rep = 0; rep < REP_P1; ++rep) {
        pg8::Gemm g{xhat0, WA_t, MTOK, 8192, DM, DM, DM}; pg8::P1Aff S; S.init(MTOK, 8192, G, (int)blockIdx.x);
        pg8::EpiK<1> E{qkvA, zA};
        pg8::gemm_phase<pg8::EpiK<1>, pg8::P1Aff, true, true>(lds, g, S, E);
    }
    xcd_barrier(bar, [&]() { int tid = threadIdx.x; asm volatile("" : "+v"(tid)); const int lane = tid & 63, wave = __builtin_amdgcn_readfirstlane(tid >> 6);
        LAS float* scr64 = (LAS float*)(lds + wave * 20480);
        for (int it = (int)blockIdx.x * 7 + wave - 1; it < 1024; it += G * 7) {
            const TItem ta{w_out_a, nullptr, WoA_t, 2048, (it & 31) * 64, 2048, (it >> 5) * 64, DM, (it & 31) * 64, 1.f};
            float va[64]; titem_load64(ta, va, lane); titem_store64(ta, va, scr64, lane); }
        wbt_under(lds, G, 1024, 0, 768); });
    dil_phase<0>(lds, G, dob, ws, qkvA, zA, a0, table);
    xcd_barrier(bar, [&]() { wbt_under(lds, G, 0, 768, 2560); });
    dil_phase<1>(lds, G, dob, ws, qkvA, zA, a0, table);
    xcd_barrier(bar, [&]() { wbt_under(lds, G, 0, 2560, 4352); });
    for (int rep = 0; rep < REP_G2; ++rep) {
        pg8::Gemm g{a0, WoA_t, MTOK, DM, DM, DM, DM}; pg8::OutOrder S; S.init(MTOK, DM, G, (int)blockIdx.x);
        pg8::EpiK<2> E{y0b, (bf16_t*)ssq0};
        pg8::gemm_phase<pg8::EpiK<2>, pg8::OutOrder, true, true>(lds, g, S, E);
    }
    xcd_barrier(bar, [&]() { int tid = threadIdx.x; asm volatile("" : "+v"(tid)); const int lane = tid & 63, wave = __builtin_amdgcn_readfirstlane(tid >> 6);
        LAS float* scr = (LAS float*)(lds + wave * 16384);
        for (int it = (int)blockIdx.x * 7 + wave - 1; it < 1024; it += G * 7) { const int sec = it >> 9, r = it & 511, kb = r >> 3, nb = r & 7;
            transpose_item(sec ? w1v : w1k, 256, nb * 32, 256, kb * 64, nullptr, W1t + (size_t)sec * 256 * 4096, 4096, nb * 32, scr, lane); }
        wbt_under(lds, G, 1024, 4352, 5120); });
    for (int rep = 0; rep < REP_EW; ++rep) { PHASE_VARS
    const bool xaff = (G == 256); const int xq = (int)blockIdx.x & 7;
    const int m_lo = xaff ? xq * 1024 + ((int)blockIdx.x >> 3) * 8 + wave : gw, m_st = xaff ? 256 : NGW, m_hi = xaff ? xq * 1024 + 1024 : MTOK;
    for (int m = m_lo; m < m_hi; m += m_st) {
        float sp = (lane < 32) ? ssq0[(size_t)m * 32 + lane] : 0.f;
        const float r0 = rsqrtf(wave_sum(sp) * (1.f / DM) + 1e-6f);
        if (lane == 0) rstd0[m] = r0;
        const float4* xr = (const float4*)(x + (size_t)m * DM) + lane; const uint2* yr = (const uint2*)(y0b + (size_t)m * DM) + lane; const float4* gr = (const float4*)norm_post + lane;
        float4 hv[8]; float ss = 0.f;
#pragma unroll
        for (int j = 0; j < 8; ++j) {
            const float4 xv = ldnt4(xr + 64 * j); const uint2 yv = yr[64 * j]; const float4 gv = gr[64 * j];
            hv[j].x = xv.x + bflo(yv.x) * r0 * gv.x; hv[j].y = xv.y + bfhi(yv.x) * r0 * gv.y; hv[j].z = xv.z + bflo(yv.y) * r0 * gv.z; hv[j].w = xv.w + bfhi(yv.y) * r0 * gv.w;
            ss += (hv[j].x * hv[j].x + hv[j].y * hv[j].y) + (hv[j].z * hv[j].z + hv[j].w * hv[j].w);
        }
        const float rh = rsqrtf(wave_sum(ss) * (1.f / DM) + 1e-6f);
        uint2* o8 = (uint2*)(xhat1 + (size_t)m * DM) + lane;
#pragma unroll
        for (int j = 0; j < 8; ++j) o8[64 * j] = make_uint2(pk2(hv[j].x * rh, hv[j].y * rh), pk2(hv[j].z * rh, hv[j].w * rh));
    } }
    xcd_barrier(bar);
    for (int rep = 0; rep < REP_P5; ++rep) {
        pg8::Gemm g{xhat1, WB_t, MTOK, NWB, DM, DM, DM}; pg8::P5Order S; S.init(MTOK, NWB, G, (int)blockIdx.x); S.cnt = kvcnt; S.ui = 0; S.lastkv = 0; S.elect = (LAS unsigned*)(lds + LDS_BYTES - 64 + 12);
        S.xcnt = (unsigned*)(ws + WS_BAR) + 3776 + 16 * bar.x; S.nloc = ((volatile LAS unsigned*)(lds + LDS_BYTES - 64))[0];
        { pg8::Unit u5; for (int i = 0; S.next(i, u5); ++i) if (u5.pn >= 32 && u5.pn < 44) S.lastkv = i; }
        pg8::EpiK<3> E{qB, kvb};
        pg8::gemm_phase<pg8::EpiK<3>, pg8::P5Order, true, true>(lds, g, S, E);
    }
    for (int rep = 0; rep < REP_EW; ++rep) {
        const int ntl5 = (MTOK / 256) * (NWB / 256);
        pg8::Gemm g{kvb, W1t, 4096, 256, 1024, 2048, 4096}; pg8::CmpOrder S{(int)blockIdx.x, G, ntl5 % G, kvcnt, ((volatile LAS unsigned*)(lds + LDS_BYTES - 64))[1]  , (unsigned*)(ws + WS_BAR) + XB_TMO, cpcnt, (LAS unsigned*)(lds + LDS_BYTES - 64 + 12)};
        pg8::EpiPart E{cpart};
        pg8::gemm_phase<pg8::EpiPart, pg8::CmpOrder, false, true>(lds, g, S, E);
        __syncthreads();
        { PHASE_VARS
          const int first5 = ntl5 % G, ci = ((int)blockIdx.x - first5 + G) % G, nidle = first5 ? G - first5 : G, ntr = nidle > 64 ? nidle - 64 : nidle, ct = nidle > 64 ? ci - 64 : ci;
          if (ci < nidle && ct >= 0 && ct < ntr) {
              LAS float* scr64 = (LAS float*)(lds + wave * 20480);
              for (int it = ct * NWAVES + wave; it < 1024; it += 2 * ntr * NWAVES) {
                  const int itb = it + ntr * NWAVES; const bool hasb = itb < 1024;
                  const TItem ta{w_out_b, nullptr, WoB_t, 2048, (it & 31) * 64, 2048, (it >> 5) * 64, DM, (it & 31) * 64, 1.f};
                  const int ib = hasb ? itb : it; const TItem tb{w_out_b, nullptr, WoB_t, 2048, (ib & 31) * 64, 2048, (ib >> 5) * 64, DM, (ib & 31) * 64, 1.f};
                  float va[64], vb[64];
                  titem_load64(ta, va, lane); if (hasb) titem_load64(tb, vb, lane);
                  titem_store64(ta, va, scr64, lane); if (hasb) titem_store64(tb, vb, scr64, lane);
              }
          } }
    }
    for (int rep = 0; rep < REP_EW; ++rep) {
        PHASE_VARS
        const int first5 = ((MTOK / 256) * (NWB / 256)) % G, ci = ((int)blockIdx.x - first5 + G) % G, nidle = first5 ? G - first5 : G;
        if (ci < nidle) {
        if (tid < 64) {
            unsigned sp = 0u; unsigned* tmo = (unsigned*)(ws + WS_BAR) + XB_TMO;
            while ((unsigned)__builtin_amdgcn_readfirstlane(__hip_atomic_load(cpcnt, __ATOMIC_RELAXED, __HIP_MEMORY_SCOPE_AGENT)) < 64u) {
                __builtin_amdgcn_s_sleep(2);
                if ((++sp & 255u) == 0u) { if (__hip_atomic_load(tmo, __ATOMIC_RELAXED, __HIP_MEMORY_SCOPE_AGENT)) break; if (sp > (1u << 18)) { atomicAdd(tmo, 1u); break; } } }
            __builtin_amdgcn_fence(__ATOMIC_ACQUIRE, "agent");
            asm volatile("s_waitcnt vmcnt(0)" ::: "memory");
        }
        __syncthreads();
        const int hsec = nidle / 2, sec = (ci >= hsec) ? 1 : 0, bl = ci - sec * hsec, nbl = sec ? nidle - hsec : hsec;
        LAS float* W2s = (LAS float*)lds;
        auto load_a = [&](int rr) -> float4 {
            const int cbl = rr >> 9, row = (sec * 4 + cbl) * 512 + (rr & 511);
            float4 a = *(const float4*)(posvec + sec * 256 + 4 * lane);
#pragma unroll
            for (int q = 1; q < 4; ++q) { const float4 pq = *(const float4*)(posvec + q * 512 + sec * 256 + 4 * lane); a.x += pq.x; a.y += pq.y; a.z += pq.z; a.w += pq.w; }
#pragma unroll
            for (int ks = 0; ks < 4; ++ks) { const uint2 pv = *(const uint2*)(cpart + ((size_t)ks * 4096 + row) * 256 + 4 * lane); a.x += bflo(pv.x); a.y += bfhi(pv.x); a.z += bflo(pv.y); a.w += bfhi(pv.y); }
            return a; };
        const int rr0 = bl * NWAVES + wave, rrs = nbl * NWAVES;
        float4 apre0 = make_float4(0.f, 0.f, 0.f, 0.f), apre1 = apre0;
        if (rr0 < 2048) apre0 = load_a(rr0);
        if (rr0 + 1024 < 2048) apre1 = load_a(rr0 + 1024);
        { const float* w2 = sec ? w2v : w2k; att::f32x4 tw[16];
#pragma unroll
          for (int i = 0; i < 16; ++i) tw[i] = *(const att::f32x4*)(w2 + 4 * (tid + i * NTHREADS));
#pragma unroll
          for (int i = 0; i < 16; ++i) *(LAS att::f32x4*)(W2s + 4 * (tid + i * NTHREADS)) = tw[i]; }
        __syncthreads();
        LAS bf16_t* hidb = (LAS bf16_t*)(lds + 131072);
        const int fr = lane & 15, fq = lane >> 4;
        for (int base = bl * NWAVES; base < 1024; base += nbl * NWAVES) {
#pragma unroll
            for (int q = 0; q < 2; ++q) { const int rr = base + wave + 1024 * q;
                const float4 a = (base == bl * NWAVES) ? (q ? apre1 : apre0) : load_a(rr);
                float hv[4] = {a.x, a.y, a.z, a.w};
#pragma unroll
                for (int j = 0; j < 4; ++j) { const float v = hv[j]; const float u = 0.7978845608028654f * (v + 0.044715f * v * v * v); hv[j] = 0.5f * v * (1.f + tanhf(u)); }
                typedef unsigned u2v_t __attribute__((ext_vector_type(2)));
                *(LAS u2v_t*)(hidb + (8 * q + wave) * 264 + 4 * lane) = (u2v_t){pk2(hv[0], hv[1]), pk2(hv[2], hv[3])}; }
            asm volatile("s_waitcnt lgkmcnt(0)" ::: "memory");
            __syncthreads();
            pg8::f32x4 acc = {0.f, 0.f, 0.f, 0.f};
#pragma unroll
            for (int ks = 0; ks < 8; ++ks) {
                const LAS float* wp = W2s + (32 * ks + 8 * fq) * 128 + 16 * wave + fr;
                pg8::u32x4 aw; aw.x = pg8::cvt_pk_bf16(wp[0 * 128], wp[1 * 128]); aw.y = pg8::cvt_pk_bf16(wp[2 * 128], wp[3 * 128]); aw.z = pg8::cvt_pk_bf16(wp[4 * 128], wp[5 * 128]); aw.w = pg8::cvt_pk_bf16(wp[6 * 128], wp[7 * 128]);
                const pg8::bf16x8 bh = *(const LAS pg8::bf16x8*)(hidb + fr * 264 + 32 * ks + 8 * fq);
                acc = __builtin_amdgcn_mfma_f32_16x16x32_bf16(__builtin_bit_cast(pg8::bf16x8, aw), bh, acc, 0, 0, 0);
            }
            { const int rr = base + (fr & 7) + 1024 * (fr >> 3), cbl = rr >> 9, b = (rr >> 7) & 3, c = rr & 127;
              bf16_t* dst = (sec ? vcmp : kcmp) + ((size_t)(b * 4 + cbl) * 128 + c) * HD + 16 * wave + 4 * fq;
              *(uint2*)dst = (c == 127) ? make_uint2(0u, 0u) : make_uint2(pk2(acc[0], acc[1]), pk2(acc[2], acc[3])); }
            __syncthreads();
        }
        }
    }
    xcd_barrier(bar, [&]() { const int t7 = (int)threadIdx.x - 64, ln = (int)threadIdx.x & 63;
        const int vcu0 = (G % 8 == 0) ? ((int)blockIdx.x % 8) * (G / 8) + (int)blockIdx.x / 8 : (int)blockIdx.x; const int gq0 = (vcu0 >> 4) & 3;
        if (vcu0 < 256) {
            LAS float* Ts = (LAS float*)(lds + L_TSEL); LAS float* Tw = (LAS float*)(lds + L_TWIN); const float NINF_ = -__builtin_inff();
            const float t0 = table[(ln >> 2) * NH + gq0 * 4 + (ln & 3)] * att::LOG2E, t1 = table[((ln + 64) >> 2) * NH + gq0 * 4 + (ln & 3)] * att::LOG2E;
            for (int i0 = 0; i0 < 4 * 2112; i0 += 448) { const int i = i0 + t7, hh = i / 2112, xx = i - hh * 2112, dist = xx - 64, idx = rel_bucket(dist > 0 ? dist : 0) * 4 + (hh & 3);
                const float a = __shfl(t0, idx & 63), bq = __shfl(t1, idx & 63); if (i < 4 * 2112) Ts[hh * 2112 + 2111 - xx] = dist >= 0 ? (idx < 64 ? a : bq) : NINF_; }
            for (int i0 = 0; i0 < 4 * 640; i0 += 448) { const int i = i0 + t7, hh = i / 640, xx = i - hh * 640, delta = xx - 64, idx = rel_bucket(delta > 0 ? delta : 0) * 4 + (hh & 3);
                const float a = __shfl(t0, idx & 63), bq = __shfl(t1, idx & 63); if (i < 4 * 640) Tw[hh * 640 + 639 - xx] = (delta >= 0 && delta < 512) ? (idx < 64 ? a : bq) : NINF_; }
        } });
    for (int rep = 0; rep < REP_P7; ++rep) {
        const int tid_ph = threadIdx.x; const int wave = __builtin_amdgcn_readfirstlane(tid_ph >> 6);
        const int jh = wave >> 1, sub = wave & 1;
        const int vcu = (G % 8 == 0) ? ((int)blockIdx.x % 8) * (G / 8) + (int)blockIdx.x / 8 : (int)blockIdx.x;
        LAS float* Tsel = (LAS float*)(lds + L_TSEL); LAS float* Twin = (LAS float*)(lds + L_TWIN);
        LAS float* impH = (LAS float*)(lds + L_IMPH);
        LAS unsigned* selm = (LAS unsigned*)(lds + L_SELM); LAS int* tl = (LAS int*)(lds + L_TL);
        const float NINF = -__builtin_inff();
        for (int pi = vcu; pi < 256; pi += G) {
        if (pi != vcu) {
            const int gq = (pi >> 4) & 3; const int tid = tid_ph;
            LAS float* tab4 = (LAS float*)(lds + L_TAB4);
            if (tid < 128) tab4[tid] = table[(tid >> 2) * NH + gq * 4 + (tid & 3)] * att::LOG2E;
            __syncthreads();
            for (int i0 = tid; i0 < 4 * 2112; i0 += 4 * NTHREADS) { float v[4];
#pragma unroll
                for (int j = 0; j < 4; ++j) { const int i = i0 + j * NTHREADS, hh = i / 2112, xx = i - hh * 2112, dist = xx - 64; v[j] = (i < 4 * 2112 && dist >= 0) ? tab4[rel_bucket(dist) * 4 + hh] : NINF; }
#pragma unroll
                for (int j = 0; j < 4; ++j) { const int i = i0 + j * NTHREADS, hh = i / 2112, xx = i - hh * 2112; if (i < 4 * 2112) Tsel[hh * 2112 + 2111 - xx] = v[j]; } }
            for (int i0 = tid; i0 < 4 * 640; i0 += 4 * NTHREADS) { float v[4];
#pragma unroll
                for (int j = 0; j < 4; ++j) { const int i = i0 + j * NTHREADS, hh = i / 640, xx = i - hh * 640, delta = xx - 64; v[j] = (i < 4 * 640 && delta >= 0 && delta < 512) ? tab4[rel_bucket(delta) * 4 + hh] : NINF; }
#pragma unroll
                for (int j = 0; j < 4; ++j) { const int i = i0 + j * NTHREADS, hh = i / 640, xx = i - hh * 640; if (i < 4 * 640) Twin[hh * 640 + 639 - xx] = v[j]; } }
        }
        for (int pass = 0; pass < 2; ++pass) {
            int tid = tid_ph; asm volatile("" : "+v"(tid));
            const int lane = tid & 63, r32 = lane & 31, hi = lane >> 5;
            const int bg = pi >> 4, qb = pass ? 31 - (pi & 15) : (pi & 15), b = bg >> 2, gq = bg & 3, h = gq * 4 + jh;
            const int tq = 64 * qb + 32 * sub + r32;
            const int grow0 = b * SEQ + 64 * qb + 32 * sub;
            const LAS float* Tsh = Tsel + jh * 2112; const LAS float* Twh = Twin + jh * 640;
            att::bf16x8 qr[8];
            { const bf16_t* qp = qB + ((size_t)h * MTOK + grow0 + r32) * HD + hi * 8;
#pragma unroll
              for (int d0 = 0; d0 < 8; ++d0) qr[d0] = *(const att::bf16x8*)(qp + d0 * 16); }
            float gsig[3];
#pragma unroll
            for (int br = 0; br < 3; ++br) gsig[br] = frcp(1.f + __expf(-bf2f(gB[(size_t)(grow0 + r32) * 256 + br * 16 + h])));
            att::f32x16 o[4];
            {
                const int sr = tid >> 4, sc = (tid & 15) * 8, vst0 = att::v_st(sr, sc), vst1 = att::v_st(32 + sr, sc), kws = ATT_KSWZ(sr, sc * 2);
                const bf16_t* Kc = kcmp + (size_t)bg * 128 * HD; const bf16_t* Vc = vcmp + (size_t)bg * 128 * HD;
#pragma unroll
                for (int tt = 0; tt < 2; ++tt) {
                    const size_t e0 = (size_t)(64 * tt + sr) * HD + sc, e1 = e0 + 32 * HD;
                    *(LAS att::bf16x8*)(lds + att::L_K + tt * att::SHM_K + kws) = *(const att::bf16x8*)(Kc + e0); *(LAS att::bf16x8*)(lds + att::L_K + tt * att::SHM_K + kws + 32 * 256) = *(const att::bf16x8*)(Kc + e1);
                    *(LAS att::bf16x8*)(lds + att::L_V + tt * att::SHM_V + vst0) = *(const att::bf16x8*)(Vc + e0); *(LAS att::bf16x8*)(lds + att::L_V + tt * att::SHM_V + vst1) = *(const att::bf16x8*)(Vc + e1);
                }
                __syncthreads();
                att::f32x16 pA0, pA1, pB0, pB1;
                const int xb = tq + 33 - 64 * hi;
#pragma unroll
                for (int r = 0; r < 16; ++r) { const int cr = 16 * ((r & 3) + 8 * (r >> 2));
                    pA0[r] = Tsh[2111 - max(xb - cr, 0)]; pA1[r] = Tsh[2111 - max(xb - cr - 512, 0)]; pB0[r] = Tsh[2111 - max(xb - cr - 1024, 0)]; pB1[r] = Tsh[2111 - max(xb - cr - 1536, 0)]; }
                {
                    const LAS unsigned char* kb[4];
#pragma unroll
                    for (int dd = 0; dd < 4; ++dd) kb[dd] = lds + att::L_K + ATT_KSWZ(r32, (dd * 16 + hi * 8) * 2);
#pragma unroll
                    for (int d0 = 0; d0 < 8; ++d0) { const LAS unsigned char* a = kb[d0 & 3] + (d0 >> 2) * 128;
                        pA0 = __builtin_amdgcn_mfma_f32_32x32x16_bf16(*(const LAS att::bf16x8*)a, qr[d0], pA0, 0, 0, 0);
                        pA1 = __builtin_amdgcn_mfma_f32_32x32x16_bf16(*(const LAS att::bf16x8*)(a + 32 * 256), qr[d0], pA1, 0, 0, 0);
                        pB0 = __builtin_amdgcn_mfma_f32_32x32x16_bf16(*(const LAS att::bf16x8*)(a + att::SHM_K), qr[d0], pB0, 0, 0, 0);
                        pB1 = __builtin_amdgcn_mfma_f32_32x32x16_bf16(*(const LAS att::bf16x8*)(a + att::SHM_K + 32 * 256), qr[d0], pB1, 0, 0, 0); }
                }
                float mx = NINF;
#pragma unroll
                for (int r = 0; r < 16; ++r) mx = fmaxf(fmaxf(mx, pA0[r]), fmaxf(fmaxf(pA1[r], pB0[r]), pB1[r]));
                { auto rr = __builtin_amdgcn_permlane32_swap(__float_as_uint(mx), __float_as_uint(mx), false, false); mx = fmaxf(__uint_as_float(rr[0]), __uint_as_float(rr[1])); }
                if (mx == NINF) mx = 0.f;
                float ps = 0.f;
#pragma unroll
                for (int r = 0; r < 16; ++r) { pA0[r] = __builtin_amdgcn_exp2f(pA0[r] - mx); pA1[r] = __builtin_amdgcn_exp2f(pA1[r] - mx);
                    pB0[r] = __builtin_amdgcn_exp2f(pB0[r] - mx); pB1[r] = __builtin_amdgcn_exp2f(pB1[r] - mx); ps += (pA0[r] + pA1[r]) + (pB0[r] + pB1[r]); }
                { auto rr = __builtin_amdgcn_permlane32_swap(__float_as_uint(ps), __float_as_uint(ps), false, false); ps = __uint_as_float(rr[0]) + __uint_as_float(rr[1]); }
                const float l_c = ps, inv = ps > 0.f ? frcp(ps) : 0.f;
                {
                    const int qrow = 32 * sub + r32; LAS float* ip = impH + (jh * 64 + qrow) * 32 + hi;
                    float eprev = 0.f;
#define IMP_GRP(P, U0) do { _Pragma("unroll") for (int q4 = 0; q4 < 4; ++q4) { \
                        const float gsum = ((P[4 * q4] + P[4 * q4 + 1]) + (P[4 * q4 + 2] + P[4 * q4 + 3])) * inv, e3 = P[4 * q4 + 3] * inv; \
                        const float eo = __uint_as_float(__builtin_amdgcn_permlane32_swap(__float_as_uint(e3), __float_as_uint(e3), false, false)[hi ? 0 : 1]);     \
                        const float ein = hi ? eo : eprev; eprev = eo; ip[2 * ((U0) + q4)] = gsum + ein; } } while (0)
                    IMP_GRP(pA0, 0); IMP_GRP(pA1, 4); IMP_GRP(pB0, 8); IMP_GRP(pB1, 12);
#undef IMP_GRP
                }
                att::bf16x8 pa0, pa1, pa2, pa3, pb0, pb1, pb2, pb3;
                ATT_PK4(pA0, 0, pa0); ATT_PK4(pA0, 8, pa1); ATT_PK4(pA1, 0, pa2); ATT_PK4(pA1, 8, pa3);
                ATT_PK4(pB0, 0, pb0); ATT_PK4(pB0, 8, pb1); ATT_PK4(pB1, 0, pb2); ATT_PK4(pB1, 8, pb3);
#pragma unroll
                for (int d_ = 0; d_ < 4; ++d_)
#pragma unroll
                    for (int r = 0; r < 16; ++r) o[d_][r] = 0.f;
                const int vb0 = att::L_V + att::v_rd_base(lane);
                att::pv_tile(o, vb0, pa0, pa1, pa2, pa3);
                att::pv_tile(o, vb0 + att::SHM_V, pb0, pb1, pb2, pb3);
                __syncthreads();
                {
                    const int q = tid >> 3, n4 = (tid & 7) * 4, cur = qb;
                    float vals[32];
#pragma unroll
                    for (int i = 0; i < 8; ++i) {
                        att::f32x4 gv = *(const LAS att::f32x4*)(impH + (0 * 64 + q) * 32 + 4 * i);
                        gv += *(const LAS att::f32x4*)(impH + (1 * 64 + q) * 32 + 4 * i); gv += *(const LAS att::f32x4*)(impH + (2 * 64 + q) * 32 + 4 * i); gv += *(const LAS att::f32x4*)(impH + (3 * 64 + q) * 32 + 4 * i);
#pragma unroll
                        for (int e = 0; e < 4; ++e) { const int n = 4 * i + e; const bool forced = (n == 0) || (n == cur) || (n == cur - 1);
                            vals[n] = forced ? 1e9f : (n > cur ? -1e9f : gv[e]); } }
                    att::f32x4 mine = *(const LAS att::f32x4*)(impH + (0 * 64 + q) * 32 + n4);
                    mine += *(const LAS att::f32x4*)(impH + (1 * 64 + q) * 32 + n4); mine += *(const LAS att::f32x4*)(impH + (2 * 64 + q) * 32 + n4); mine += *(const LAS att::f32x4*)(impH + (3 * 64 + q) * 32 + n4);
                    unsigned bits = 0u;
#pragma unroll
                    for (int e = 0; e < 4; ++e) {
                        const int n = n4 + e; const bool forced = (n == 0) || (n == cur) || (n == cur - 1);
                        const float myv = forced ? 1e9f : (n > cur ? -1e9f : mine[e]);
                        int rank = 0;
#pragma unroll
                        for (int m2 = 0; m2 < 32; ++m2) rank += (vals[m2] > myv || (vals[m2] == myv && m2 < n)) ? 1 : 0;
                        if (rank < 16 && n <= cur) bits |= 1u << n;
                    }
                    bits |= __shfl_xor(bits, 1); bits |= __shfl_xor(bits, 2); bits |= __shfl_xor(bits, 4);
                    if ((tid & 7) == 0) selm[q] = bits;
                }
                __syncthreads();
                if (tid < 64) {
                    unsigned un = selm[lane];
#pragma unroll
                    for (int off = 1; off < 64; off <<= 1) un |= __shfl_xor(un, off);
                    if (lane < 32 && ((un >> lane) & 1u)) tl[__popc(un & ((1u << lane) - 1u))] = lane;
                    if (lane == 0) { tl[32] = __popc(un); tl[33] = (int)un; }
                }
                __syncthreads();
                GateF F{zB + (size_t)grow0 * 6144 + 0 * 2048 + h * HD, gsig[0], a1 + (size_t)grow0 * DM + h * HD, 1};
                att::emit(lds, o, l_c, lane, wave, F);
            }
            {
                SelU U; U.K = kvb + ((size_t)(2 * 4 + gq) * MTOK + b * SEQ) * HD; U.V = kvb + ((size_t)(3 * 4 + gq) * MTOK + b * SEQ) * HD;
                U.un = (unsigned)__builtin_amdgcn_readfirstlane(tl[33]); U.ntl = __builtin_amdgcn_readfirstlane(tl[32]); U.mymask = selm[32 * sub + r32]; U.tq_off = tq - 4 * hi + 5; U.T = Tsh;
#pragma unroll
                for (int d_ = 0; d_ < 4; ++d_)
#pragma unroll
                    for (int r = 0; r < 16; ++r) o[d_][r] = 0.f;
                float m_reg = -1e30f, l_reg = 0.f;
                for (int rf = 0; rf < REP_F7; ++rf) {
                    if (rf) { asm volatile("" :: "v"(o[0]), "v"(o[1]), "v"(o[2]), "v"(o[3]), "v"(m_reg), "v"(l_reg));
#pragma unroll
                        for (int d_ = 0; d_ < 4; ++d_)
#pragma unroll
                            for (int r = 0; r < 16; ++r) o[d_][r] = 0.f;
                        m_reg = -1e30f; l_reg = 0.f; }
                    att::flash_tiles(lds, U, qr, o, m_reg, l_reg, tid, lane, wave);
                }
                GateF F{zB + (size_t)grow0 * 6144 + 1 * 2048 + h * HD, gsig[1], a1 + (size_t)grow0 * DM + h * HD, 0};
                att::emit(lds, o, l_reg, lane, wave, F);
            }
            {
                WinU U; U.K = kvb + ((size_t)(4 * 4 + gq) * MTOK + b * SEQ) * HD; U.V = kvb + ((size_t)(5 * 4 + gq) * MTOK + b * SEQ) * HD;
                const int jlo = qb < 8 ? 8 - qb : 0; U.tk_base = 64 * qb - 512 + 64 * jlo; U.ntl = 9 - jlo; U.tq_off = tq - 4 * hi + 5; U.T = Twh;
#pragma unroll
                for (int d_ = 0; d_ < 4; ++d_)
#pragma unroll
                    for (int r = 0; r < 16; ++r) o[d_][r] = 0.f;
                float m_reg = -1e30f, l_reg = 0.f;
                for (int rf = 0; rf < REP_F7; ++rf) {
                    if (rf) { asm volatile("" :: "v"(o[0]), "v"(o[1]), "v"(o[2]), "v"(o[3]), "v"(m_reg), "v"(l_reg));
#pragma unroll
                        for (int d_ = 0; d_ < 4; ++d_)
#pragma unroll
                            for (int r = 0; r < 16; ++r) o[d_][r] = 0.f;
                        m_reg = -1e30f; l_reg = 0.f; }
                    att::flash_tiles(lds, U, qr, o, m_reg, l_reg, tid, lane, wave);
                }
                GateF F{zB + (size_t)grow0 * 6144 + 2 * 2048 + h * HD, gsig[2], a1 + (size_t)grow0 * DM + h * HD, 0};
                att::emit(lds, o, l_reg, lane, wave, F);
            }
        }
        __syncthreads();
        }
    }
    xcd_barrier(bar);
    for (int rep = 0; rep < REP_G2; ++rep) {
        pg8::Gemm g{a1, WoB_t, MTOK, DM, DM, DM, DM}; pg8::OutOrder S; S.init(MTOK, DM, G, (int)blockIdx.x);
        pg8::EpiK<2> E{y1b, (bf16_t*)ssq1};
        pg8::gemm_phase<pg8::EpiK<2>, pg8::OutOrder, true, true>(lds, g, S, E);
    }
    xcd_barrier(bar);
    for (int rep = 0; rep < REP_EW; ++rep) { PHASE_VARS
    const bool xaff = (G == 256); const int xq = (int)blockIdx.x & 7;
    const int m_lo = xaff ? xq * 1024 + ((int)blockIdx.x >> 3) * 8 + wave : gw, m_st = xaff ? 256 : NGW, m_hi = xaff ? xq * 1024 + 1024 : MTOK;
    for (int m = m_lo; m < m_hi; m += m_st) {
        float sp = (lane < 32) ? ssq1[(size_t)m * 32 + lane] : 0.f;
        const float r1 = rsqrtf(wave_sum(sp) * (1.f / DM) + 1e-6f), r0 = rstd0[m];
        const float4* xr = (const float4*)(x + (size_t)m * DM) + lane; const uint2* y0r = (const uint2*)(y0b + (size_t)m * DM) + lane; const uint2* y1r = (const uint2*)(y1b + (size_t)m * DM) + lane;
        const float4* g0r = (const float4*)norm_post + lane; const float4* g1r = (const float4*)(norm_post + DM) + lane;
        float4* orow = (float4*)(p.out + (size_t)m * DM) + lane;
#pragma unroll
        for (int j = 0; j < 8; ++j) {
            const float4 xv = ldnt4(xr + 64 * j); const uint2 a = ldnt2(y0r + 64 * j), bb = ldnt2(y1r + 64 * j); const float4 g0 = g0r[64 * j], g1 = g1r[64 * j];
            float4 o;
            o.x = xv.x + bflo(a.x) * r0 * g0.x + bflo(bb.x) * r1 * g1.x; o.y = xv.y + bfhi(a.x) * r0 * g0.y + bfhi(bb.x) * r1 * g1.y;
            o.z = xv.z + bflo(a.y) * r0 * g0.z + bflo(bb.y) * r1 * g1.z; o.w = xv.w + bfhi(a.y) * r0 * g0.w + bfhi(bb.y) * r1 * g1.w;
            { att::f32x4 ov = {o.x, o.y, o.z, o.w}; __builtin_nontemporal_store(ov, (att::f32x4*)(orow + 64 * j)); }
        }
    } }
}

extern "C" void kernel_launch(void* const* d_in, const int* in_sizes, int n_in, void* d_out, int out_size, void* d_ws, size_t ws_size, hipStream_t stream) {
    static int grid = 0;
    if (grid == 0) {
        if (n_in != 16 || ws_size < WS_END) { fprintf(stderr, "kernel_launch: unexpected n_in %d / ws_size %zu\n", n_in, ws_size); grid = -1; return; }
        int dev = 0, cus = 0, per_cu = 0;
        (void)hipGetDevice(&dev); (void)hipDeviceGetAttribute(&cus, hipDeviceAttributeMultiprocessorCount, dev);
        if (hipFuncSetAttribute((const void*)yoco_fwd, hipFuncAttributeMaxDynamicSharedMemorySize, LDS_BYTES) != hipSuccess) { fprintf(stderr, "kernel_launch: hipFuncSetAttribute failed\n"); grid = -1; return; }
        if (hipOccupancyMaxActiveBlocksPerMultiprocessor(&per_cu, (const void*)yoco_fwd, NTHREADS, LDS_BYTES) != hipSuccess || per_cu < 1) { fprintf(stderr, "kernel_launch: occupancy query says %d\n", per_cu); per_cu = 1; }
        (void)hipGetLastError();
        grid = cus;
        if (grid != 256) fprintf(stderr, "kernel_launch: note: %d CUs\n", grid);
    }
    if (grid < 0) return;
    if (hipMemsetAsync((char*)d_ws + WS_BAR, 0, 16384, stream) != hipSuccess) { fprintf(stderr, "kernel_launch: memset failed\n"); return; }
    Params prm{};
    for (int i = 0; i < 16; ++i) prm.in[i] = (const float*)d_in[i];
    prm.out = (float*)d_out; prm.ws = (unsigned char*)d_ws;
    void* args[] = {&prm};
    hipError_t e = hipLaunchCooperativeKernel((const void*)yoco_fwd, dim3(grid), dim3(NTHREADS), args, LDS_BYTES, stream);
    if (e != hipSuccess) fprintf(stderr, "kernel_launch: cooperative launch failed: %s (grid %d)\n", hipGetErrorString(e), grid);
}
```
